# Optimizing an MI355X kernel written in HIP

```python
import jax, jax.numpy as jnp
from jax import lax
import numpy as np

D_MODEL = 1024
BATCH = 16
SEQ = 4096
DEPTH = 4

N_A_LAYERS = DEPTH // 2
N_B_LAYERS = DEPTH - N_A_LAYERS
MLSTM_HEADS = 8
MLSTM_QK_DIM = D_MODEL // 2 // MLSTM_HEADS
MLSTM_V_DIM = D_MODEL // MLSTM_HEADS
MLSTM_CHUNK = 64
MLSTM_SPLITS = [MLSTM_HEADS * MLSTM_QK_DIM, MLSTM_HEADS * MLSTM_QK_DIM, MLSTM_HEADS * MLSTM_V_DIM,
                MLSTM_HEADS * MLSTM_V_DIM, MLSTM_HEADS, MLSTM_HEADS]
MLSTM_IN = sum(MLSTM_SPLITS)
FOX_HEADS = 16
FOX_HEAD_DIM = D_MODEL // FOX_HEADS
FOX_BLOCK = 128
D_FF = 2816
CONV_WIDTH = 3
EPS = 1e-6

kernel_name = 'hybrid_mlstm_fox_yoco_trunk'


def rmsnorm(x, w):
    xf = x.astype(jnp.float32)
    y = xf * lax.rsqrt(jnp.mean(xf * xf, axis=-1, keepdims=True) + EPS)
    return (y * w.astype(jnp.float32)).astype(x.dtype)


def mlstm_mixer(h, w_in, b_gate, w_head_norm, w_out):
    B, S, _ = h.shape
    H, DK, DV, L = MLSTM_HEADS, MLSTM_QK_DIM, MLSTM_V_DIM, MLSTM_CHUNK
    NC = S // L
    proj = h @ w_in
    idx = list(np.cumsum(MLSTM_SPLITS)[:-1])
    q, k, v, o, ig, fg = jnp.split(proj, idx, axis=-1)
    f32 = jnp.float32
    ig = ig.astype(f32) + b_gate[:H].astype(f32)
    lf = jax.nn.log_sigmoid(fg.astype(f32) + b_gate[H:].astype(f32))

    def to_chunks(t, d):
        return t.astype(f32).reshape(B, NC, L, H, d).transpose(1, 0, 3, 2, 4)

    qc = to_chunks(q, DK) * (DK ** -0.5)
    kc = to_chunks(k, DK)
    vc = to_chunks(v, DV)
    ic = ig.reshape(B, NC, L, H).transpose(1, 0, 3, 2)
    fc = lf.reshape(B, NC, L, H).transpose(1, 0, 3, 2)
    causal = jnp.tril(jnp.ones((L, L), dtype=bool))

    def step(carry, inp):
        C, n, m = carry
        qt, kt, vt, it, ft = inp
        b = jnp.cumsum(ft, axis=-1)
        dmat = jnp.where(causal, b[..., :, None] - b[..., None, :] + it[..., None, :], -jnp.inf)
        m_inter = b + m[..., None]
        m_t = jnp.maximum(m_inter, jnp.max(dmat, axis=-1))
        s = jnp.einsum('bhtd,bhsd->bhts', qt, kt) * jnp.exp(dmat - m_t[..., None])
        w_inter = jnp.exp(m_inter - m_t)
        num = jnp.einsum('bhts,bhse->bhte', s, vt) + w_inter[..., None] * jnp.einsum('bhtd,bhde->bhte', qt, C)
        den = jnp.sum(s, axis=-1) + w_inter * jnp.einsum('bhtd,bhd->bht', qt, n)
        ht = num / jnp.maximum(jnp.abs(den), jnp.exp(-m_t))[..., None]
        b_last = b[..., -1]
        g = b_last[..., None] - b + it
        m_new = jnp.maximum(b_last + m, jnp.max(g, axis=-1))
        decay = jnp.exp(b_last + m - m_new)
        wk = jnp.exp(g - m_new[..., None])
        C_new = decay[..., None, None] * C + jnp.einsum('bhs,bhsd,bhse->bhde', wk, kt, vt)
        n_new = decay[..., None] * n + jnp.einsum('bhs,bhsd->bhd', wk, kt)
        return (C_new, n_new, m_new), ht

    init = (jnp.zeros((B, H, DK, DV), f32), jnp.zeros((B, H, DK), f32), jnp.zeros((B, H), f32))
    _, hs = lax.scan(step, init, (qc, kc, vc, ic, fc))
    hs = hs.transpose(1, 0, 3, 2, 4).reshape(B, S, H, DV)
    hs = hs * lax.rsqrt(jnp.mean(hs * hs, axis=-1, keepdims=True) + EPS)
    hs = hs.reshape(B, S, H * DV) * w_head_norm.astype(f32)
    hs = hs * jax.nn.sigmoid(o.astype(f32))
    return hs.astype(h.dtype) @ w_out


def shared_kv(x, kv_norm, kv_w, kv_b_f):
    B, S, _ = x.shape
    h = rmsnorm(x, kv_norm)
    proj = h @ kv_w
    k, v, f = jnp.split(proj, [D_MODEL, 2 * D_MODEL], axis=-1)
    k = k.reshape(B, S, FOX_HEADS, FOX_HEAD_DIM)
    v = v.reshape(B, S, FOX_HEADS, FOX_HEAD_DIM)
    log_f = jax.nn.log_sigmoid(f.astype(jnp.float32) + kv_b_f.astype(jnp.float32))
    c = jnp.cumsum(log_f, axis=1).transpose(0, 2, 1)
    return k, v, c


def fox_mixer(h, w_qg, w_out, k, v, c):
    B, S, _ = h.shape
    H, DH, BLK = FOX_HEADS, FOX_HEAD_DIM, FOX_BLOCK
    NQ = S // BLK
    proj = h @ w_qg
    q, g = jnp.split(proj, [D_MODEL], axis=-1)
    q = q.reshape(B, S, H, DH) * (DH ** -0.5)
    qb = q.reshape(B, NQ, BLK, H, DH).transpose(1, 0, 2, 3, 4)
    cb = c.reshape(B, H, NQ, BLK).transpose(2, 0, 1, 3)
    starts = jnp.arange(NQ) * BLK
    key_pos = jnp.arange(S)

    def block(args):
        qi, ci, st = args
        logits = jnp.einsum('bqhd,bkhd->bhqk', qi, k).astype(jnp.float32)
        logits = logits + (ci[..., :, None] - c[..., None, :])
        qpos = st + jnp.arange(BLK)
        mask = key_pos[None, :] <= qpos[:, None]
        logits = jnp.where(mask, logits, -jnp.inf)
        p = jax.nn.softmax(logits, axis=-1)
        return jnp.einsum('bhqk,bkhd->bqhd', p.astype(v.dtype), v)

    o = lax.map(block, (qb, cb, starts))
    o = o.transpose(1, 0, 2, 3, 4).reshape(B, S, D_MODEL)
    o = o * jax.nn.sigmoid(g)
    return o @ w_out


def conv_ffn(h, w_up, conv_w, conv_b, w_down):
    S = h.shape[1]
    u = h @ w_up
    up = jnp.pad(u, ((0, 0), (CONV_WIDTH - 1, 0), (0, 0)))
    y = conv_b
    for j in range(CONV_WIDTH):
        y = y + conv_w[j] * up[:, j:j + S]
    gate, val = jnp.split(y, 2, axis=-1)
    return (jax.nn.gelu(gate, approximate=True) * val) @ w_down


def setup_inputs(seed: int = 0) -> dict:
    key = jax.random.key(seed)
    ks = jax.random.split(key, 24)
    D, H = D_MODEL, MLSTM_HEADS
    f32 = jnp.float32

    def nrm(k, shape, scale):
        return jax.random.normal(k, shape, f32) * scale

    def gain(k, shape):
        return 1.0 + 0.05 * jax.random.normal(k, shape, f32)

    x = jax.random.normal(ks[0], (BATCH, SEQ, D), f32)
    norm_mix_pre = gain(ks[1], (DEPTH, D))
    norm_mix_post = gain(ks[2], (DEPTH, D))
    norm_ffn_pre = gain(ks[3], (DEPTH, D))
    norm_ffn_post = gain(ks[4], (DEPTH, D))
    mlstm_w_in = nrm(ks[5], (N_A_LAYERS, D, MLSTM_IN), D ** -0.5)
    mlstm_b_gate = jnp.concatenate([
        nrm(ks[6], (N_A_LAYERS, H), 0.1),
        jax.random.uniform(ks[7], (N_A_LAYERS, H), f32, minval=3.0, maxval=6.0)], axis=-1)
    mlstm_norm = gain(ks[8], (N_A_LAYERS, H * MLSTM_V_DIM))
    mlstm_w_out = nrm(ks[9], (N_A_LAYERS, H * MLSTM_V_DIM, D), (H * MLSTM_V_DIM) ** -0.5)
    kv_norm = gain(ks[10], (D,))
    kv_w = nrm(ks[11], (D, 2 * D + FOX_HEADS), D ** -0.5)
    kv_b_f = jax.random.uniform(ks[12], (FOX_HEADS,), f32, minval=1.0, maxval=6.0)
    fox_w_qg = nrm(ks[13], (N_B_LAYERS, D, 2 * D), D ** -0.5)
    fox_w_out = nrm(ks[14], (N_B_LAYERS, D, D), D ** -0.5)
    ffn_w_up = nrm(ks[15], (DEPTH, D, 2 * D_FF), D ** -0.5)
    ffn_conv_w = nrm(ks[16], (DEPTH, CONV_WIDTH, 2 * D_FF), CONV_WIDTH ** -0.5)
    ffn_conv_b = nrm(ks[17], (DEPTH, 2 * D_FF), 0.02)
    ffn_w_down = nrm(ks[18], (DEPTH, D_FF, D), D_FF ** -0.5)
    return {'x': x, 'norm_mix_pre': norm_mix_pre, 'norm_mix_post': norm_mix_post,
            'norm_ffn_pre': norm_ffn_pre, 'norm_ffn_post': norm_ffn_post,
            'mlstm_w_in': mlstm_w_in, 'mlstm_b_gate': mlstm_b_gate, 'mlstm_norm': mlstm_norm,
            'mlstm_w_out': mlstm_w_out, 'kv_norm': kv_norm, 'kv_w': kv_w, 'kv_b_f': kv_b_f,
            'fox_w_qg': fox_w_qg, 'fox_w_out': fox_w_out, 'ffn_w_up': ffn_w_up,
            'ffn_conv_w': ffn_conv_w, 'ffn_conv_b': ffn_conv_b, 'ffn_w_down': ffn_w_down}


def reference(x, norm_mix_pre, norm_mix_post, norm_ffn_pre, norm_ffn_post, mlstm_w_in, mlstm_b_gate,
              mlstm_norm, mlstm_w_out, kv_norm, kv_w, kv_b_f, fox_w_qg, fox_w_out, ffn_w_up,
              ffn_conv_w, ffn_conv_b, ffn_w_down):
    k_sh = v_sh = c_sh = None
    for layer in range(DEPTH):
        h = rmsnorm(x, norm_mix_pre[layer])
        if layer < N_A_LAYERS:
            y = mlstm_mixer(h, mlstm_w_in[layer], mlstm_b_gate[layer], mlstm_norm[layer], mlstm_w_out[layer])
        else:
            j = layer - N_A_LAYERS
            y = fox_mixer(h, fox_w_qg[j], fox_w_out[j], k_sh, v_sh, c_sh)
        x = x + rmsnorm(y, norm_mix_post[layer])
        h = rmsnorm(x, norm_ffn_pre[layer])
        y = conv_ffn(h, ffn_w_up[layer], ffn_conv_w[layer], ffn_conv_b[layer], ffn_w_down[layer])
        x = x + rmsnorm(y, norm_ffn_post[layer])
        if layer == N_A_LAYERS - 1:
            k_sh, v_sh, c_sh = shared_kv(x, kv_norm, kv_w, kv_b_f)
    return x
```

```cpp
#include <hip/hip_runtime.h>
#include <hip/hip_bf16.h>
#include <cstdio>
#include <cstdint>
#include <cmath>
#include <hip/hip_runtime.h>
#include <cstdio>
#include <cstdint>
namespace pg8 {
#define PG8_LAS __attribute__((address_space(3)))
typedef unsigned short bf16_t;
typedef short bf16x8 __attribute__((ext_vector_type(8)));
typedef float f32x4 __attribute__((ext_vector_type(4)));
typedef unsigned u32x4 __attribute__((ext_vector_type(4)));
constexpr int BM = 256, BK = 64, HALF = 128, HTB = HALF * BK * 2  , STAGE_BYTES = 8 * HTB, NXCD = 8, WGM = 8;

__host__ __device__ __forceinline__ int lds_byte(int r, int c) { const int st = (r >> 4) * 2 + (c >> 5), rr = r & 15, cc = c & 31, ob = rr * 64 + cc * 2; return st * 1024 + (ob ^ (((ob >> 9) & 1) << 5)); }
__host__ __device__ __forceinline__ void stage_rc(int b, int& R, int& C) { const int st = b / 1024, sb = b % 1024, swz = sb ^ (((sb >> 9) & 1) << 5); R = (st >> 1) * 16 + swz / 64; C = (st & 1) * 32 + (swz % 64) / 2; }
__host__ __device__ __forceinline__ int perm32(int rho) { const int n = rho >> 4, i = rho & 15; return 8 * (i >> 2) + 4 * n + (i & 3); }

struct Unit { int pm, pn; };
struct Gemm { const bf16_t* A; const bf16_t* Bt; int M, N, K; };

struct StaticOrder {
    int nM, nN, nwg, G, c;
    __host__ __device__ void init(int M, int N, int G_, int c_) { nM = M / BM; nN = N / BM; nwg = nM * nN; G = G_; c = c_; }
    __host__ __device__ bool next(int i, Unit& u) const {
        const long L = (long)i * G + c; if (L >= nwg) return false;
        int wgid = (int)L; { const int q = nwg / NXCD, r = nwg % NXCD, xcd = wgid % NXCD, off = wgid / NXCD; wgid = (xcd < r ? xcd * (q + 1) : r * (q + 1) + (xcd - r) * q) + off; }
        const int nig = WGM * nN, gid = wgid / nig, fm = gid * WGM, gsz = (nM - fm) < WGM ? (nM - fm) : WGM;
        u.pm = fm + ((wgid % nig) % gsz); u.pn = (wgid % nig) / gsz; return true;
    }
    __device__ __forceinline__ void a_ready(const Unit&) const {}
    __device__ __forceinline__ void done(const Unit&) const {}
};

__device__ __forceinline__ unsigned cvt_pk_bf16(float lo, float hi) { unsigned r; asm volatile("v_cvt_pk_bf16_f32 %0, %1, %2" : "=v"(r) : "v"(lo), "v"(hi)); return r; }
typedef float f32x2 __attribute__((ext_vector_type(2)));
__device__ __forceinline__ f32x2 gelu_pk(f32x2 v) {
    const f32x2 av = __builtin_elementwise_abs(v), d = av * 0.2316418882f + 1.0f;
    f32x2 t; t.x = __builtin_amdgcn_rcpf(d.x); t.y = __builtin_amdgcn_rcpf(d.y);
    f32x2 q = t * 0.5307027145f + (-0.7265760135f); q = q * t + 0.7107068705f; q = q * t + (-0.142248368f); q = q * t + 0.127414796f; q = q * t;
    const f32x2 s = (v * v) * (-0.72134752044f);
    f32x2 e; e.x = __builtin_amdgcn_exp2f(s.x); e.y = __builtin_amdgcn_exp2f(s.y);
    const f32x2 m = v * (q * e), r = v - m;
    f32x2 o; o.x = v.x < 0.f ? m.x : r.x; o.y = v.y < 0.f ? m.y : r.y; return o;
}

template <int ACT  > struct EpiBf16 {
    static constexpr bool PERM = true, AFTER_DRAIN = false; static_assert(ACT == 0 || ACT == 1, "EpiBf16: ACT is 0 (none) or 1 (gelu_pk)");
    bf16_t* O; int ldc; const float* bias; int split_cols; size_t split_stride; float scale0;
    __device__ __forceinline__ void operator()(const f32x4 (&acc)[2][2][4][2], const Unit& u, int wr, int wc, int fr, int fq) const {
        const int row0 = u.pm * BM + wr * 64 + fr; int colt = u.pn * BM; bf16_t* base = O;
        float sc = 1.f; if (split_cols) { const int t = colt / split_cols; base += (size_t)t * split_stride; colt -= t * split_cols; if (t == 0) sc = scale0; }
        const int col0 = colt + wc * 32 + 8 * fq, bcol0 = u.pn * BM + wc * 32 + 8 * fq;
        f32x4 bv[2][2];
#pragma unroll
        for (int bj = 0; bj < 2; ++bj)
#pragma unroll
            for (int n = 0; n < 2; ++n) bv[bj][n] = bias ? *(const f32x4*)(bias + bcol0 + bj * HALF + 4 * n) : (f32x4){0.f, 0.f, 0.f, 0.f};
#pragma unroll
        for (int ai = 0; ai < 2; ++ai)
#pragma unroll
            for (int m = 0; m < 4; ++m) { bf16_t* rowp = base + (size_t)(row0 + ai * HALF + m * 16) * ldc + col0;
#pragma unroll
                for (int bj = 0; bj < 2; ++bj) { f32x4 v0 = acc[ai][bj][m][0] + bv[bj][0], v1 = acc[ai][bj][m][1] + bv[bj][1];
                    if (ACT == 1) { f32x2 a = gelu_pk((f32x2){v0[0], v0[1]}), b = gelu_pk((f32x2){v0[2], v0[3]}), c = gelu_pk((f32x2){v1[0], v1[1]}), d = gelu_pk((f32x2){v1[2], v1[3]});
                        v0 = (f32x4){a.x, a.y, b.x, b.y}; v1 = (f32x4){c.x, c.y, d.x, d.y}; }
                    v0 = v0 * sc; v1 = v1 * sc; u32x4 w; w.x = cvt_pk_bf16(v0[0], v0[1]); w.y = cvt_pk_bf16(v0[2], v0[3]); w.z = cvt_pk_bf16(v1[0], v1[1]); w.w = cvt_pk_bf16(v1[2], v1[3]);
                    *(u32x4*)(rowp + bj * HALF) = w; } }
    }
};

struct PanelStats {
    unsigned* xbuf;
    unsigned* cnt;
    unsigned* tmo;
    int ntn; float eps;
    unsigned code;
    __device__ __forceinline__ bool run(const f32x4 (&v)[2][2][4][2], const Unit& u, int wr, int wc, int fr, int fq, PG8_LAS unsigned char* lds, int wid, int lane) const {
        typedef float f32x2v __attribute__((ext_vector_type(2)));
        PG8_LAS f32x2v* P = (PG8_LAS f32x2v*)lds;
        PG8_LAS f32x2v* S = (PG8_LAS f32x2v*)(lds + 8192);
        PG8_LAS unsigned* flag = (PG8_LAS unsigned*)(lds + 8192 + 2048);
#pragma unroll
        for (int ai = 0; ai < 2; ++ai)
#pragma unroll
            for (int m = 0; m < 4; ++m) {
                float s = 0.f;
#pragma unroll
                for (int bj = 0; bj < 2; ++bj)
#pragma unroll
                    for (int n = 0; n < 2; ++n) { const f32x4 x = v[ai][bj][m][n]; s += (x[0] + x[1]) + (x[2] + x[3]); }
                s += __shfl_xor(s, 16); s += __shfl_xor(s, 32);
                const float mw = s * (1.0f / 64.0f); float q = 0.f;
#pragma unroll
                for (int bj = 0; bj < 2; ++bj)
#pragma unroll
                    for (int n = 0; n < 2; ++n) { const f32x4 d = v[ai][bj][m][n] - mw; q += (d[0] * d[0] + d[1] * d[1]) + (d[2] * d[2] + d[3] * d[3]); }
                q += __shfl_xor(q, 16); q += __shfl_xor(q, 32);
                if (fq == 0) P[(ai * HALF + wr * 64 + m * 16 + fr) * 4 + wc] = (f32x2v){mw, q};
            }
        asm volatile("s_waitcnt lgkmcnt(0)" ::: "memory"); __builtin_amdgcn_s_barrier(); asm volatile("" ::: "memory");
#if defined(BROKEN_EXCHANGE_NO_WAIT)
#warning BROKEN CONTROL BUILD: the row-statistics exchange does not wait; results are wrong by design
        if (blockIdx.x >= 64) { const long long t0_ = clock64(); while (clock64() - t0_ < 60000) __builtin_amdgcn_s_sleep(8); }
#endif
        const int row = wid * 32 + (lane & 31);
        if (lane < 32) {
            const f32x2v a = P[row * 4 + 0], b = P[row * 4 + 1], c = P[row * 4 + 2], d = P[row * 4 + 3];
            const float mt = (a.x + b.x + c.x + d.x) * 0.25f;
            const float da = a.x - mt, db = b.x - mt, dc = c.x - mt, dd = d.x - mt;
            const float m2 = (a.y + b.y) + (c.y + d.y) + 64.0f * ((da * da + db * db) + (dc * dc + dd * dd));
            unsigned long long* slot = (unsigned long long*)xbuf + ((size_t)(u.pm * BM + row) * 4 + u.pn);
            __hip_atomic_store(slot, ((unsigned long long)__float_as_uint(m2) << 32) | __float_as_uint(mt), __ATOMIC_RELAXED, __HIP_MEMORY_SCOPE_AGENT);
        }
        asm volatile("s_waitcnt vmcnt(0)" ::: "memory");
        if (lane == 0) __hip_atomic_fetch_add(cnt + 64 * u.pm, 1u, __ATOMIC_RELAXED, __HIP_MEMORY_SCOPE_AGENT);
        if (wid == 0) {
            bool dead = false; const unsigned long long t0 = __builtin_amdgcn_s_memrealtime(); const unsigned want = 8u * (unsigned)ntn;
            for (;;) {
#if defined(BROKEN_EXCHANGE_NO_WAIT)
                break;
#endif
                if ((unsigned)__builtin_amdgcn_readfirstlane(__hip_atomic_load(cnt + 64 * u.pm, __ATOMIC_RELAXED, __HIP_MEMORY_SCOPE_AGENT)) >= want) break;
                if (__builtin_amdgcn_s_memrealtime() - t0 > 2000000ull) {
                    if (lane == 0) { unsigned expect = 0u; __hip_atomic_compare_exchange_strong(tmo + 1, &expect, code | (unsigned)(u.pm & 0xff), __ATOMIC_RELAXED, __ATOMIC_RELAXED, __HIP_MEMORY_SCOPE_AGENT);
                                     __hip_atomic_store(tmo, 1u, __ATOMIC_RELAXED, __HIP_MEMORY_SCOPE_AGENT); }
                    dead = true; break; }
                __builtin_amdgcn_s_sleep(2);
            }
            __builtin_amdgcn_fence(__ATOMIC_ACQUIRE, "agent");
            if (lane == 0) flag[0] = dead ? 1u : 0u;
        }
        asm volatile("s_waitcnt vmcnt(0) lgkmcnt(0)" ::: "memory"); __builtin_amdgcn_s_barrier(); asm volatile("" ::: "memory");
        const bool bad = flag[0] != 0u;
        if (lane < 32) {
            const unsigned long long* slot = (const unsigned long long*)xbuf + (size_t)(u.pm * BM + row) * 4; float mt[4], m2[4]; float ms = 0.f;
#pragma unroll
            for (int t = 0; t < 4; ++t) { if (t < ntn) { const unsigned long long w = __hip_atomic_load(slot + t, __ATOMIC_RELAXED, __HIP_MEMORY_SCOPE_AGENT); mt[t] = __uint_as_float((unsigned)w); m2[t] = __uint_as_float((unsigned)(w >> 32)); } else { mt[t] = 0.f; m2[t] = 0.f; } ms += mt[t]; }
            const float mean = ms / (float)ntn; float q = 0.f;
#pragma unroll
            for (int t = 0; t < 4; ++t) if (t < ntn) { const float dm = mt[t] - mean; q += m2[t] + 256.0f * dm * dm; }
            S[row] = (f32x2v){mean, 1.0f / sqrtf(q / (256.0f * (float)ntn) + eps)};
        }
        asm volatile("s_waitcnt lgkmcnt(0)" ::: "memory"); __builtin_amdgcn_s_barrier(); asm volatile("" ::: "memory");
        return bad;
    }
};
struct EpiLnRes {
    static constexpr bool PERM = false, AFTER_DRAIN = true;
    const float* base; float* out; int ldc; const float* bias; PanelStats st; unsigned poison;
    __device__ __forceinline__ void fused(f32x4 (&acc)[2][2][4][2], const Unit& u, int wr, int wc, int fr, int fq, PG8_LAS unsigned char* lds, int wid, int lane) const {
        typedef float f32x2v __attribute__((ext_vector_type(2)));
        const PG8_LAS f32x2v* S = (const PG8_LAS f32x2v*)(lds + 8192);
        const int col0 = u.pn * BM + wc * 32 + 4 * fq;
#pragma unroll
        for (int bj = 0; bj < 2; ++bj)
#pragma unroll
            for (int n = 0; n < 2; ++n) { const f32x4 bv = bias ? *(const f32x4*)(bias + col0 + bj * HALF + n * 16) : (f32x4){0.f, 0.f, 0.f, 0.f};
#pragma unroll
                for (int ai = 0; ai < 2; ++ai)
#pragma unroll
                    for (int m = 0; m < 4; ++m) acc[ai][bj][m][n] += bv; }
        f32x4 pre[4][2][2];
#pragma unroll
        for (int m = 0; m < 4; ++m) { const size_t off = (size_t)(u.pm * BM + wr * 64 + m * 16 + fr) * ldc + col0;
#pragma unroll
            for (int bj = 0; bj < 2; ++bj)
#pragma unroll
                for (int n = 0; n < 2; ++n) pre[m][bj][n] = *(const f32x4*)(base + off + bj * HALF + n * 16); }
        const bool bad = st.run(acc, u, wr, wc, fr, fq, lds, wid, lane) || poison != 0u;
        const float qnan = __builtin_nanf("");
#pragma unroll
        for (int ai = 0; ai < 2; ++ai)
#pragma unroll
            for (int m = 0; m < 4; ++m) { const int r = ai * HALF + wr * 64 + m * 16 + fr; const f32x2v sr = S[r]; const size_t off = (size_t)(u.pm * BM + r) * ldc + col0;
#pragma unroll
                for (int bj = 0; bj < 2; ++bj)
#pragma unroll
                    for (int n = 0; n < 2; ++n) { const f32x4 bs = ai == 0 ? pre[m][bj][n] : *(const f32x4*)(base + off + bj * HALF + n * 16); f32x4 o = bs + (acc[ai][bj][m][n] - sr.x) * sr.y;
                        if (bad) o = (f32x4){qnan, qnan, qnan, qnan}; *(f32x4*)(out + off + bj * HALF + n * 16) = o; }
                if (m & 1) asm volatile("" ::: "memory"); }
    }
};
struct EpiLnResLn {
    static constexpr bool PERM = false, AFTER_DRAIN = true;
    const float* base; float* out; bf16_t* xn; int ldc; const float* bias; PanelStats st1, st2; unsigned poison;
    __device__ __forceinline__ void fused(f32x4 (&acc)[2][2][4][2], const Unit& u, int wr, int wc, int fr, int fq, PG8_LAS unsigned char* lds, int wid, int lane) const {
        typedef float f32x2v __attribute__((ext_vector_type(2))); typedef unsigned u32x2v __attribute__((ext_vector_type(2)));
        const PG8_LAS f32x2v* S = (const PG8_LAS f32x2v*)(lds + 8192);
        const int col0 = u.pn * BM + wc * 32 + 4 * fq;
#pragma unroll
        for (int bj = 0; bj < 2; ++bj)
#pragma unroll
            for (int n = 0; n < 2; ++n) { const f32x4 bv = bias ? *(const f32x4*)(bias + col0 + bj * HALF + n * 16) : (f32x4){0.f, 0.f, 0.f, 0.f};
#pragma unroll
                for (int ai = 0; ai < 2; ++ai)
#pragma unroll
                    for (int m = 0; m < 4; ++m) acc[ai][bj][m][n] += bv; }
        bool bad = st1.run(acc, u, wr, wc, fr, fq, lds, wid, lane) || poison != 0u;
        const float qnan = __builtin_nanf("");
#pragma unroll
        for (int ai = 0; ai < 2; ++ai)
#pragma unroll
            for (int m = 0; m < 4; ++m) { const int r = ai * HALF + wr * 64 + m * 16 + fr; const f32x2v sr = S[r]; const size_t off = (size_t)(u.pm * BM + r) * ldc + col0;
#pragma unroll
                for (int bj = 0; bj < 2; ++bj)
#pragma unroll
                    for (int n = 0; n < 2; ++n) { const f32x4 bs = *(const f32x4*)(base + off + bj * HALF + n * 16); acc[ai][bj][m][n] = bs + (acc[ai][bj][m][n] - sr.x) * sr.y; }
                asm volatile("" : "+v"(acc[ai][0][m][0]), "+v"(acc[ai][0][m][1]), "+v"(acc[ai][1][m][0]), "+v"(acc[ai][1][m][1]));
                if (m & 1) asm volatile("" ::: "memory"); }
        const bool bad1 = bad;
        bad = st2.run(acc, u, wr, wc, fr, fq, lds, wid, lane) || bad;
#pragma unroll
        for (int ai = 0; ai < 2; ++ai)
#pragma unroll
            for (int m = 0; m < 4; ++m) { const int r = ai * HALF + wr * 64 + m * 16 + fr; const f32x2v sr = S[r]; const size_t off = (size_t)(u.pm * BM + r) * ldc + col0;
#pragma unroll
                for (int bj = 0; bj < 2; ++bj)
#pragma unroll
                    for (int n = 0; n < 2; ++n) { const f32x4 x1 = acc[ai][bj][m][n]; *(f32x4*)(out + off + bj * HALF + n * 16) = bad1 ? (f32x4){qnan, qnan, qnan, qnan} : x1;
                        const f32x4 o = (x1 - sr.x) * sr.y; u32x2v w; w.x = cvt_pk_bf16(o[0], o[1]); w.y = cvt_pk_bf16(o[2], o[3]);
                        if (bad) { w.x = 0x7fc07fc0u; w.y = 0x7fc07fc0u; } *(u32x2v*)(xn + off + bj * HALF + n * 16) = w; }
                asm volatile("" ::: "memory"); }
    }
};

template <class Epi, class Sched, bool ALIGN_EPI = false, bool SP2 = false>
__device__ __forceinline__ void gemm_phase(PG8_LAS unsigned char* lds, const Gemm g, const Sched& S, const Epi& E) {
    int tid = threadIdx.x; asm volatile("" : "+v"(tid)); const int wid = __builtin_amdgcn_readfirstlane(tid >> 6), lane = tid & 63, wr = wid >> 2, wc = wid & 3, fr = lane & 15, fq = lane >> 4;
    const int K = g.K, nt = K / BK;
    unsigned voffA[2], voffB[2];
#pragma unroll
    for (int i = 0; i < 2; ++i) { int R, C; stage_rc(tid * 16 + i * 8192, R, C); const int Rb = Epi::PERM ? ((R & ~31) + perm32(R & 31)) : R;
        voffA[i] = (unsigned)(R * K + C) * 2u; voffB[i] = (unsigned)(Rb * K + C) * 2u; }
    const size_t kstep = (size_t)(BK * 2);
    const size_t hstep = (size_t)HALF * K * 2;
    const size_t tstep = 2 * hstep;
    const unsigned ldsw = (unsigned)wid * 1024u;
    const int aoff = lds_byte(wr * 64 + fr, fq * 8), boff = lds_byte(wc * 32 + fr, fq * 8);
#define PG8_SA(b, h) (((b) * 2 + (h)) * HTB)
#define PG8_SB(b, h) ((4 + (b) * 2 + (h)) * HTB)
#define PG8_STAGE(bufoff, gbase, voff) do { _Pragma("unroll") for (int _i = 0; _i < 2; ++_i) \
        __builtin_amdgcn_global_load_lds((const unsigned*)((const char*)(gbase) + (voff)[_i]), (PG8_LAS unsigned*)(lds + (bufoff) + ldsw + _i * 8192), 16, 0, 0); } while (0)
#define PG8_LDA(dst, b, h) do { _Pragma("unroll") for (int m = 0; m < 4; ++m) _Pragma("unroll") for (int k = 0; k < 2; ++k) dst[m][k] = *(const PG8_LAS bf16x8*)(lds + PG8_SA(b, h) + aoff + m * 2048 + k * 1024); } while (0)
#define PG8_LDB(dst, b, h) do { _Pragma("unroll") for (int n = 0; n < 2; ++n) _Pragma("unroll") for (int k = 0; k < 2; ++k) dst[n][k] = *(const PG8_LAS bf16x8*)(lds + PG8_SB(b, h) + boff + n * 2048 + k * 1024); } while (0)
#define PG8_MMA(ai, bj, At, Bt) do { __builtin_amdgcn_s_setprio(1); _Pragma("unroll") for (int m = 0; m < 4; ++m) _Pragma("unroll") for (int n = 0; n < 2; ++n) _Pragma("unroll") for (int k = 0; k < 2; ++k) \
        acc[ai][bj][m][n] = __builtin_amdgcn_mfma_f32_16x16x32_bf16(Bt[n][k], At[m][k], acc[ai][bj][m][n], 0, 0, 0); __builtin_amdgcn_s_setprio(0); } while (0)
#define PG8_WAIT_V(n) asm volatile("s_waitcnt vmcnt(" #n ")" ::: "memory")
#define PG8_WAIT_L(n) asm volatile("s_waitcnt lgkmcnt(" #n ")" ::: "memory")
#define PG8_BAR __builtin_amdgcn_s_barrier()
#define PG8_SCHED __builtin_amdgcn_sched_barrier(0)
    Unit cur, nxt; int ui = 0;
    if (!S.next(0, cur)) return;
    f32x4 acc[2][2][4][2];
#pragma unroll
    for (int a = 0; a < 2; ++a)
#pragma unroll
        for (int b = 0; b < 2; ++b)
#pragma unroll
            for (int m = 0; m < 4; ++m)
#pragma unroll
                for (int n = 0; n < 2; ++n) acc[a][b][m][n] = (f32x4){0.f, 0.f, 0.f, 0.f};
    bf16x8 At[4][2], B0[2][2], B1[2][2];
    const char* cA = (const char*)g.A + (size_t)cur.pm * tstep; const char* cB = (const char*)g.Bt + (size_t)cur.pn * tstep;
    S.a_ready(cur);
    if constexpr (SP2) {
        PG8_STAGE(PG8_SB(0, 0), cB, voffB); PG8_STAGE(PG8_SB(0, 1), cB + hstep, voffB); PG8_STAGE(PG8_SA(0, 0), cA, voffA); PG8_STAGE(PG8_SA(0, 1), cA + hstep, voffA);
        if (wr == 1) PG8_BAR;
        PG8_WAIT_V(2); PG8_BAR;
        PG8_STAGE(PG8_SB(1, 0), cB + kstep, voffB); PG8_STAGE(PG8_SA(1, 0), cA + kstep, voffA); PG8_STAGE(PG8_SB(1, 1), cB + hstep + kstep, voffB);
        PG8_WAIT_V(6); PG8_BAR;
    } else {
        PG8_STAGE(PG8_SB(0, 0), cB, voffB); PG8_STAGE(PG8_SA(0, 0), cA, voffA); PG8_STAGE(PG8_SB(0, 1), cB + hstep, voffB); PG8_STAGE(PG8_SA(0, 1), cA + hstep, voffA);
        if (wr == 1) PG8_BAR;
        PG8_WAIT_V(4); PG8_BAR;
        PG8_STAGE(PG8_SB(1, 0), cB + kstep, voffB); PG8_STAGE(PG8_SA(1, 0), cA + kstep, voffA); PG8_STAGE(PG8_SB(1, 1), cB + hstep + kstep, voffB);
        PG8_WAIT_V(6); PG8_BAR;
    }
    for (;;) {
        const bool has_next = S.next(ui + 1, nxt);
        const char* nA = has_next ? (const char*)g.A + (size_t)nxt.pm * tstep : cA; const char* nB = has_next ? (const char*)g.Bt + (size_t)nxt.pn * tstep : cB;
        for (int t = 0; t < nt; t += 2) {
            const bool last = (t == nt - 2);
            const char* a1 = cA + (size_t)(t + 1) * kstep;
            const char* a2 = last ? nA : cA + (size_t)(t + 2) * kstep; const char* b2 = last ? nB : cB + (size_t)(t + 2) * kstep;
            const char* a3 = a2 + kstep; const char* b3 = b2 + kstep;
            if (last && has_next) S.a_ready(nxt);
            if constexpr (SP2) {
            PG8_LDB(B0, 0, 0); PG8_LDB(B1, 0, 1); PG8_SCHED; PG8_LDA(At, 0, 0); PG8_STAGE(PG8_SA(1, 1), a1 + hstep, voffA);
            PG8_WAIT_V(8); PG8_WAIT_L(0); PG8_BAR; PG8_MMA(0, 0, At, B0); PG8_MMA(0, 1, At, B1); PG8_BAR; PG8_SCHED;
            PG8_LDA(At, 0, 1); PG8_STAGE(PG8_SB(0, 0), b2, voffB); PG8_STAGE(PG8_SB(0, 1), b2 + hstep, voffB); PG8_STAGE(PG8_SA(0, 0), a2, voffA);
            PG8_WAIT_V(8); PG8_WAIT_L(0); PG8_BAR; PG8_MMA(1, 0, At, B0); PG8_MMA(1, 1, At, B1); PG8_BAR; PG8_SCHED;
            PG8_LDB(B0, 1, 0); PG8_LDB(B1, 1, 1); PG8_SCHED; PG8_LDA(At, 1, 0); PG8_STAGE(PG8_SA(0, 1), a2 + hstep, voffA);
            PG8_WAIT_V(8); PG8_WAIT_L(0); PG8_BAR; PG8_MMA(0, 0, At, B0); PG8_MMA(0, 1, At, B1); PG8_BAR; PG8_SCHED;
            PG8_LDA(At, 1, 1); PG8_STAGE(PG8_SB(1, 0), b3, voffB); PG8_STAGE(PG8_SB(1, 1), b3 + hstep, voffB); PG8_STAGE(PG8_SA(1, 0), a3, voffA);
            PG8_WAIT_V(8); PG8_WAIT_L(0); PG8_BAR; PG8_MMA(1, 0, At, B0); PG8_MMA(1, 1, At, B1); PG8_BAR; PG8_SCHED;
            } else {
            PG8_LDB(B0, 0, 0); PG8_SCHED; PG8_LDA(At, 0, 0); PG8_STAGE(PG8_SA(1, 1), a1 + hstep, voffA);
            PG8_WAIT_L(8); PG8_BAR; PG8_WAIT_L(0); PG8_MMA(0, 0, At, B0); PG8_BAR; PG8_SCHED;
            PG8_LDB(B1, 0, 1); PG8_STAGE(PG8_SB(0, 0), b2, voffB);
            PG8_BAR; PG8_WAIT_L(0); PG8_MMA(0, 1, At, B1); PG8_BAR;
            PG8_LDA(At, 0, 1); PG8_STAGE(PG8_SA(0, 0), a2, voffA);
            PG8_BAR; PG8_WAIT_L(0); PG8_MMA(1, 0, At, B0); PG8_BAR; PG8_SCHED;
            PG8_STAGE(PG8_SB(0, 1), b2 + hstep, voffB);
            PG8_WAIT_V(6); PG8_BAR; PG8_MMA(1, 1, At, B1); PG8_BAR;
            PG8_LDB(B0, 1, 0); PG8_SCHED; PG8_LDA(At, 1, 0); PG8_STAGE(PG8_SA(0, 1), a2 + hstep, voffA);
            PG8_WAIT_L(8); PG8_BAR; PG8_WAIT_L(0); PG8_MMA(0, 0, At, B0); PG8_BAR; PG8_SCHED;
            PG8_LDB(B1, 1, 1); PG8_STAGE(PG8_SB(1, 0), b3, voffB);
            PG8_BAR; PG8_WAIT_L(0); PG8_MMA(0, 1, At, B1); PG8_BAR;
            PG8_LDA(At, 1, 1); PG8_STAGE(PG8_SA(1, 0), a3, voffA);
            PG8_BAR; PG8_WAIT_L(0); PG8_MMA(1, 0, At, B0); PG8_BAR; PG8_SCHED;
            PG8_STAGE(PG8_SB(1, 1), b3 + hstep, voffB);
            PG8_WAIT_V(6); PG8_BAR; PG8_MMA(1, 1, At, B1); PG8_BAR;
            }
        }
        if constexpr (ALIGN_EPI) { if (wr == 0) PG8_BAR; }
        if constexpr (!Epi::AFTER_DRAIN) { E(acc, cur, wr, wc, fr, fq); S.done(cur); }
        if (!has_next) break;
#pragma unroll
        for (int a = 0; a < 2; ++a)
#pragma unroll
            for (int b = 0; b < 2; ++b)
#pragma unroll
                for (int m = 0; m < 4; ++m)
#pragma unroll
                    for (int n = 0; n < 2; ++n) acc[a][b][m][n] = (f32x4){0.f, 0.f, 0.f, 0.f};
        cur = nxt; cA = nA; cB = nB; ++ui;
        if constexpr (ALIGN_EPI) { if (wr == 1) PG8_BAR; }
    }
    PG8_WAIT_V(0);
    if constexpr (!ALIGN_EPI) { if (wr == 0) PG8_BAR; }
    PG8_BAR;
    if constexpr (Epi::AFTER_DRAIN) { E.fused(acc, cur, wr, wc, fr, fq, lds, wid, lane); S.done(cur); }
#undef PG8_SA
#undef PG8_SB
#undef PG8_STAGE
#undef PG8_LDA
#undef PG8_LDB
#undef PG8_MMA
#undef PG8_WAIT_V
#undef PG8_WAIT_L
#undef PG8_BAR
#undef PG8_SCHED
}
}

#ifndef PG8_SP2
#define PG8_SP2 true
#endif
#ifndef PG8_ALIGN
#define PG8_ALIGN true
#endif
#include <hip/hip_bf16.h>
#include <cmath>
namespace attn_body {
using bf16=__hip_bfloat16;
using bf16x8=__attribute__((ext_vector_type(8)))short;
using s16x4=__attribute__((ext_vector_type(4)))short;
using f32x16=__attribute__((ext_vector_type(16)))float;
using u32x4=__attribute__((ext_vector_type(4)))unsigned;
constexpr int BATCH=16,NHEAD=16,SEQ=4096,D=64,DM=NHEAD*D;
constexpr int NW=8,QBLK=32,QB=QBLK*NW,KVBLK=64,NQB=SEQ/QB;
constexpr int ATTN_PITCH=DM, ATTN_UNIT_ROWS=QB;
__device__ __forceinline__ int crow(int r,int hi){return (r&3)+8*(r>>2)+4*hi;}
#define SBAR() __builtin_amdgcn_sched_barrier(0)
__device__ __forceinline__ void cmask(f32x16&p0,f32x16&p1,int jb,int qrel,int hi){
  const float NEG=-INFINITY; int kb=64*jb+4*hi;
  #pragma unroll
  for(int r=0;r<16;++r){int kv=kb+(r&3)+8*(r>>2); if(kv>qrel)p0[r]=NEG; if(kv+32>qrel)p1[r]=NEG;}
}

constexpr int NSLOT=3, SLOTB=8192;
constexpr int LDS_K=0, LDS_V=NSLOT*SLOTB, LDS_WS=2*NSLOT*SLOTB, LDS_OST=LDS_WS+NW*64*4, LDS_BYTES=LDS_OST+NW*4096;
constexpr float C2=0.125f*1.4426950408889634f;
__device__ __forceinline__ void glds16(const void*gsrc,unsigned lds_dst){unsigned keep;
  asm volatile("s_mov_b32 %0, m0\n\ts_mov_b32 m0, %2\n\ts_nop 0\n\tglobal_load_lds_dwordx4 %1, off\n\ts_mov_b32 m0, %0":"=&s"(keep):"v"(gsrc),"s"(lds_dst):"memory");}
__device__ __forceinline__ void glds16s(const void*sbase,unsigned voff,unsigned lds_dst){unsigned keep;
  asm volatile("s_mov_b32 %0, m0\n\ts_mov_b32 m0, %3\n\ts_nop 0\n\tglobal_load_lds_dwordx4 %1, %2\n\ts_mov_b32 m0, %0":"=&s"(keep):"v"(voff),"s"(sbase),"s"(lds_dst):"memory");}
__device__ __forceinline__ float max3f(float a,float b,float c){float r;asm("v_max3_f32 %0, %1, %2, %3":"=v"(r):"v"(a),"v"(b),"v"(c));return r;}
__device__ __forceinline__ float max2f(float a,float b){float r;asm("v_max_f32_e32 %0, %1, %2":"=v"(r):"v"(a),"v"(b));return r;}
__device__ __forceinline__ float fadd_s(float a,float b){float r;asm("v_add_f32_e32 %0, %1, %2":"=v"(r):"v"(a),"v"(b));return r;}
__device__ __forceinline__ float fsub_s(float a,float b){float r;asm("v_sub_f32_e32 %0, %1, %2":"=v"(r):"v"(a),"v"(b));return r;}
typedef float f32x2_t __attribute__((ext_vector_type(2))); typedef __bf16 bf16x2_t __attribute__((ext_vector_type(2)));
__device__ __forceinline__ unsigned cvtpk_s(float lo,float hi){f32x2_t v={lo,hi};bf16x2_t b=__builtin_convertvector(v,bf16x2_t);return __builtin_bit_cast(unsigned,b);}
#define WAIT_BAR(N) asm volatile("s_waitcnt vmcnt(" #N ") lgkmcnt(0)\n\ts_barrier":::"memory")

__device__ __forceinline__ void qkt(f32x16&p0,f32x16&p1,const char*Kslot,const bf16x8*qr,const f32x16&negm,int r32,int hi){
  const char*kb=Kslot+hi*1024+r32*16;
  #pragma unroll
  for(int d0=0;d0<4;++d0){
    const bf16x8 b0=*reinterpret_cast<const bf16x8*>(kb+d0*2048);
    const bf16x8 b1=*reinterpret_cast<const bf16x8*>(kb+d0*2048+512);
    if(d0==0){p0=__builtin_amdgcn_mfma_f32_32x32x16_bf16(b0,qr[0],negm,0,0,0);p1=__builtin_amdgcn_mfma_f32_32x32x16_bf16(b1,qr[0],negm,0,0,0);}
    else{p0=__builtin_amdgcn_mfma_f32_32x32x16_bf16(b0,qr[d0],p0,0,0,0);p1=__builtin_amdgcn_mfma_f32_32x32x16_bf16(b1,qr[d0],p1,0,0,0);}}
}
typedef __attribute__((address_space(3))) const char* lds_cptr;
typedef short v4i16_t __attribute__((ext_vector_type(4)));
__device__ __forceinline__ void kload8(bf16x8*kf,lds_cptr kp){
  kf[0]=*(const __attribute__((address_space(3))) bf16x8*)(kp);      kf[1]=*(const __attribute__((address_space(3))) bf16x8*)(kp+512);
  kf[2]=*(const __attribute__((address_space(3))) bf16x8*)(kp+2048); kf[3]=*(const __attribute__((address_space(3))) bf16x8*)(kp+2560);
  kf[4]=*(const __attribute__((address_space(3))) bf16x8*)(kp+4096); kf[5]=*(const __attribute__((address_space(3))) bf16x8*)(kp+4608);
  kf[6]=*(const __attribute__((address_space(3))) bf16x8*)(kp+6144); kf[7]=*(const __attribute__((address_space(3))) bf16x8*)(kp+6656);
}
__device__ __forceinline__ void kload2(bf16x8*kf,lds_cptr kp,int j){ kf[2*j]=*(const __attribute__((address_space(3))) bf16x8*)(kp+j*2048); kf[2*j+1]=*(const __attribute__((address_space(3))) bf16x8*)(kp+j*2048+512); }
__device__ __forceinline__ s16x4 vtr(lds_cptr p){ return __builtin_bit_cast(s16x4,__builtin_amdgcn_ds_read_tr16_b64_v4i16((__attribute__((address_space(3))) v4i16_t*)p)); }
__device__ __forceinline__ float rowmax(const f32x16&p0,const f32x16&p1){
  float a=max3f(p0[0],p0[1],p1[0]),b=max3f(p0[2],p0[3],p1[1]);a=max3f(a,p1[2],p1[3]);
  #pragma unroll
  for(int r=4;r<16;r+=4){a=max3f(a,p0[r],p0[r+1]);b=max3f(b,p0[r+2],p0[r+3]);a=max3f(a,p1[r],p1[r+1]);b=max3f(b,p1[r+2],p1[r+3]);}
  const float m=max2f(a,b);
  auto rr=__builtin_amdgcn_permlane32_swap(__float_as_uint(m),__float_as_uint(m),false,false);
  return max2f(__uint_as_float(rr[0]),__uint_as_float(rr[1]));
}
__device__ __forceinline__ void pv(f32x16*o,int vb,bf16x8 pa0,bf16x8 pa1,bf16x8 pa2,bf16x8 pa3){
  #pragma unroll
  for(int d0=0;d0<2;++d0){s16x4 lo[4],hi[4];
    #pragma unroll
    for(int ks=0;ks<4;++ks){
      asm volatile("ds_read_b64_tr_b16 %0,%1 offset:%c2":"=&v"(lo[ks]):"v"(vb),"i"(d0*4096+ks*1024):"memory");
      asm volatile("ds_read_b64_tr_b16 %0,%1 offset:%c2":"=&v"(hi[ks]):"v"(vb),"i"(d0*4096+ks*1024+512):"memory");}
    asm volatile("s_waitcnt lgkmcnt(0)":::"memory");SBAR();
    #define PK(k) (bf16x8){lo[k][0],lo[k][1],lo[k][2],lo[k][3],hi[k][0],hi[k][1],hi[k][2],hi[k][3]}
    o[d0]=__builtin_amdgcn_mfma_f32_32x32x16_bf16(pa0,PK(0),o[d0],0,0,0);
    o[d0]=__builtin_amdgcn_mfma_f32_32x32x16_bf16(pa1,PK(1),o[d0],0,0,0);
    o[d0]=__builtin_amdgcn_mfma_f32_32x32x16_bf16(pa2,PK(2),o[d0],0,0,0);
    o[d0]=__builtin_amdgcn_mfma_f32_32x32x16_bf16(pa3,PK(3),o[d0],0,0,0);
    #undef PK
  }
}

#ifndef ATTN_STORE16
#define ATTN_STORE16(p,v) (*(u32x4*)(p)=(v))
#endif
typedef const __attribute__((address_space(3))) float* lds_cf32;
typedef float f32x4_t __attribute__((ext_vector_type(4)));
template<int THRL> __device__ __forceinline__ void attn_unit(int b,int h,int qb,const bf16*Q,const bf16*__restrict__ K,const bf16*__restrict__ V,bf16*O,const bf16*__restrict__ G,lds_cf32 cs,char*shm){
  int tid=threadIdx.x; asm volatile("":"+v"(tid));   const int lane=tid&63,r32=lane&31,hi=lane>>5; const int wid=__builtin_amdgcn_readfirstlane(tid>>6);
  const long rowbase=(long)b*SEQ; const int q0=qb*QB;
  const bf16*Qw=Q+(rowbase+q0+wid*QBLK)*DM+h*D;
  const bf16*Kh=K+rowbase*DM+h*D,*Vh=V+rowbase*DM+h*D;
  const unsigned lds0=(unsigned)(uintptr_t)shm;
  float*wsf=(float*)(shm+LDS_WS)+wid*64;
  const unsigned kvoff=(unsigned)((lane*DM+wid*8)*2);
  const unsigned vvoff=(unsigned)(((16*(wid&3)+(lane>>2))*DM+(wid>>2)*32+(lane&3)*8)*2);
  const unsigned kdst=lds0+LDS_K+wid*1024, vdst=lds0+LDS_V+wid*1024;
  #define DMA_K(t,slot) glds16s(Kh+(long)(t)*KVBLK*DM,kvoff,(unsigned)__builtin_amdgcn_readfirstlane(kdst+(slot)))
  #define DMA_V(t,slot) glds16s(Vh+(long)(t)*KVBLK*DM,vvoff,(unsigned)__builtin_amdgcn_readfirstlane(vdst+(slot)))
  const int vb0=(int)(lds0+LDS_V)+((lane>>4)&1)*32+(lane&3)*8+(4*hi+((lane&15)>>2))*64;
  const char*Kbase=shm+LDS_K; bf16x8 kf[8];
  const lds_cptr shm3=(lds_cptr)shm; const lds_cptr kp0=shm3+LDS_K+hi*1024+r32*16; const lds_cptr vp0=shm3+LDS_V+((lane>>4)&1)*32+(lane&3)*8+(4*hi+((lane&15)>>2))*64;
  const int NT=(q0+QB)/KVBLK;
  DMA_K(0,0);DMA_V(0,0);DMA_K(1,SLOTB);
  bf16x8 qr[4];
  #pragma unroll
  for(int d0=0;d0<4;++d0)qr[d0]=*reinterpret_cast<const bf16x8*>(&Qw[(long)r32*DM+d0*16+hi*8]);
  const int qrel=wid*QBLK+r32;
  #define ct2 (cs[q0+qrel])
  float mhat=0.f,l_reg=0.f;f32x16 o[2];o[0]=f32x16{};o[1]=f32x16{};f32x16 negm;
  _Pragma("unroll") for(int r=0;r<16;++r)negm[r]=ct2; asm volatile("":"+v"(negm));
  #define KBIAS(P0,P1,t) do{ const __attribute__((address_space(3))) f32x4_t* cb_=(const __attribute__((address_space(3))) f32x4_t*)(cs+64*(t)); \
    _Pragma("unroll") for(int g_=0;g_<4;++g_){ const f32x4_t a_=cb_[2*g_+hi], b_=cb_[8+2*g_+hi]; \
      P0[4*g_+0]-=a_[0];P0[4*g_+1]-=a_[1];P0[4*g_+2]-=a_[2];P0[4*g_+3]-=a_[3]; P1[4*g_+0]-=b_[0];P1[4*g_+1]-=b_[1];P1[4*g_+2]-=b_[2];P1[4*g_+3]-=b_[3]; } }while(0)
  #define CMASK(P0,P1,t) do{int jb_=(t)-(NT-4); if(jb_>=0)cmask(P0,P1,jb_,qrel,hi);}while(0)
  bool resc=false;
  #define START(P0,P1) do{ const float rm=rowmax(P0,P1); resc=false; \
    { const float dl=rm; mhat=fadd_s(mhat,dl); \
      _Pragma("unroll") for(int r=0;r<16;++r){P0[r]=fsub_s(P0[r],dl);P1[r]=fsub_s(P1[r],dl);} \
      _Pragma("unroll") for(int r=0;r<16;++r)negm[r]=ct2-mhat; asm volatile("":"+v"(negm)); } \
    _Pragma("unroll") for(int r=0;r<16;++r)P0[r]=__builtin_amdgcn_exp2f(P0[r]); }while(0)
  #define RESC() do{ if(resc){ asm volatile("s_waitcnt lgkmcnt(0)":::"memory"); \
      _Pragma("unroll") for(int d_=0;d_<2;++d_) _Pragma("unroll") for(int r=0;r<16;++r)o[d_][r]*=wsf[crow(r,hi)]; } }while(0)
  f32x16 pA0,pA1,pB0,pB1;
  int sl_prev=0,sl_cur=0,sl_next=SLOTB;
  #define ROT() do{sl_prev=sl_cur;sl_cur=sl_next;sl_next=(sl_next==(NSLOT-1)*SLOTB)?0:sl_next+SLOTB;}while(0)
  DMA_K(2,2*SLOTB);
  WAIT_BAR(3);
  qkt(pA0,pA1,Kbase,qr,negm,r32,hi);asm volatile("s_nop 15\n\ts_nop 7":"+v"(pA0),"+v"(pA1));KBIAS(pA0,pA1,0);CMASK(pA0,pA1,0);
  START(pA0,pA1);
  _Pragma("unroll") for(int r=0;r<16;++r)pA1[r]=__builtin_amdgcn_exp2f(pA1[r]);
  WAIT_BAR(0);
  DMA_K(3,0);DMA_V(1,SLOTB);
  ROT();
  kload8(kf,kp0+sl_cur);
  WAIT_BAR(2);
  s16x4 vlo[8],vhi[8]; u32x4 pw0,pw1,pw2,pw3;
  #define PKW(P,B) cvtpk_s(P[B],P[B+1])
  #define PAF(k) __builtin_bit_cast(bf16x8,pw##k)
  #define VFR(i) (bf16x8){vlo[i][0],vlo[i][1],vlo[i][2],vlo[i][3],vhi[i][0],vhi[i][1],vhi[i][2],vhi[i][3]}
  #define PIN(x) asm volatile("":"+v"(x))
  #define MX3(a,b,c) __builtin_fmaxf(__builtin_fmaxf((a),(b)),(c))
  #define GAPA(MF,A0,A1,A2,A3,W0,W1,PW) do{ MF; sacc+=A0; sacc+=A1; sacc+=A2; sacc+=A3; PIN(sacc); W0; W1; PIN(PW); SBAR(); }while(0)
  #define EX(v) __builtin_amdgcn_exp2f(v)
  #define GAPB(MF,X,B) do{ MF; X[B]=EX(X[B]); X[B+1]=EX(X[B+1]); X[B+2]=EX(X[B+2]); X[B+3]=EX(X[B+3]); PIN(X); SBAR(); }while(0)
  #define VRD(i) do{ vlo[i]=vtr(vp_+(((i)>>2)*4096+((i)&3)*1024)); vhi[i]=vtr(vp_+(((i)>>2)*4096+((i)&3)*1024+512)); }while(0)
  #define KRD(G,j) do{ if(G){ kload2(kf,kp0+sl_next,j); SBAR(); } }while(0)
  #define STEP(C0,C1,P0,P1,t,GK,GV,GL) do{ SBAR(); \
    const lds_cptr vp_=vp0+sl_prev; \
    VRD(0); SBAR(); float sacc=(P0[0]+P0[1]); \
    GAPA(C0=__builtin_amdgcn_mfma_f32_32x32x16_bf16(kf[0],qr[0],negm,0,0,0), P0[2],P0[3],P0[4],P0[5],     pw0[0]=PKW(P0,0), pw0[1]=PKW(P0,2), pw0); \
    VRD(4); SBAR(); GAPA(C1=__builtin_amdgcn_mfma_f32_32x32x16_bf16(kf[1],qr[0],negm,0,0,0), P0[6],P0[7],P0[8],P0[9],     pw0[2]=PKW(P0,4), pw0[3]=PKW(P0,6), pw0); \
    VRD(1); SBAR(); GAPA(C0=__builtin_amdgcn_mfma_f32_32x32x16_bf16(kf[2],qr[1],C0,0,0,0),   P0[10],P0[11],P0[12],P0[13], pw1[0]=PKW(P0,8), pw1[1]=PKW(P0,10), pw1); \
    VRD(5); SBAR(); GAPA(C1=__builtin_amdgcn_mfma_f32_32x32x16_bf16(kf[3],qr[1],C1,0,0,0),   P0[14],P0[15],P1[0],P1[1],   pw1[2]=PKW(P0,12),pw1[3]=PKW(P0,14), pw1); \
    VRD(2); SBAR(); GAPA(C0=__builtin_amdgcn_mfma_f32_32x32x16_bf16(kf[4],qr[2],C0,0,0,0),   P1[2],P1[3],P1[4],P1[5],     pw2[0]=PKW(P1,0), pw2[1]=PKW(P1,2), pw2); \
    VRD(6); SBAR(); GAPA(C1=__builtin_amdgcn_mfma_f32_32x32x16_bf16(kf[5],qr[2],C1,0,0,0),   P1[6],P1[7],P1[8],P1[9],     pw2[2]=PKW(P1,4), pw2[3]=PKW(P1,6), pw2); \
    VRD(3); SBAR(); GAPA(C0=__builtin_amdgcn_mfma_f32_32x32x16_bf16(kf[6],qr[3],C0,0,0,0),   P1[10],P1[11],P1[12],P1[13], pw3[0]=PKW(P1,8), pw3[1]=PKW(P1,10), pw3); \
    VRD(7); SBAR(); GAPA(C1=__builtin_amdgcn_mfma_f32_32x32x16_bf16(kf[7],qr[3],C1,0,0,0),   P1[14],P1[15],0.f,0.f,       pw3[2]=PKW(P1,12),pw3[3]=PKW(P1,14), pw3); \
    l_reg+=sacc; \
    if(GK){DMA_K((t)+3,sl_cur);} if(GV){DMA_V((t)+1,sl_next);} \
    KBIAS(C0,C1,t); CMASK(C0,C1,t); \
    { float a=MX3(C0[0],C0[1],C1[0]),b=MX3(C0[2],C0[3],C1[1]); a=MX3(a,C1[2],C1[3]); \
      _Pragma("unroll") for(int r=4;r<16;r+=4){a=MX3(a,C0[r],C0[r+1]);b=MX3(b,C0[r+2],C0[r+3]);a=MX3(a,C1[r],C1[r+1]);b=MX3(b,C1[r+2],C1[r+3]);} \
      float rm=__builtin_fmaxf(a,b); { auto rr=__builtin_amdgcn_permlane32_swap(__float_as_uint(rm),__float_as_uint(rm),false,false); rm=__builtin_fmaxf(__uint_as_float(rr[0]),__uint_as_float(rr[1])); } \
      resc=false; \
      if(__builtin_expect(__any(rm>(float)THRL),0)){ const float dl=__builtin_fmaxf(rm,0.f); mhat+=dl; \
        _Pragma("unroll") for(int r=0;r<16;++r){C0[r]-=dl;C1[r]-=dl;} \
        _Pragma("unroll") for(int r=0;r<16;++r)negm[r]=ct2-mhat; asm volatile("":"+v"(negm)); \
        const float f=__builtin_amdgcn_exp2f(-dl); l_reg*=f; if(hi==0)wsf[r32]=f; resc=true; } } \
    SBAR(); \
    GAPB(o[0]=__builtin_amdgcn_mfma_f32_32x32x16_bf16(PAF(0),VFR(0),o[0],0,0,0), C0,0); \
    GAPB(o[1]=__builtin_amdgcn_mfma_f32_32x32x16_bf16(PAF(0),VFR(4),o[1],0,0,0), C0,4); \
    KRD(GL,0); GAPB(o[0]=__builtin_amdgcn_mfma_f32_32x32x16_bf16(PAF(1),VFR(1),o[0],0,0,0), C0,8); \
    KRD(GL,1); GAPB(o[1]=__builtin_amdgcn_mfma_f32_32x32x16_bf16(PAF(1),VFR(5),o[1],0,0,0), C0,12); \
    KRD(GL,2); GAPB(o[0]=__builtin_amdgcn_mfma_f32_32x32x16_bf16(PAF(2),VFR(2),o[0],0,0,0), C1,0); \
    KRD(GL,3); GAPB(o[1]=__builtin_amdgcn_mfma_f32_32x32x16_bf16(PAF(2),VFR(6),o[1],0,0,0), C1,4); \
    GAPB(o[0]=__builtin_amdgcn_mfma_f32_32x32x16_bf16(PAF(3),VFR(3),o[0],0,0,0), C1,8); \
    GAPB(o[1]=__builtin_amdgcn_mfma_f32_32x32x16_bf16(PAF(3),VFR(7),o[1],0,0,0), C1,12); \
    }while(0)
  int t=1;
  #undef CMASK
  #define CMASK(P0,P1,t) do{}while(0)
  for(;t+5<NT;t+=2){
    STEP(pB0,pB1,pA0,pA1,t,true,true,true);     WAIT_BAR(2); RESC(); ROT();
    STEP(pA0,pA1,pB0,pB1,t+1,true,true,true);   WAIT_BAR(2); RESC(); ROT();
  }
  #undef CMASK
  #define CMASK(P0,P1,t) do{int jb_=(t)-(NT-4); if(jb_>=0)cmask(P0,P1,jb_,qrel,hi);}while(0)
  #define ENDW(tt) do{ if((tt)+3<NT){WAIT_BAR(2);} else if((tt)+2<NT){WAIT_BAR(1);} else {WAIT_BAR(0);} }while(0)
  for(;t+1<NT;t+=2){
    STEP(pB0,pB1,pA0,pA1,t,(t+3<NT),(t+1<NT),(t+1<NT));       ENDW(t);   RESC(); ROT();
    STEP(pA0,pA1,pB0,pB1,t+1,(t+4<NT),(t+2<NT),(t+2<NT));     ENDW(t+1); RESC(); ROT();
  }
  STEP(pB0,pB1,pA0,pA1,NT-1,false,false,false); RESC();
  { float sacc=pB0[0]+pB0[1]; _Pragma("unroll") for(int r=2;r<16;++r)sacc+=pB0[r]; _Pragma("unroll") for(int r=0;r<16;++r)sacc+=pB1[r]; l_reg+=sacc;
    pw0=(u32x4){PKW(pB0,0),PKW(pB0,2),PKW(pB0,4),PKW(pB0,6)};pw1=(u32x4){PKW(pB0,8),PKW(pB0,10),PKW(pB0,12),PKW(pB0,14)};pw2=(u32x4){PKW(pB1,0),PKW(pB1,2),PKW(pB1,4),PKW(pB1,6)};pw3=(u32x4){PKW(pB1,8),PKW(pB1,10),PKW(pB1,12),PKW(pB1,14)};
    SBAR(); pv(o,vb0+sl_cur,PAF(0),PAF(1),PAF(2),PAF(3)); }
  #undef PKW
  #undef PAF
  #undef VFR
  #undef PIN
  #undef MX3
  #undef GAPA
  #undef GAPB
  #undef EX
  #undef VRD
  #undef KRD
  #undef STEP
  #undef ENDW
  {auto rr=__builtin_amdgcn_permlane32_swap(__float_as_uint(l_reg),__float_as_uint(l_reg),false,false);l_reg=__uint_as_float(rr[0])+__uint_as_float(rr[1]);}
  int lane_e=lane; asm volatile("":"+v"(lane_e)); const int r32e=lane_e&31,hie=lane_e>>5;
  if(hie==0)wsf[32+r32e]=l_reg;asm volatile("s_waitcnt lgkmcnt(0)":::"memory");
  float rli[16];
  #pragma unroll
  for(int r=0;r<16;++r)rli[r]=__builtin_amdgcn_rcpf(wsf[32+crow(r,hie)]);
  bf16*Ow=O+(rowbase+q0+wid*QBLK)*DM+h*D;
  { bf16*stg=(bf16*)(shm+LDS_OST)+wid*2048;
    #pragma unroll
    for(int r=0;r<16;++r){const int orow=crow(r,hie);
      #pragma unroll
      for(int d0=0;d0<2;++d0)stg[orow*64+d0*32+r32e]=__float2bfloat16(o[d0][r]*rli[r]);}
    asm volatile("s_waitcnt lgkmcnt(0)":::"memory");
    const bf16*Gw=G+(rowbase+q0+wid*QBLK)*DM+h*D;
    #pragma unroll
    for(int i=0;i<4;++i){const int row=i*8+(lane_e>>3),ch=lane_e&7; const u32x4 v=*(const u32x4*)(stg+row*64+ch*8); const u32x4 gv=*(const u32x4*)(Gw+(long)row*DM+ch*8); u32x4 w;
      #pragma unroll
      for(int e=0;e<4;++e){ const float o0=__uint_as_float(v[e]<<16),o1=__uint_as_float(v[e]&0xffff0000u),g0=__uint_as_float(gv[e]<<16),g1=__uint_as_float(gv[e]&0xffff0000u);
        const float s0=__builtin_amdgcn_rcpf(1.f+__builtin_amdgcn_exp2f(-1.4426950408889634f*g0)),s1=__builtin_amdgcn_rcpf(1.f+__builtin_amdgcn_exp2f(-1.4426950408889634f*g1)); w[e]=cvtpk_s(o0*s0,o1*s1); }
      ATTN_STORE16(Ow+(long)row*DM+ch*8,w);} }
  asm volatile("s_waitcnt lgkmcnt(0)\n\ts_barrier":::"memory");
  #undef KBIAS
  #undef ct2
  #undef DMA_K
  #undef DMA_V
  #undef CMASK
  #undef START
  #undef RESC
  #undef ROT
}
constexpr int ATTN_LDS_BYTES=LDS_BYTES;
struct AttnTensors { const bf16* Q; const bf16* K; const bf16* V; bf16* O; const bf16* G; };
struct AttnUnit { int bh; int qb; };
#undef SBAR
#undef WAIT_BAR
}
#define GAS __attribute__((address_space(1)))
#define LAS __attribute__((address_space(3)))
typedef unsigned short bf16;
typedef unsigned v4u __attribute__((ext_vector_type(4)));
typedef float f32x4 __attribute__((ext_vector_type(4)));
typedef short bf16x8 __attribute__((ext_vector_type(8)));
typedef GAS unsigned gu32;
typedef GAS unsigned long long gu64;
#define RLX_AGENT __ATOMIC_RELAXED, __HIP_MEMORY_SCOPE_AGENT
#define LDS_WAIT() asm volatile("s_waitcnt lgkmcnt(0)" ::: "memory")
#define VM_WAIT() asm volatile("s_waitcnt vmcnt(0)" ::: "memory")
__device__ __forceinline__ unsigned long long rt() { return __builtin_amdgcn_s_memrealtime(); }
__device__ __forceinline__ unsigned f2bf(float f) { unsigned u = __builtin_bit_cast(unsigned, f); return (u + 0x7fffu + ((u >> 16) & 1u)) >> 16; }
__device__ __forceinline__ unsigned pk2(float lo, float hi) { return f2bf(lo) | (f2bf(hi) << 16); }

#define XB_TMO      128
#define XB_XCNT(j)  (256  + 64 * (j))
#define XB_XSUB(j)  (1280 + 64 * (j))
#define XB_XGEN(j)  (2304 + 64 * (j))
#define XB_TOP      3328
#define XB_TOPGEN   3392
#define XCD_BAR_WORDS 3456
#define XB_SPIN_CAP (1u << 18)

__device__ __forceinline__ unsigned xb_ld(unsigned* p)              { return __hip_atomic_load(p, __ATOMIC_RELAXED, __HIP_MEMORY_SCOPE_AGENT); }
__device__ __forceinline__ unsigned xb_add(unsigned* p, unsigned v) { return __hip_atomic_fetch_add(p, v, __ATOMIC_RELAXED, __HIP_MEMORY_SCOPE_AGENT); }
__device__ __forceinline__ unsigned xb_xcc_id() { return (unsigned)__builtin_amdgcn_s_getreg((3 << 11) | 20) & 0xFu; }
#define XB_SPIN(cond, bar) do { unsigned _sp = 0; while (cond) { __builtin_amdgcn_s_sleep(1); \
    if ((++_sp & 255u) == 0u) { if (xb_ld(&(bar)[XB_TMO])) break; if (_sp > XB_SPIN_CAP) { atomicAdd(&(bar)[XB_TMO], 1u); break; } } } } while (0)

struct XcdBarrier {
    unsigned* bar; unsigned x;
    volatile LAS unsigned* st;
};

__device__ __forceinline__ XcdBarrier xcd_barrier_post(unsigned* bar, volatile LAS unsigned* st) {
    XcdBarrier b; b.bar = bar; b.x = xb_xcc_id(); b.st = st;
    if (threadIdx.x == 0) (void)xb_add(&bar[XB_XCNT(b.x)], 1u);
    return b;
}
__device__ __forceinline__ void xcd_barrier_complete(unsigned* bar, unsigned x, unsigned& nloc, unsigned& nx) {
    const unsigned G = gridDim.x * gridDim.y * gridDim.z;
    unsigned sum, cnt, mine, sp = 0u;
    for (;;) {
        sum = 0u; cnt = 0u; mine = 0u;
#pragma unroll
        for (unsigned j = 0; j < 16; ++j) { const unsigned c = xb_ld(&bar[XB_XCNT(j)]); sum += c; cnt += (c > 0u) ? 1u : 0u; mine = (j == x) ? c : mine; }
        if (sum == G) break;
        __builtin_amdgcn_s_sleep(1);
        if ((++sp & 255u) == 0u) { if (xb_ld(&bar[XB_TMO])) break; if (sp > XB_SPIN_CAP) { atomicAdd(&bar[XB_TMO], 1u); break; } }
    }
    nloc = mine > 0u ? mine : 1u; nx = cnt > 0u ? cnt : 1u;
}

__device__ __forceinline__ void xcd_barrier(const XcdBarrier& b) {
    asm volatile("s_waitcnt vmcnt(0)" ::: "memory");
    __syncthreads();
    if (threadIdx.x == 0) {
        unsigned* bar = b.bar;
        __builtin_amdgcn_s_waitcnt(0);
        unsigned nloc = b.st[0], nx = b.st[1];
        if (nloc == 0u) { xcd_barrier_complete(bar, b.x, nloc, nx); b.st[0] = nloc; b.st[1] = nx; }
        const unsigned old = xb_add(&bar[XB_XSUB(b.x)], 1u);
        const unsigned gen = old / nloc;
        if (old + 1u == (gen + 1u) * nloc) {
            __builtin_amdgcn_fence(__ATOMIC_RELEASE, "agent");
            asm volatile("s_waitcnt vmcnt(0)" ::: "memory");
            const unsigned og = xb_add(&bar[XB_TOP], 1u);
            const unsigned tg = og / nx;
            if (og + 1u == (tg + 1u) * nx) xb_add(&bar[XB_TOPGEN], 1u);
            else XB_SPIN(xb_ld(&bar[XB_TOPGEN]) == tg, bar);
            __builtin_amdgcn_fence(__ATOMIC_ACQUIRE, "agent");
            xb_add(&bar[XB_XGEN(b.x)], 1u);
            asm volatile("s_waitcnt vmcnt(0)" ::: "memory");
        } else {
            XB_SPIN(xb_ld(&bar[XB_XGEN(b.x)]) == gen, bar);
            __builtin_amdgcn_fence(__ATOMIC_ACQUIRE, "agent");
            asm volatile("s_waitcnt vmcnt(0)" ::: "memory");
        }
    }
    __syncthreads();
}

constexpr int NWAVES = 8;
constexpr int BATCH = 16, SEQ = 4096, D = 1024, M = BATCH * SEQ;
constexpr int MH = 8, DK = 64, DV = 128, LCH = 64, NCH = SEQ / LCH;
constexpr int MIN_N = 3088, MIN_NP = 3328, MIN_LD = 3072;
constexpr int FH = 16;
constexpr int DFF = 2816, DFF2 = 5632;
constexpr int KV_N = 2064, KV_NP = 2304;
constexpr int MHALF = M / 2;
constexpr float EPS = 1e-6f;
constexpr float LOG2E = 1.4426950408889634f;

constexpr size_t MiB = 1u << 20;
constexpr size_t WS_CTL = 0, CTL_ZERO_BYTES = 1 * MiB;
constexpr size_t WS_GATES = 2 * MiB;
constexpr size_t WS_W = 8 * MiB;
constexpr size_t SZ_WIN = (size_t)MIN_NP * D * 2, SZ_SQ = (size_t)D * D * 2, SZ_WKV = (size_t)KV_NP * D * 2, SZ_WQG = (size_t)2 * D * D * 2, SZ_WUP = (size_t)DFF2 * D * 2, SZ_WDN = (size_t)D * DFF * 2;
constexpr size_t WS_WIN = WS_W, WS_WMOUT = WS_WIN + 2 * SZ_WIN, WS_WKV = WS_WMOUT + 2 * SZ_SQ, WS_WQG = WS_WKV + SZ_WKV, WS_WFOUT = WS_WQG + 2 * SZ_WQG,
                 WS_WUP = WS_WFOUT + 2 * SZ_SQ, WS_WDN = WS_WUP + 4 * SZ_WUP, WS_WEND = WS_WDN + 4 * SZ_WDN;
constexpr size_t WS_XH = 112 * MiB;
constexpr size_t WS_KB = 240 * MiB, WS_VB = 368 * MiB;
constexpr size_t WS_S = 496 * MiB;
constexpr size_t WS_QKVO = WS_S, WS_HA = WS_S + 384 * MiB;
constexpr size_t WS_FQ = WS_S, WS_FG = WS_S + 128 * MiB;
constexpr size_t WS_U = WS_S, WS_ACT = WS_S + 352 * MiB;
constexpr size_t WS_END = 1024 * MiB;
static_assert(WS_WEND <= WS_XH && WS_ACT + (size_t)MHALF * DFF * 2 <= WS_END && WS_HA + (size_t)M * D * 2 <= WS_END, "d_ws map");
constexpr int CW_TMO = 0, CW_BAR = 4096;

constexpr int RING_OFF = 0, RING_BYTES = 131072;
constexpr int LDSCTL_OFF = RING_BYTES, MISC_OFF = LDSCTL_OFF + 320;
constexpr int LDS_BYTES = 147456;

__device__ __forceinline__ float wave_sum(float v) {
#pragma unroll
    for (int o = 1; o < 64; o <<= 1) v += __shfl_xor(v, o);
    return v;
}
__device__ __forceinline__ float bf_lo(unsigned w) { return __uint_as_float(w << 16); }
__device__ __forceinline__ float bf_hi(unsigned w) { return __uint_as_float(w & 0xffff0000u); }
__device__ __forceinline__ unsigned cvtpk(float lo, float hi) { typedef float f2 __attribute__((ext_vector_type(2))); typedef __bf16 b2 __attribute__((ext_vector_type(2))); f2 v = {lo, hi}; b2 b = __builtin_convertvector(v, b2); return __builtin_bit_cast(unsigned, b); }
#define BAR_LDS() do { asm volatile("s_waitcnt lgkmcnt(0)" ::: "memory"); __builtin_amdgcn_s_barrier(); asm volatile("" ::: "memory"); } while (0)

namespace pg8 {
struct EpiOut {
    static constexpr bool PERM = true, AFTER_DRAIN = false;
    bf16_t* O; int ldc; int split_cols; size_t split_stride; float scale0; int gate_tile; float* Gt;
    __device__ __forceinline__ void operator()(const f32x4 (&acc)[2][2][4][2], const Unit& u, int wr, int wc, int fr, int fq) const {
        const int row0 = u.pm * BM + wr * 64 + fr;
        if (u.pn == gate_tile) {
            if (wc == 0 && fq < 2) {
#pragma unroll
                for (int ai = 0; ai < 2; ++ai)
#pragma unroll
                    for (int m = 0; m < 4; ++m) { GAS float* gp = (GAS float*)Gt + (size_t)(row0 + ai * HALF + m * 16) * 16 + 8 * fq; *(GAS f32x4*)gp = acc[ai][0][m][0]; *(GAS f32x4*)(gp + 4) = acc[ai][0][m][1]; }
            }
            return;
        }
        int colt = u.pn * BM; bf16_t* base = O; float sc = 1.f;
        if (split_cols) { const int t = colt / split_cols; base += (size_t)t * split_stride; colt -= t * split_cols; if (t == 0) sc = scale0; }
        const int col0 = colt + wc * 32 + 8 * fq;
#pragma unroll
        for (int ai = 0; ai < 2; ++ai)
#pragma unroll
            for (int m = 0; m < 4; ++m) { bf16_t* rowp = base + (size_t)(row0 + ai * HALF + m * 16) * ldc + col0;
#pragma unroll
                for (int bj = 0; bj < 2; ++bj) { const f32x4 v0 = acc[ai][bj][m][0] * sc, v1 = acc[ai][bj][m][1] * sc;
                    u32x4 w; w.x = cvt_pk_bf16(v0[0], v0[1]); w.y = cvt_pk_bf16(v0[2], v0[3]); w.z = cvt_pk_bf16(v1[0], v1[1]); w.w = cvt_pk_bf16(v1[2], v1[3]);
                    *(u32x4*)(rowp + bj * HALF) = w; } }
    }
};
}

__device__ __forceinline__ void wt_item(const float* W, int Ns, const float* gain, bf16* WT, int Kd, int dst_row0, int k0, int n0, LAS float* scr, int lane) {
    const int nn = lane & 31; const bool inb = (n0 + nn) < Ns;
#pragma unroll 8
    for (int i = 0; i < 32; ++i) { const int kk = 2 * i + (lane >> 5); float v = inb ? W[(size_t)(k0 + kk) * Ns + n0 + nn] : 0.f; if (gain) v *= gain[k0 + kk]; scr[kk * 33 + nn] = v; }
    LDS_WAIT(); asm volatile("" ::: "memory");
    const int c = lane & 7;
#pragma unroll
    for (int j = 0; j < 4; ++j) { const int n = (lane >> 3) + 8 * j; const LAS float* s = scr + (8 * c) * 33 + n;
        v4u o; o.x = cvtpk(s[0 * 33], s[1 * 33]); o.y = cvtpk(s[2 * 33], s[3 * 33]); o.z = cvtpk(s[4 * 33], s[5 * 33]); o.w = cvtpk(s[6 * 33], s[7 * 33]);
        *(GAS v4u*)(WT + (size_t)(dst_row0 + n) * Kd + k0 + 8 * c) = o; }
    LDS_WAIT(); asm volatile("" ::: "memory");
}
struct Ins { const float* p[18]; };
__device__ __forceinline__ void prologue_weights(const Ins& in, unsigned char* ws, LAS unsigned char* lds, int gw, int NGW, int wave, int lane) {
    LAS float* scr = (LAS float*)(lds + RING_OFF + wave * 16384);
    constexpr int I_IN = 16 * (MIN_NP / 32), I_SQ = 16 * 32, I_KV = 16 * (KV_NP / 32), I_QG = 16 * 64, I_UP = 16 * (DFF2 / 32), I_DN = (DFF / 64) * 32;
    constexpr int E0 = 2 * I_IN, E1 = E0 + 2 * I_SQ, E2 = E1 + I_KV, E3 = E2 + 2 * I_QG, E4 = E3 + 2 * I_SQ, E5 = E4 + 4 * I_UP, E6 = E5 + 4 * I_DN;
    for (int it = gw; it < E6; it += NGW) {
        const float* W; const float* gain = nullptr; bf16* WT; int Ns, Kd = D, nblk, r, kind = 0;
        if (it < E0)      { r = it;      const int L = r / I_IN; r -= L * I_IN; W = in.p[5] + (size_t)L * D * MIN_N; gain = in.p[1] + L * D; WT = (bf16*)(ws + WS_WIN + L * SZ_WIN); Ns = MIN_N; nblk = MIN_NP / 32; }
        else if (it < E1) { r = it - E0; const int L = r / I_SQ; r -= L * I_SQ; W = in.p[8] + (size_t)L * D * D; WT = (bf16*)(ws + WS_WMOUT + L * SZ_SQ); Ns = D; nblk = 32; }
        else if (it < E2) { r = it - E1; W = in.p[10]; gain = in.p[9]; WT = (bf16*)(ws + WS_WKV); Ns = KV_N; nblk = KV_NP / 32; }
        else if (it < E3) { r = it - E2; const int L = r / I_QG; r -= L * I_QG; W = in.p[12] + (size_t)L * D * 2 * D; gain = in.p[1] + (2 + L) * D; WT = (bf16*)(ws + WS_WQG + L * SZ_WQG); Ns = 2 * D; nblk = 64; }
        else if (it < E4) { r = it - E3; const int L = r / I_SQ; r -= L * I_SQ; W = in.p[13] + (size_t)L * D * D; WT = (bf16*)(ws + WS_WFOUT + L * SZ_SQ); Ns = D; nblk = 32; }
        else if (it < E5) { r = it - E4; const int L = r / I_UP; r -= L * I_UP; W = in.p[14] + (size_t)L * D * DFF2; gain = in.p[3] + L * D; WT = (bf16*)(ws + WS_WUP + L * SZ_WUP); Ns = DFF2; nblk = DFF2 / 32; kind = 1; }
        else              { r = it - E5; const int L = r / I_DN; r -= L * I_DN; W = in.p[17] + (size_t)L * DFF * D; WT = (bf16*)(ws + WS_WDN + L * SZ_WDN); Ns = D; nblk = 32; Kd = DFF; }
        const int kb = r / nblk, nb = r - kb * nblk, n0 = 32 * nb;
        int drow = n0;
        if (kind == 1) drow = (n0 < DFF) ? 256 * (n0 >> 7) + (n0 & 127) : 256 * ((n0 - DFF) >> 7) + 128 + ((n0 - DFF) & 127);
        wt_item(W, Ns, gain, WT, Kd, drow, 64 * kb, n0, scr, lane);
    }
}

__device__ __forceinline__ void norm_first(const float* x, bf16* XH, int gw, int NGW, int lane) {
    for (int m = gw; m < M; m += NGW) {
        const GAS f32x4* xr = (const GAS f32x4*)(x + (size_t)m * D) + lane;
        f32x4 v[4]; float s = 0.f;
#pragma unroll
        for (int j = 0; j < 4; ++j) { v[j] = xr[64 * j]; s += (v[j].x * v[j].x + v[j].y * v[j].y) + (v[j].z * v[j].z + v[j].w * v[j].w); }
        const float r = 1.0f / sqrtf(wave_sum(s) * (1.f / D) + EPS);
        GAS unsigned long long* o8 = (GAS unsigned long long*)(XH + (size_t)m * D) + lane;
#pragma unroll
        for (int j = 0; j < 4; ++j) o8[64 * j] = (unsigned long long)cvtpk(v[j].x * r, v[j].y * r) | ((unsigned long long)cvtpk(v[j].z * r, v[j].w * r) << 32);
    }
}
__device__ __forceinline__ void norm_res(const float* xold, const bf16* Y, const float* wpost, float* xout, bf16* XH, bool write_xh, int gw, int NGW, int lane) {
    f32x4 wp[4];
#pragma unroll
    for (int j = 0; j < 4; ++j) wp[j] = ((const GAS f32x4*)wpost)[lane + 64 * j];
    for (int m = gw; m < M; m += NGW) {
        const GAS f32x4* xr = (const GAS f32x4*)(xold + (size_t)m * D) + lane;
        const GAS unsigned long long* yr = (const GAS unsigned long long*)(Y + (size_t)m * D) + lane;
        f32x4 xv[4], yv[4]; float sy = 0.f;
#pragma unroll
        for (int j = 0; j < 4; ++j) { xv[j] = xr[64 * j]; const unsigned long long w = yr[64 * j]; const unsigned lo = (unsigned)w, hi = (unsigned)(w >> 32);
            yv[j] = (f32x4){bf_lo(lo), bf_hi(lo), bf_lo(hi), bf_hi(hi)}; sy += (yv[j].x * yv[j].x + yv[j].y * yv[j].y) + (yv[j].z * yv[j].z + yv[j].w * yv[j].w); }
        const float ry = 1.0f / sqrtf(wave_sum(sy) * (1.f / D) + EPS); float sx = 0.f;
#pragma unroll
        for (int j = 0; j < 4; ++j) { xv[j] = xv[j] + (yv[j] * ry) * wp[j]; sx += (xv[j].x * xv[j].x + xv[j].y * xv[j].y) + (xv[j].z * xv[j].z + xv[j].w * xv[j].w); }
        GAS f32x4* xo = (GAS f32x4*)(xout + (size_t)m * D) + lane;
#pragma unroll
        for (int j = 0; j < 4; ++j) xo[64 * j] = xv[j];
        if (write_xh) {
            const float rx = 1.0f / sqrtf(wave_sum(sx) * (1.f / D) + EPS);
            GAS unsigned long long* o8 = (GAS unsigned long long*)(XH + (size_t)m * D) + lane;
#pragma unroll
            for (int j = 0; j < 4; ++j) o8[64 * j] = (unsigned long long)cvtpk(xv[j].x * rx, xv[j].y * rx) | ((unsigned long long)cvtpk(xv[j].z * rx, xv[j].w * rx) << 32);
        }
    }
}

__device__ __forceinline__ float gelu_tanh(float x) {
    const float z = x + 0.044715f * x * x * x;
    return x * __builtin_amdgcn_rcpf(1.f + __builtin_amdgcn_exp2f(-2.0f * 0.7978845608028654f * LOG2E * z));
}
__device__ __forceinline__ void conv_phase(const bf16* U, const float* cw, const float* cb, bf16* ACT, int gtid, int NT) {
    constexpr int RG = 16, NRG = MHALF / RG, NCG = DFF / 8;
    for (int task = gtid; task < NRG * NCG; task += NT) {
        const int rg = task / NCG, cg = task - rg * NCG, r0 = rg * RG, c0 = cg * 8;
        const int ucol = 256 * (c0 >> 7) + (c0 & 127);
        float wg[3][8], wv[3][8], bg[8], bv[8];
#pragma unroll
        for (int j = 0; j < 3; ++j)
#pragma unroll
            for (int e = 0; e < 8; ++e) { wg[j][e] = cw[j * DFF2 + c0 + e]; wv[j][e] = cw[j * DFF2 + DFF + c0 + e]; }
#pragma unroll
        for (int e = 0; e < 8; ++e) { bg[e] = cb[c0 + e]; bv[e] = cb[DFF + c0 + e]; }
        float g2[8], g1[8], v2[8], v1[8];
        const bool has_prev = (r0 % SEQ) != 0;
        if (has_prev) {
            const v4u a = *(const GAS v4u*)(U + (size_t)(r0 - 2) * DFF2 + ucol), b = *(const GAS v4u*)(U + (size_t)(r0 - 2) * DFF2 + ucol + 128);
            const v4u c = *(const GAS v4u*)(U + (size_t)(r0 - 1) * DFF2 + ucol), d = *(const GAS v4u*)(U + (size_t)(r0 - 1) * DFF2 + ucol + 128);
#pragma unroll
            for (int e = 0; e < 4; ++e) { g2[2 * e] = bf_lo(a[e]); g2[2 * e + 1] = bf_hi(a[e]); v2[2 * e] = bf_lo(b[e]); v2[2 * e + 1] = bf_hi(b[e]);
                                          g1[2 * e] = bf_lo(c[e]); g1[2 * e + 1] = bf_hi(c[e]); v1[2 * e] = bf_lo(d[e]); v1[2 * e + 1] = bf_hi(d[e]); }
        } else {
#pragma unroll
            for (int e = 0; e < 8; ++e) { g2[e] = 0.f; g1[e] = 0.f; v2[e] = 0.f; v1[e] = 0.f; }
        }
#pragma unroll 4
        for (int i = 0; i < RG; ++i) {
            const v4u a = *(const GAS v4u*)(U + (size_t)(r0 + i) * DFF2 + ucol), b = *(const GAS v4u*)(U + (size_t)(r0 + i) * DFF2 + ucol + 128);
            float g0[8], v0[8]; v4u o;
#pragma unroll
            for (int e = 0; e < 4; ++e) { g0[2 * e] = bf_lo(a[e]); g0[2 * e + 1] = bf_hi(a[e]); v0[2 * e] = bf_lo(b[e]); v0[2 * e + 1] = bf_hi(b[e]); }
            float r[8];
#pragma unroll
            for (int e = 0; e < 8; ++e) { const float yg = bg[e] + wg[0][e] * g2[e] + wg[1][e] * g1[e] + wg[2][e] * g0[e]; const float yv = bv[e] + wv[0][e] * v2[e] + wv[1][e] * v1[e] + wv[2][e] * v0[e];
                r[e] = gelu_tanh(yg) * yv; g2[e] = g1[e]; g1[e] = g0[e]; v2[e] = v1[e]; v1[e] = v0[e]; }
            o.x = cvtpk(r[0], r[1]); o.y = cvtpk(r[2], r[3]); o.z = cvtpk(r[4], r[5]); o.w = cvtpk(r[6], r[7]);
            *(GAS v4u*)(ACT + (size_t)(r0 + i) * DFF + c0) = o;
        }
    }
}

typedef short s16x4 __attribute__((ext_vector_type(4)));
typedef LAS s16x4 las_s16x4; typedef LAS bf16x8 las_bf16x8; typedef LAS f32x4 las_f32x4;
__device__ __forceinline__ s16x4 tr16(const LAS bf16* p) { typedef short v4i16_t __attribute__((ext_vector_type(4))); return __builtin_bit_cast(s16x4, __builtin_amdgcn_ds_read_tr16_b64_v4i16((LAS v4i16_t*)p)); }
__device__ __forceinline__ float wscan_add(float v, int lane) {
#pragma unroll
    for (int o = 1; o < 64; o <<= 1) { const float t = __shfl_up(v, o); if (lane >= o) v += t; }
    return v;
}
__device__ __forceinline__ float wscan_max(float v, int lane) {
#pragma unroll
    for (int o = 1; o < 64; o <<= 1) { const float t = __shfl_up(v, o); if (lane >= o) v = fmaxf(v, t); }
    return v;
}
constexpr int ML_A2 = 0, ML_M2 = 16384, ML_MT2 = 32768, ML_CH = 49152, ML_RS = 50176, ML_HSQ = 50688, ML_PS = 51712, ML_BUF = 56320;
constexpr int ML_QP = 72, ML_KP = 72, ML_VP = 136, ML_PP = 72;
constexpr int ML_QS = 0, ML_KS = 32 * ML_QP * 2, ML_VS = ML_KS + 64 * ML_KP * 2, ML_BUFB = ML_VS + 64 * ML_VP * 2;
static_assert(ML_BUF + 2 * ML_BUFB <= RING_BYTES && ML_BUFB % 16 == 0 && ML_KS % 16 == 0 && ML_VS % 16 == 0, "mlstm lds map");

__device__ __forceinline__ void mlstm_phase(LAS unsigned char* lds, const bf16* QKVO, const float* GT, const float* bgate, const float* whn, bf16* HA, int vcu, int G, int tid, int wave, int lane) {
    LAS float* A2 = (LAS float*)(lds + ML_A2); LAS float* M2 = (LAS float*)(lds + ML_M2); LAS float* MT2 = (LAS float*)(lds + ML_MT2);
    LAS float* blast = (LAS float*)(lds + ML_CH); LAS float* amaxc = blast + 64; LAS float* m2c = blast + 128; LAS float* Mlc = blast + 192;
    LAS float* RS = (LAS float*)(lds + ML_RS); LAS float* HSQ = (LAS float*)(lds + ML_HSQ);
    LAS bf16* Ps = (LAS bf16*)(lds + ML_PS);
    const int fr = lane & 15, fq = lane >> 4, q4 = fr >> 2, p4 = fr & 3;
    const int tt_s = wave >> 2, st_s = wave & 3, e0 = 16 * wave;
    for (int unit = vcu; unit < BATCH * MH * 2; unit += G) {
        const int bh = unit >> 1, rh = unit & 1, b = bh >> 3, h = bh & 7;
        {
            const float bi = bgate[h], bfg = bgate[MH + h];
            int lane_s = lane; asm volatile("" : "+v"(lane_s));
            for (int c = wave; c < NCH; c += NWAVES) {
                const size_t row = (size_t)b * SEQ + c * LCH + lane;
                const float iv = GT[row * 16 + h] + bi, fv = GT[row * 16 + MH + h] + bfg;
                const float lf = fminf(fv, 0.f) - log1pf(expf(-fabsf(fv)));
                const float b2 = wscan_add(lf * LOG2E, lane_s);
                const float a2 = iv * LOG2E - b2;
                const float lam = wscan_max(a2, lane_s);
                A2[c * LCH + lane] = a2; M2[c * LCH + lane] = lam; MT2[c * LCH + lane] = b2;
                if (lane == 63) { blast[c] = b2; amaxc[c] = lam; }
            }
            __syncthreads();
            if (tid == 0) { float m2 = 0.f; for (int c = 0; c < NCH; ++c) { m2c[c] = m2; const float Ml = fmaxf(m2, amaxc[c]); Mlc[c] = Ml; m2 = blast[c] + Ml; } }
            __syncthreads();
            for (int t = tid; t < SEQ; t += NWAVES * 64) { const float Mv = fmaxf(m2c[t >> 6], M2[t]); M2[t] = Mv; MT2[t] = MT2[t] + Mv; }
            __syncthreads();
        }
        const bf16* Qg = QKVO + (size_t)b * SEQ * MIN_LD + h * DK;
        const bf16* Kg = Qg + 512;
        const bf16* Vg = QKVO + (size_t)b * SEQ * MIN_LD + 1024 + h * DV;
        const bf16* Og = Vg + 1024;
        const float whn_l = whn[h * DV + e0 + fr];
        f32x4 Cst[4], Nst[4];
#pragma unroll
        for (int i = 0; i < 4; ++i) { Cst[i] = (f32x4){0.f, 0.f, 0.f, 0.f}; Nst[i] = (f32x4){0.f, 0.f, 0.f, 0.f}; }
        v4u kreg, vreg0, vreg1, qreg = (v4u){0u, 0u, 0u, 0u};
#define ML_LOAD(c) do { const size_t r_ = (size_t)(c) * LCH; \
            kreg = *(const GAS v4u*)(Kg + (r_ + (tid >> 3)) * MIN_LD + (tid & 7) * 8); \
            vreg0 = *(const GAS v4u*)(Vg + (r_ + (tid >> 4)) * MIN_LD + (tid & 15) * 8); \
            vreg1 = *(const GAS v4u*)(Vg + (r_ + 32 + (tid >> 4)) * MIN_LD + (tid & 15) * 8); \
            if (tid < 256) qreg = *(const GAS v4u*)(Qg + (r_ + 32 * rh + (tid >> 3)) * MIN_LD + (tid & 7) * 8); } while (0)
#define ML_STORE(bufp) do { \
            *(LAS v4u*)((bufp) + ML_KS + ((tid >> 3) * ML_KP + (tid & 7) * 8) * 2) = kreg; \
            *(LAS v4u*)((bufp) + ML_VS + ((tid >> 4) * ML_VP + (tid & 15) * 8) * 2) = vreg0; \
            *(LAS v4u*)((bufp) + ML_VS + ((32 + (tid >> 4)) * ML_VP + (tid & 15) * 8) * 2) = vreg1; \
            if (tid < 256) *(LAS v4u*)((bufp) + ML_QS + ((tid >> 3) * ML_QP + (tid & 7) * 8) * 2) = qreg; } while (0)
        ML_LOAD(0);
        ML_STORE(lds + ML_BUF);
        BAR_LDS();
#pragma unroll 1
        for (int c = 0; c < NCH; ++c) {
            LAS unsigned char* buf = lds + ML_BUF + (c & 1) * ML_BUFB;
            LAS unsigned char* nbuf = lds + ML_BUF + ((c & 1) ^ 1) * ML_BUFB;
            const LAS bf16* Qs = (const LAS bf16*)(buf + ML_QS); const LAS bf16* Ks = (const LAS bf16*)(buf + ML_KS); const LAS bf16* Vs = (const LAS bf16*)(buf + ML_VS);
            if (c + 1 < NCH) ML_LOAD(c + 1);
            unsigned short og[2][4];
#pragma unroll
            for (int tt = 0; tt < 2; ++tt)
#pragma unroll
                for (int j = 0; j < 4; ++j) og[tt][j] = *(const GAS unsigned short*)(Og + ((size_t)c * LCH + 32 * rh + 16 * tt + 4 * fq + j) * MIN_LD + e0 + fr);
            const int cb = c * LCH;
            {
                const LAS bf16* Kt = Ks + (16 * st_s + fr) * ML_KP + 8 * fq;
                const LAS bf16* Qt = Qs + (16 * tt_s + fr) * ML_QP + 8 * fq;
                f32x4 sacc = (f32x4){0.f, 0.f, 0.f, 0.f};
#pragma unroll
                for (int g = 0; g < 2; ++g) { const bf16x8 ka = *(const las_bf16x8*)(Kt + 32 * g), qb = *(const las_bf16x8*)(Qt + 32 * g); sacc = __builtin_amdgcn_mfma_f32_16x16x32_bf16(ka, qb, sacc, 0, 0, 0); }
                const int t_loc = 16 * tt_s + fr, t_pos = 32 * rh + t_loc;
                const float Mt = M2[cb + t_pos];
                const f32x4 av = *(const las_f32x4*)(A2 + cb + 16 * st_s + 4 * fq);
                float p[4], rs = 0.f;
#pragma unroll
                for (int j = 0; j < 4; ++j) { const int s_pos = 16 * st_s + 4 * fq + j; const float w = __builtin_amdgcn_exp2f(av[j] - Mt - 3.0f); p[j] = (s_pos <= t_pos) ? sacc[j] * w : 0.f; rs += p[j]; }
                rs += __shfl_xor(rs, 16); rs += __shfl_xor(rs, 32);
                if (fq == 0) RS[st_s * 32 + t_loc] = rs;
                typedef unsigned u32x2 __attribute__((ext_vector_type(2)));
                u32x2 pk; pk.x = cvtpk(p[0], p[1]); pk.y = cvtpk(p[2], p[3]);
                *(LAS u32x2*)(Ps + t_loc * ML_PP + 16 * st_s + 4 * fq) = pk;
            }
            BAR_LDS();
            bf16x8 vf[2];
            {
                const LAS bf16* Vt = Vs + (8 * fq + q4) * ML_VP + e0 + 4 * p4;
#pragma unroll
                for (int g = 0; g < 2; ++g) { const s16x4 lo = tr16(Vt + 32 * g * ML_VP), hi = tr16(Vt + (32 * g + 4) * ML_VP); vf[g] = (bf16x8){lo[0], lo[1], lo[2], lo[3], hi[0], hi[1], hi[2], hi[3]}; }
            }
            float hval[2][4];
            {
                f32x4 hi_acc[2], he_acc[2], qn_acc[2];
                bf16x8 cbf[2], nbf[2];
#pragma unroll
                for (int g = 0; g < 2; ++g) {
                    typedef unsigned u32x4v __attribute__((ext_vector_type(4)));
                    u32x4v a, n;
                    a.x = cvtpk(Cst[2 * g][0], Cst[2 * g][1]); a.y = cvtpk(Cst[2 * g][2], Cst[2 * g][3]); a.z = cvtpk(Cst[2 * g + 1][0], Cst[2 * g + 1][1]); a.w = cvtpk(Cst[2 * g + 1][2], Cst[2 * g + 1][3]);
                    n.x = cvtpk(Nst[2 * g][0], Nst[2 * g][1]); n.y = cvtpk(Nst[2 * g][2], Nst[2 * g][3]); n.z = cvtpk(Nst[2 * g + 1][0], Nst[2 * g + 1][1]); n.w = cvtpk(Nst[2 * g + 1][2], Nst[2 * g + 1][3]);
                    cbf[g] = __builtin_bit_cast(bf16x8, a); nbf[g] = __builtin_bit_cast(bf16x8, n);
                }
#pragma unroll
                for (int tt = 0; tt < 2; ++tt) {
                    hi_acc[tt] = (f32x4){0.f, 0.f, 0.f, 0.f}; he_acc[tt] = (f32x4){0.f, 0.f, 0.f, 0.f}; qn_acc[tt] = (f32x4){0.f, 0.f, 0.f, 0.f};
#pragma unroll
                    for (int g = 0; g < 2; ++g) {
                        const bf16x8 pf = *(const las_bf16x8*)(Ps + (16 * tt + fr) * ML_PP + 32 * g + 8 * fq);
                        hi_acc[tt] = __builtin_amdgcn_mfma_f32_16x16x32_bf16(pf, vf[g], hi_acc[tt], 0, 0, 0);
                        const s16x4 qlo = *(const las_s16x4*)(Qs + (16 * tt + fr) * ML_QP + 32 * g + 4 * fq), qhi = *(const las_s16x4*)(Qs + (16 * tt + fr) * ML_QP + 32 * g + 16 + 4 * fq);
                        const bf16x8 qp = (bf16x8){qlo[0], qlo[1], qlo[2], qlo[3], qhi[0], qhi[1], qhi[2], qhi[3]};
                        he_acc[tt] = __builtin_amdgcn_mfma_f32_16x16x32_bf16(qp, cbf[g], he_acc[tt], 0, 0, 0);
                        qn_acc[tt] = __builtin_amdgcn_mfma_f32_16x16x32_bf16(qp, nbf[g], qn_acc[tt], 0, 0, 0);
                    }
                }
                const float m2cc = m2c[c];
#pragma unroll
                for (int tt = 0; tt < 2; ++tt) {
                    const int tl0 = 16 * tt + 4 * fq;
                    const f32x4 Mv = *(const las_f32x4*)(M2 + cb + 32 * rh + tl0), MTv = *(const las_f32x4*)(MT2 + cb + 32 * rh + tl0);
                    const f32x4 r0 = *(const las_f32x4*)(RS + tl0), r1 = *(const las_f32x4*)(RS + 32 + tl0), r2 = *(const las_f32x4*)(RS + 64 + tl0), r3 = *(const las_f32x4*)(RS + 96 + tl0);
#pragma unroll
                    for (int j = 0; j < 4; ++j) {
                        const float w = __builtin_amdgcn_exp2f(m2cc - Mv[j] - 3.0f);
                        const float num = hi_acc[tt][j] + w * he_acc[tt][j];
                        const float den = (r0[j] + r1[j]) + (r2[j] + r3[j]) + w * qn_acc[tt][j];
                        const float dd = fmaxf(fabsf(den), __builtin_amdgcn_exp2f(-MTv[j]));
                        const float hv = num * __builtin_amdgcn_rcpf(dd);
                        hval[tt][j] = hv;
                        float q = hv * hv;
                        q += __shfl_xor(q, 1); q += __shfl_xor(q, 2); q += __shfl_xor(q, 4); q += __shfl_xor(q, 8);
                        if (fr == 0) HSQ[wave * 32 + tl0 + j] = q;
                    }
                }
            }
            if (c + 1 < NCH) ML_STORE(nbuf);
            {
                const float Ml = Mlc[c], decay = __builtin_amdgcn_exp2f(m2c[c] - Ml);
                bf16x8 vfs[2], wkf[2];
#pragma unroll
                for (int g = 0; g < 2; ++g) {
                    const f32x4 a0 = *(const las_f32x4*)(A2 + cb + 32 * g + 8 * fq), a1 = *(const las_f32x4*)(A2 + cb + 32 * g + 8 * fq + 4);
                    float wk[8];
#pragma unroll
                    for (int j = 0; j < 4; ++j) { wk[j] = __builtin_amdgcn_exp2f(a0[j] - Ml); wk[4 + j] = __builtin_amdgcn_exp2f(a1[j] - Ml); }
                    typedef unsigned u32x4v __attribute__((ext_vector_type(4)));
                    const u32x4v vr = __builtin_bit_cast(u32x4v, vf[g]); u32x4v vs, ws_;
#pragma unroll
                    for (int e = 0; e < 4; ++e) { vs[e] = cvtpk(bf_lo(vr[e]) * wk[2 * e], bf_hi(vr[e]) * wk[2 * e + 1]); ws_[e] = cvtpk(wk[2 * e], wk[2 * e + 1]); }
                    vfs[g] = __builtin_bit_cast(bf16x8, vs); wkf[g] = __builtin_bit_cast(bf16x8, ws_);
                }
                const LAS bf16* Kt2 = Ks + (8 * fq + q4) * ML_KP + 4 * p4;
#pragma unroll
                for (int dt = 0; dt < 4; ++dt) {
                    Cst[dt] = Cst[dt] * decay; Nst[dt] = Nst[dt] * decay;
#pragma unroll
                    for (int g = 0; g < 2; ++g) {
                        const s16x4 lo = tr16(Kt2 + 32 * g * ML_KP + 16 * dt), hi = tr16(Kt2 + (32 * g + 4) * ML_KP + 16 * dt);
                        const bf16x8 kf = (bf16x8){lo[0], lo[1], lo[2], lo[3], hi[0], hi[1], hi[2], hi[3]};
                        Cst[dt] = __builtin_amdgcn_mfma_f32_16x16x32_bf16(kf, vfs[g], Cst[dt], 0, 0, 0);
                        Nst[dt] = __builtin_amdgcn_mfma_f32_16x16x32_bf16(kf, wkf[g], Nst[dt], 0, 0, 0);
                    }
                }
            }
            BAR_LDS();
#pragma unroll
            for (int tt = 0; tt < 2; ++tt) {
                const int tl0 = 16 * tt + 4 * fq;
                f32x4 ss = *(const las_f32x4*)(HSQ + tl0);
#pragma unroll
                for (int w = 1; w < NWAVES; ++w) ss = ss + *(const las_f32x4*)(HSQ + w * 32 + tl0);
#pragma unroll
                for (int j = 0; j < 4; ++j) {
                    const float r = 1.0f / sqrtf(ss[j] * (1.f / DV) + EPS);
                    const float ogf = __uint_as_float((unsigned)og[tt][j] << 16);
                    const float sg = __builtin_amdgcn_rcpf(1.f + __builtin_amdgcn_exp2f(-LOG2E * ogf));
                    const float ov = hval[tt][j] * r * whn_l * sg;
                    const size_t row = (size_t)b * SEQ + cb + 32 * rh + tl0 + j;
                    *(GAS unsigned short*)(HA + row * D + h * DV + e0 + fr) = (unsigned short)(cvtpk(ov, 0.f) & 0xffffu);
                }
            }
        }
#undef ML_LOAD
#undef ML_STORE
        __syncthreads();
    }
}

constexpr int FX_CS = 86016, FX_WT = FX_CS + SEQ * 4;
static_assert(attn_body::ATTN_LDS_BYTES <= FX_CS && FX_WT + 64 <= RING_BYTES, "fox lds map");
__device__ __forceinline__ void fox_phase(unsigned char* lds_g, LAS unsigned char* lds, const bf16* Qb, const bf16* Kb, const bf16* Vb, const bf16* Gb, bf16* Ob, const float* FG, const float* kvbf, int vcu, int G) {
    LAS float* cs = (LAS float*)(lds + FX_CS); LAS float* wt = (LAS float*)(lds + FX_WT);
    for (int bh = vcu; bh < BATCH * FH; bh += G) {
        const int b = bh >> 4, h = bh & 15;
        int tid = threadIdx.x; asm volatile("" : "+v"(tid)); const int lane = tid & 63, wave = __builtin_amdgcn_readfirstlane(tid >> 6);
        {
            int lane_s = lane; asm volatile("" : "+v"(lane_s));
            const float bb = kvbf[h]; float pre[8]; float run = 0.f;
#pragma unroll
            for (int k = 0; k < 8; ++k) { const float fv = FG[((size_t)b * SEQ + 8 * tid + k) * 16 + h] + bb; const float lf = fminf(fv, 0.f) - log1pf(expf(-fabsf(fv))); run += lf * LOG2E; pre[k] = run; }
            const float incl = wscan_add(run, lane_s);
            if (lane_s == 63) wt[wave] = incl;
            __syncthreads();
            float off = incl - run;
            for (int w = 0; w < wave; ++w) off += wt[w];
#pragma unroll
            for (int k = 0; k < 8; ++k) cs[8 * tid + k] = off + pre[k];
            __syncthreads();
        }
        for (int qb = 0; qb < SEQ / 256; ++qb)
            attn_body::attn_unit<8>(b, h, qb, (const attn_body::bf16*)Qb, (const attn_body::bf16*)Kb, (const attn_body::bf16*)Vb, (attn_body::bf16*)Ob, (const attn_body::bf16*)Gb, (attn_body::lds_cf32)cs, (char*)lds_g);
        __syncthreads();
    }
}

struct Args { Ins in; float* out; unsigned char* ws; };
struct KArgs { const GAS float* in[18]; GAS float* out; GAS unsigned char* ws; };
static_assert(sizeof(KArgs) == sizeof(Args), "kernarg view");
typedef const __attribute__((address_space(4))) KArgs* kargs_t;
__device__ __forceinline__ kargs_t kargs() { kargs_t p = (kargs_t)__builtin_amdgcn_kernarg_segment_ptr(); asm volatile("" : "+s"(p)); return p; }
#define PHASE_IDS() \
    int tid = threadIdx.x; asm volatile("" : "+v"(tid)); \
    const int lane = tid & 63, wave = __builtin_amdgcn_readfirstlane(tid >> 6); \
    int G = gridDim.x, bx = blockIdx.x; asm volatile("" : "+s"(G), "+s"(bx)); \
    const int vcu = (G % 8 == 0) ? (bx % 8) * (G / 8) + bx / 8 : bx; \
    const int gw = vcu * NWAVES + wave, NGW = G * NWAVES, gtid = vcu * (NWAVES * 64) + tid, NT = G * NWAVES * 64; \
    (void)lane; (void)wave; (void)vcu; (void)gw; (void)NGW; (void)gtid; (void)NT; \
    const kargs_t ka = kargs(); unsigned char* ws = (unsigned char*)ka->ws; (void)ws; \
    extern __shared__ __attribute__((aligned(16))) unsigned char lds_raw[]; LAS unsigned char* lds = (LAS unsigned char*)lds_raw; (void)lds;
#define GRID_BAR() do { XcdBarrier bar_; bar_.bar = (unsigned*)((unsigned char*)kargs()->ws + WS_CTL) + CW_BAR; bar_.x = xb_xcc_id(); \
    { extern __shared__ __attribute__((aligned(16))) unsigned char lds_b_[]; bar_.st = (volatile LAS unsigned*)((LAS unsigned char*)lds_b_ + MISC_OFF) + 8; } xcd_barrier(bar_); } while (0)

__global__ void __launch_bounds__(NWAVES * 64, 2) yoco_fwd(Args args_unused) {
    {
        PHASE_IDS();
        for (int u = tid; u < (LDS_BYTES - LDSCTL_OFF) / 4; u += NWAVES * 64) ((LAS unsigned*)(lds + LDSCTL_OFF))[u] = 0u;
        __syncthreads();
        (void)xcd_barrier_post((unsigned*)(ws + WS_CTL) + CW_BAR, (volatile LAS unsigned*)(lds + MISC_OFF) + 8);
        Ins in;
#pragma unroll
        for (int i = 0; i < 18; ++i) in.p[i] = (const float*)ka->in[i];
        prologue_weights(in, ws, lds, gw, NGW, wave, lane);
        norm_first(in.p[0], (bf16*)(ws + WS_XH), gw, NGW, lane);
    }
    GRID_BAR();

#pragma unroll 1
    for (int L = 0; L < 4; ++L) {
        if (L < 2) {
            {
                PHASE_IDS();
                pg8::Gemm g{(const bf16*)(ws + WS_XH), (const bf16*)(ws + WS_WIN + L * SZ_WIN), M, MIN_NP, D}; pg8::StaticOrder S; S.init(M, MIN_NP, G, bx);
                pg8::EpiOut E{(bf16*)(ws + WS_QKVO), MIN_LD, 0, 0, 1.f, MIN_LD / 256, (float*)(ws + WS_GATES)};
                pg8::gemm_phase<pg8::EpiOut, pg8::StaticOrder, true, true>(lds + RING_OFF, g, S, E);
            }
            GRID_BAR();
            {
                PHASE_IDS();
                mlstm_phase(lds, (const bf16*)(ws + WS_QKVO), (const float*)(ws + WS_GATES), (const float*)ka->in[6] + L * 16, (const float*)ka->in[7] + L * D, (bf16*)(ws + WS_HA), vcu, G, tid, wave, lane);
            }
        } else {
            {
                PHASE_IDS();
                const int j = L - 2;
                pg8::Gemm g{(const bf16*)(ws + WS_XH), (const bf16*)(ws + WS_WQG + j * SZ_WQG), M, 2 * D, D}; pg8::StaticOrder S; S.init(M, 2 * D, G, bx);
                pg8::EpiOut E{(bf16*)(ws + WS_FQ), D, D, (size_t)(WS_FG - WS_FQ) / 2, attn_body::C2, -1, nullptr};
                pg8::gemm_phase<pg8::EpiOut, pg8::StaticOrder, true, true>(lds + RING_OFF, g, S, E);
            }
            GRID_BAR();
            {
                PHASE_IDS();
                fox_phase(lds_raw, lds, (const bf16*)(ws + WS_FQ), (const bf16*)(ws + WS_KB), (const bf16*)(ws + WS_VB), (const bf16*)(ws + WS_FG), (bf16*)(ws + WS_FQ), (const float*)(ws + WS_GATES), (const float*)ka->in[11], vcu, G);
            }
        }
        GRID_BAR();
        {
            PHASE_IDS();
            const bf16* Aout = (L < 2) ? (const bf16*)(ws + WS_HA) : (const bf16*)(ws + WS_FQ);
            const bf16* Wout = (L < 2) ? (const bf16*)(ws + WS_WMOUT + L * SZ_SQ) : (const bf16*)(ws + WS_WFOUT + (L - 2) * SZ_SQ);
            pg8::Gemm g{Aout, Wout, M, D, D}; pg8::StaticOrder S; S.init(M, D, G, bx);
            pg8::EpiOut E{(bf16*)(ws + WS_XH), D, 0, 0, 1.f, -1, nullptr};
            pg8::gemm_phase<pg8::EpiOut, pg8::StaticOrder, true, true>(lds + RING_OFF, g, S, E);
        }
        GRID_BAR();
        {
            PHASE_IDS();
            norm_res(L == 0 ? (const float*)ka->in[0] : (float*)ka->out, (const bf16*)(ws + WS_XH), (const float*)ka->in[2] + L * D, (float*)ka->out, (bf16*)(ws + WS_XH), true, gw, NGW, lane);
        }
        GRID_BAR();
#pragma unroll 1
        for (int hf = 0; hf < 2; ++hf) {
            {
                PHASE_IDS();
                pg8::Gemm g{(const bf16*)(ws + WS_XH) + (size_t)hf * MHALF * D, (const bf16*)(ws + WS_WUP + L * SZ_WUP), MHALF, DFF2, D}; pg8::StaticOrder S; S.init(MHALF, DFF2, G, bx);
                pg8::EpiOut E{(bf16*)(ws + WS_U), DFF2, 0, 0, 1.f, -1, nullptr};
                pg8::gemm_phase<pg8::EpiOut, pg8::StaticOrder, true, true>(lds + RING_OFF, g, S, E);
            }
            GRID_BAR();
            {
                PHASE_IDS();
                conv_phase((const bf16*)(ws + WS_U), (const float*)ka->in[15] + (size_t)L * 3 * DFF2, (const float*)ka->in[16] + (size_t)L * DFF2, (bf16*)(ws + WS_ACT), gtid, NT);
            }
            GRID_BAR();
            {
                PHASE_IDS();
                pg8::Gemm g{(const bf16*)(ws + WS_ACT), (const bf16*)(ws + WS_WDN + L * SZ_WDN), MHALF, D, DFF}; pg8::StaticOrder S; S.init(MHALF, D, G, bx);
                pg8::EpiOut E{(bf16*)(ws + WS_XH) + (size_t)hf * MHALF * D, D, 0, 0, 1.f, -1, nullptr};
                pg8::gemm_phase<pg8::EpiOut, pg8::StaticOrder, true, true>(lds + RING_OFF, g, S, E);
            }
        }
        GRID_BAR();
        {
            PHASE_IDS();
            norm_res((float*)ka->out, (const bf16*)(ws + WS_XH), (const float*)ka->in[4] + L * D, (float*)ka->out, (bf16*)(ws + WS_XH), L < 3, gw, NGW, lane);
        }
        GRID_BAR();
        if (L == 1) {
            PHASE_IDS();
            pg8::Gemm g{(const bf16*)(ws + WS_XH), (const bf16*)(ws + WS_WKV), M, KV_NP, D}; pg8::StaticOrder S; S.init(M, KV_NP, G, bx);
            pg8::EpiOut E{(bf16*)(ws + WS_KB), D, D, (size_t)(WS_VB - WS_KB) / 2, 1.f, 8, (float*)(ws + WS_GATES)};
            pg8::gemm_phase<pg8::EpiOut, pg8::StaticOrder, true, true>(lds + RING_OFF, g, S, E);
        }
    }
}

extern "C" void kernel_launch(void* const* d_in, const int* in_sizes, int n_in, void* d_out, int out_size, void* d_ws, size_t ws_size, hipStream_t stream) {
    static int grid = 0;
    if (grid == 0) {
        if (n_in != 18 || in_sizes[0] != M * D || out_size != M * D || ws_size < WS_END) { fprintf(stderr, "kernel_launch: unexpected shapes (n_in %d, in0 %d, out %d, ws %zu); nothing launched\n", n_in, n_in > 0 ? in_sizes[0] : -1, out_size, ws_size); grid = -1; return; }
        if (hipFuncSetAttribute((const void*)yoco_fwd, hipFuncAttributeMaxDynamicSharedMemorySize, LDS_BYTES) != hipSuccess) { fprintf(stderr, "kernel_launch: hipFuncSetAttribute failed\n"); grid = -1; return; }
        int dev = 0, cus = 0, per_cu = 0;
        (void)hipGetDevice(&dev); (void)hipDeviceGetAttribute(&cus, hipDeviceAttributeMultiprocessorCount, dev);
        (void)hipOccupancyMaxActiveBlocksPerMultiprocessor(&per_cu, (const void*)yoco_fwd, NWAVES * 64, LDS_BYTES);
        (void)hipGetLastError();
        grid = (cus >= 256 && per_cu >= 1) ? 256 : (cus > 0 ? cus : 256);
    }
    if (grid < 0) return;
    (void)hipMemsetAsync((char*)d_ws + WS_CTL, 0, CTL_ZERO_BYTES, stream);
    Args a{};
    for (int i = 0; i < 18; ++i) a.in.p[i] = (const float*)d_in[i];
    a.out = (float*)d_out; a.ws = (unsigned char*)d_ws;
    hipLaunchKernelGGL(yoco_fwd, dim3(grid), dim3(NWAVES * 64), LDS_BYTES, stream, a);
}
```

```cpp
#include <hip/hip_runtime.h>
#include <hip/hip_bf16.h>
#include <cstdio>
#include <cstdint>
#include <cmath>

#include <hip/hip_runtime.h>
#include <cstdio>
#include <cstdint>
namespace pg8 {
#define PG8_LAS __attribute__((address_space(3)))
typedef unsigned short bf16_t;
typedef short bf16x8 __attribute__((ext_vector_type(8)));
typedef float f32x4 __attribute__((ext_vector_type(4)));
typedef unsigned u32x4 __attribute__((ext_vector_type(4)));
constexpr int BM = 256, BK = 64, HALF = 128, HTB = HALF * BK * 2  , STAGE_BYTES = 8 * HTB, NXCD = 8, WGM = 8;

__host__ __device__ __forceinline__ int lds_byte(int r, int c) { const int st = (r >> 4) * 2 + (c >> 5), rr = r & 15, cc = c & 31, ob = rr * 64 + cc * 2; return st * 1024 + (ob ^ (((ob >> 9) & 1) << 5)); }
__host__ __device__ __forceinline__ void stage_rc(int b, int& R, int& C) { const int st = b / 1024, sb = b % 1024, swz = sb ^ (((sb >> 9) & 1) << 5); R = (st >> 1) * 16 + swz / 64; C = (st & 1) * 32 + (swz % 64) / 2; }
__host__ __device__ __forceinline__ int perm32(int rho) { const int n = rho >> 4, i = rho & 15; return 8 * (i >> 2) + 4 * n + (i & 3); }

struct Unit { int pm, pn; };
struct Gemm { const bf16_t* A; const bf16_t* Bt; int M, N, K; };

struct StaticOrder {
    int nM, nN, nwg, G, c;
    __host__ __device__ void init(int M, int N, int G_, int c_) { nM = M / BM; nN = N / BM; nwg = nM * nN; G = G_; c = c_; }
    __host__ __device__ bool next(int i, Unit& u) const {
        const long L = (long)i * G + c; if (L >= nwg) return false;
        int wgid = (int)L; { const int q = nwg / NXCD, r = nwg % NXCD, xcd = wgid % NXCD, off = wgid / NXCD; wgid = (xcd < r ? xcd * (q + 1) : r * (q + 1) + (xcd - r) * q) + off; }
        const int nig = WGM * nN, gid = wgid / nig, fm = gid * WGM, gsz = (nM - fm) < WGM ? (nM - fm) : WGM;
        u.pm = fm + ((wgid % nig) % gsz); u.pn = (wgid % nig) / gsz; return true;
    }
    __device__ __forceinline__ void a_ready(const Unit&) const {}
    __device__ __forceinline__ void done(const Unit&) const {}
};

__device__ __forceinline__ unsigned cvt_pk_bf16(float lo, float hi) { unsigned r; asm volatile("v_cvt_pk_bf16_f32 %0, %1, %2" : "=v"(r) : "v"(lo), "v"(hi)); return r; }
typedef float f32x2 __attribute__((ext_vector_type(2)));
__device__ __forceinline__ f32x2 gelu_pk(f32x2 v) {
    const f32x2 av = __builtin_elementwise_abs(v), d = av * 0.2316418882f + 1.0f;
    f32x2 t; t.x = __builtin_amdgcn_rcpf(d.x); t.y = __builtin_amdgcn_rcpf(d.y);
    f32x2 q = t * 0.5307027145f + (-0.7265760135f); q = q * t + 0.7107068705f; q = q * t + (-0.142248368f); q = q * t + 0.127414796f; q = q * t;
    const f32x2 s = (v * v) * (-0.72134752044f);
    f32x2 e; e.x = __builtin_amdgcn_exp2f(s.x); e.y = __builtin_amdgcn_exp2f(s.y);
    const f32x2 m = v * (q * e), r = v - m;
    f32x2 o; o.x = v.x < 0.f ? m.x : r.x; o.y = v.y < 0.f ? m.y : r.y; return o;
}

template <int ACT  > struct EpiBf16 {
    static constexpr bool PERM = true, AFTER_DRAIN = false; static_assert(ACT == 0 || ACT == 1, "EpiBf16: ACT is 0 (none) or 1 (gelu_pk)");
    bf16_t* O; int ldc; const float* bias; int split_cols; size_t split_stride; float scale0;
    __device__ __forceinline__ void operator()(const f32x4 (&acc)[2][2][4][2], const Unit& u, int wr, int wc, int fr, int fq) const {
        const int row0 = u.pm * BM + wr * 64 + fr; int colt = u.pn * BM; bf16_t* base = O;
        float sc = 1.f; if (split_cols) { const int t = colt / split_cols; base += (size_t)t * split_stride; colt -= t * split_cols; if (t == 0) sc = scale0; }
        const int col0 = colt + wc * 32 + 8 * fq, bcol0 = u.pn * BM + wc * 32 + 8 * fq;
        f32x4 bv[2][2];
#pragma unroll
        for (int bj = 0; bj < 2; ++bj)
#pragma unroll
            for (int n = 0; n < 2; ++n) bv[bj][n] = bias ? *(const f32x4*)(bias + bcol0 + bj * HALF + 4 * n) : (f32x4){0.f, 0.f, 0.f, 0.f};
#pragma unroll
        for (int ai = 0; ai < 2; ++ai)
#pragma unroll
            for (int m = 0; m < 4; ++m) { bf16_t* rowp = base + (size_t)(row0 + ai * HALF + m * 16) * ldc + col0;
#pragma unroll
                for (int bj = 0; bj < 2; ++bj) { f32x4 v0 = acc[ai][bj][m][0] + bv[bj][0], v1 = acc[ai][bj][m][1] + bv[bj][1];
                    if (ACT == 1) { f32x2 a = gelu_pk((f32x2){v0[0], v0[1]}), b = gelu_pk((f32x2){v0[2], v0[3]}), c = gelu_pk((f32x2){v1[0], v1[1]}), d = gelu_pk((f32x2){v1[2], v1[3]});
                        v0 = (f32x4){a.x, a.y, b.x, b.y}; v1 = (f32x4){c.x, c.y, d.x, d.y}; }
                    v0 = v0 * sc; v1 = v1 * sc; u32x4 w; w.x = cvt_pk_bf16(v0[0], v0[1]); w.y = cvt_pk_bf16(v0[2], v0[3]); w.z = cvt_pk_bf16(v1[0], v1[1]); w.w = cvt_pk_bf16(v1[2], v1[3]);
                    *(u32x4*)(rowp + bj * HALF) = w; } }
    }
};

struct PanelStats {
    unsigned* xbuf;
    unsigned* cnt;
    unsigned* tmo;
    int ntn; float eps;
    unsigned code;
    __device__ __forceinline__ bool run(const f32x4 (&v)[2][2][4][2], const Unit& u, int wr, int wc, int fr, int fq, PG8_LAS unsigned char* lds, int wid, int lane) const {
        typedef float f32x2v __attribute__((ext_vector_type(2)));
        PG8_LAS f32x2v* P = (PG8_LAS f32x2v*)lds;
        PG8_LAS f32x2v* S = (PG8_LAS f32x2v*)(lds + 8192);
        PG8_LAS unsigned* flag = (PG8_LAS unsigned*)(lds + 8192 + 2048);
#pragma unroll
        for (int ai = 0; ai < 2; ++ai)
#pragma unroll
            for (int m = 0; m < 4; ++m) {
                float s = 0.f;
#pragma unroll
                for (int bj = 0; bj < 2; ++bj)
#pragma unroll
                    for (int n = 0; n < 2; ++n) { const f32x4 x = v[ai][bj][m][n]; s += (x[0] + x[1]) + (x[2] + x[3]); }
                s += __shfl_xor(s, 16); s += __shfl_xor(s, 32);
                const float mw = s * (1.0f / 64.0f); float q = 0.f;
#pragma unroll
                for (int bj = 0; bj < 2; ++bj)
#pragma unroll
                    for (int n = 0; n < 2; ++n) { const f32x4 d = v[ai][bj][m][n] - mw; q += (d[0] * d[0] + d[1] * d[1]) + (d[2] * d[2] + d[3] * d[3]); }
                q += __shfl_xor(q, 16); q += __shfl_xor(q, 32);
                if (fq == 0) P[(ai * HALF + wr * 64 + m * 16 + fr) * 4 + wc] = (f32x2v){mw, q};
            }
        asm volatile("s_waitcnt lgkmcnt(0)" ::: "memory"); __builtin_amdgcn_s_barrier(); asm volatile("" ::: "memory");
#if defined(BROKEN_EXCHANGE_NO_WAIT)
#warning BROKEN CONTROL BUILD: the row-statistics exchange does not wait; results are wrong by design
        if (blockIdx.x >= 64) { const long long t0_ = clock64(); while (clock64() - t0_ < 60000) __builtin_amdgcn_s_sleep(8); }
#endif
        const int row = wid * 32 + (lane & 31);
        if (lane < 32) {
            const f32x2v a = P[row * 4 + 0], b = P[row * 4 + 1], c = P[row * 4 + 2], d = P[row * 4 + 3];
            const float mt = (a.x + b.x + c.x + d.x) * 0.25f;
            const float da = a.x - mt, db = b.x - mt, dc = c.x - mt, dd = d.x - mt;
            const float m2 = (a.y + b.y) + (c.y + d.y) + 64.0f * ((da * da + db * db) + (dc * dc + dd * dd));
            unsigned long long* slot = (unsigned long long*)xbuf + ((size_t)(u.pm * BM + row) * 4 + u.pn);
            __hip_atomic_store(slot, ((unsigned long long)__float_as_uint(m2) << 32) | __float_as_uint(mt), __ATOMIC_RELAXED, __HIP_MEMORY_SCOPE_AGENT);
        }
        asm volatile("s_waitcnt vmcnt(0)" ::: "memory");
        if (lane == 0) __hip_atomic_fetch_add(cnt + 64 * u.pm, 1u, __ATOMIC_RELAXED, __HIP_MEMORY_SCOPE_AGENT);
        if (wid == 0) {
            bool dead = false; const unsigned long long t0 = __builtin_amdgcn_s_memrealtime(); const unsigned want = 8u * (unsigned)ntn;
            for (;;) {
#if defined(BROKEN_EXCHANGE_NO_WAIT)
                break;
#endif
                if ((unsigned)__builtin_amdgcn_readfirstlane(__hip_atomic_load(cnt + 64 * u.pm, __ATOMIC_RELAXED, __HIP_MEMORY_SCOPE_AGENT)) >= want) break;
                if (__builtin_amdgcn_s_memrealtime() - t0 > 2000000ull) {
                    if (lane == 0) { unsigned expect = 0u; __hip_atomic_compare_exchange_strong(tmo + 1, &expect, code | (unsigned)(u.pm & 0xff), __ATOMIC_RELAXED, __ATOMIC_RELAXED, __HIP_MEMORY_SCOPE_AGENT);
                                     __hip_atomic_store(tmo, 1u, __ATOMIC_RELAXED, __HIP_MEMORY_SCOPE_AGENT); }
                    dead = true; break; }
                __builtin_amdgcn_s_sleep(2);
            }
            __builtin_amdgcn_fence(__ATOMIC_ACQUIRE, "agent");
            if (lane == 0) flag[0] = dead ? 1u : 0u;
        }
        asm volatile("s_waitcnt vmcnt(0) lgkmcnt(0)" ::: "memory"); __builtin_amdgcn_s_barrier(); asm volatile("" ::: "memory");
        const bool bad = flag[0] != 0u;
        if (lane < 32) {
            const unsigned long long* slot = (const unsigned long long*)xbuf + (size_t)(u.pm * BM + row) * 4; float mt[4], m2[4]; float ms = 0.f;
#pragma unroll
            for (int t = 0; t < 4; ++t) { if (t < ntn) { const unsigned long long w = __hip_atomic_load(slot + t, __ATOMIC_RELAXED, __HIP_MEMORY_SCOPE_AGENT); mt[t] = __uint_as_float((unsigned)w); m2[t] = __uint_as_float((unsigned)(w >> 32)); } else { mt[t] = 0.f; m2[t] = 0.f; } ms += mt[t]; }
            const float mean = ms / (float)ntn; float q = 0.f;
#pragma unroll
            for (int t = 0; t < 4; ++t) if (t < ntn) { const float dm = mt[t] - mean; q += m2[t] + 256.0f * dm * dm; }
            S[row] = (f32x2v){mean, 1.0f / sqrtf(q / (256.0f * (float)ntn) + eps)};
        }
        asm volatile("s_waitcnt lgkmcnt(0)" ::: "memory"); __builtin_amdgcn_s_barrier(); asm volatile("" ::: "memory");
        return bad;
    }
};
struct EpiLnRes {
    static constexpr bool PERM = false, AFTER_DRAIN = true;
    const float* base; float* out; int ldc; const float* bias; PanelStats st; unsigned poison;
    __device__ __forceinline__ void fused(f32x4 (&acc)[2][2][4][2], const Unit& u, int wr, int wc, int fr, int fq, PG8_LAS unsigned char* lds, int wid, int lane) const {
        typedef float f32x2v __attribute__((ext_vector_type(2)));
        const PG8_LAS f32x2v* S = (const PG8_LAS f32x2v*)(lds + 8192);
        const int col0 = u.pn * BM + wc * 32 + 4 * fq;
#pragma unroll
        for (int bj = 0; bj < 2; ++bj)
#pragma unroll
            for (int n = 0; n < 2; ++n) { const f32x4 bv = bias ? *(const f32x4*)(bias + col0 + bj * HALF + n * 16) : (f32x4){0.f, 0.f, 0.f, 0.f};
#pragma unroll
                for (int ai = 0; ai < 2; ++ai)
#pragma unroll
                    for (int m = 0; m < 4; ++m) acc[ai][bj][m][n] += bv; }
        f32x4 pre[4][2][2];
#pragma unroll
        for (int m = 0; m < 4; ++m) { const size_t off = (size_t)(u.pm * BM + wr * 64 + m * 16 + fr) * ldc + col0;
#pragma unroll
            for (int bj = 0; bj < 2; ++bj)
#pragma unroll
                for (int n = 0; n < 2; ++n) pre[m][bj][n] = *(const f32x4*)(base + off + bj * HALF + n * 16); }
        const bool bad = st.run(acc, u, wr, wc, fr, fq, lds, wid, lane) || poison != 0u;
        const float qnan = __builtin_nanf("");
#pragma unroll
        for (int ai = 0; ai < 2; ++ai)
#pragma unroll
            for (int m = 0; m < 4; ++m) { const int r = ai * HALF + wr * 64 + m * 16 + fr; const f32x2v sr = S[r]; const size_t off = (size_t)(u.pm * BM + r) * ldc + col0;
#pragma unroll
                for (int bj = 0; bj < 2; ++bj)
#pragma unroll
                    for (int n = 0; n < 2; ++n) { const f32x4 bs = ai == 0 ? pre[m][bj][n] : *(const f32x4*)(base + off + bj * HALF + n * 16); f32x4 o = bs + (acc[ai][bj][m][n] - sr.x) * sr.y;
                        if (bad) o = (f32x4){qnan, qnan, qnan, qnan}; *(f32x4*)(out + off + bj * HALF + n * 16) = o; }
                if (m & 1) asm volatile("" ::: "memory"); }
    }
};
struct EpiLnResLn {
    static constexpr bool PERM = false, AFTER_DRAIN = true;
    const float* base; float* out; bf16_t* xn; int ldc; const float* bias; PanelStats st1, st2; unsigned poison;
    __device__ __forceinline__ void fused(f32x4 (&acc)[2][2][4][2], const Unit& u, int wr, int wc, int fr, int fq, PG8_LAS unsigned char* lds, int wid, int lane) const {
        typedef float f32x2v __attribute__((ext_vector_type(2))); typedef unsigned u32x2v __attribute__((ext_vector_type(2)));
        const PG8_LAS f32x2v* S = (const PG8_LAS f32x2v*)(lds + 8192);
        const int col0 = u.pn * BM + wc * 32 + 4 * fq;
#pragma unroll
        for (int bj = 0; bj < 2; ++bj)
#pragma unroll
            for (int n = 0; n < 2; ++n) { const f32x4 bv = bias ? *(const f32x4*)(bias + col0 + bj * HALF + n * 16) : (f32x4){0.f, 0.f, 0.f, 0.f};
#pragma unroll
                for (int ai = 0; ai < 2; ++ai)
#pragma unroll
                    for (int m = 0; m < 4; ++m) acc[ai][bj][m][n] += bv; }
        bool bad = st1.run(acc, u, wr, wc, fr, fq, lds, wid, lane) || poison != 0u;
        const float qnan = __builtin_nanf("");
#pragma unroll
        for (int ai = 0; ai < 2; ++ai)
#pragma unroll
            for (int m = 0; m < 4; ++m) { const int r = ai * HALF + wr * 64 + m * 16 + fr; const f32x2v sr = S[r]; const size_t off = (size_t)(u.pm * BM + r) * ldc + col0;
#pragma unroll
                for (int bj = 0; bj < 2; ++bj)
#pragma unroll
                    for (int n = 0; n < 2; ++n) { const f32x4 bs = *(const f32x4*)(base + off + bj * HALF + n * 16); acc[ai][bj][m][n] = bs + (acc[ai][bj][m][n] - sr.x) * sr.y; }
                asm volatile("" : "+v"(acc[ai][0][m][0]), "+v"(acc[ai][0][m][1]), "+v"(acc[ai][1][m][0]), "+v"(acc[ai][1][m][1]));
                if (m & 1) asm volatile("" ::: "memory"); }
        const bool bad1 = bad;
        bad = st2.run(acc, u, wr, wc, fr, fq, lds, wid, lane) || bad;
#pragma unroll
        for (int ai = 0; ai < 2; ++ai)
#pragma unroll
            for (int m = 0; m < 4; ++m) { const int r = ai * HALF + wr * 64 + m * 16 + fr; const f32x2v sr = S[r]; const size_t off = (size_t)(u.pm * BM + r) * ldc + col0;
#pragma unroll
                for (int bj = 0; bj < 2; ++bj)
#pragma unroll
                    for (int n = 0; n < 2; ++n) { const f32x4 x1 = acc[ai][bj][m][n]; *(f32x4*)(out + off + bj * HALF + n * 16) = bad1 ? (f32x4){qnan, qnan, qnan, qnan} : x1;
                        const f32x4 o = (x1 - sr.x) * sr.y; u32x2v w; w.x = cvt_pk_bf16(o[0], o[1]); w.y = cvt_pk_bf16(o[2], o[3]);
                        if (bad) { w.x = 0x7fc07fc0u; w.y = 0x7fc07fc0u; } *(u32x2v*)(xn + off + bj * HALF + n * 16) = w; }
                asm volatile("" ::: "memory"); }
    }
};

template <class E, class = void> struct aperm_of { static constexpr bool value = false; };
template <class E> struct aperm_of<E, decltype((void)E::APERM)> { static constexpr bool value = E::APERM; };
template <class Epi, class Sched, bool ALIGN_EPI = false, bool SP2 = false>
__device__ __forceinline__ void gemm_phase(PG8_LAS unsigned char* lds, const Gemm g, const Sched& S, const Epi& E) {
    int tid = threadIdx.x; asm volatile("" : "+v"(tid)); const int wid = __builtin_amdgcn_readfirstlane(tid >> 6), lane = tid & 63, wr = wid >> 2, wc = wid & 3, fr = lane & 15, fq = lane >> 4;
    const int K = g.K, nt = K / BK;
    unsigned voffA[2], voffB[2];
#pragma unroll
    for (int i = 0; i < 2; ++i) { int R, C; stage_rc(tid * 16 + i * 8192, R, C); const int Rb = Epi::PERM ? ((R & ~31) + perm32(R & 31)) : R;
        const int Ra = aperm_of<Epi>::value ? ((R & ~63) + 4 * (R & 15) + ((R >> 4) & 3)) : R;
        voffA[i] = (unsigned)(Ra * K + C) * 2u; voffB[i] = (unsigned)(Rb * K + C) * 2u; }
    const size_t kstep = (size_t)(BK * 2);
    const size_t hstep = (size_t)HALF * K * 2;
    const size_t tstep = 2 * hstep;
    const unsigned ldsw = (unsigned)wid * 1024u;
    const int aoff = lds_byte(wr * 64 + fr, fq * 8), boff = lds_byte(wc * 32 + fr, fq * 8);
#define PG8_SA(b, h) (((b) * 2 + (h)) * HTB)
#define PG8_SB(b, h) ((4 + (b) * 2 + (h)) * HTB)
#define PG8_STAGE(bufoff, gbase, voff) do { _Pragma("unroll") for (int _i = 0; _i < 2; ++_i) \
        __builtin_amdgcn_global_load_lds((const unsigned*)((const char*)(gbase) + (voff)[_i]), (PG8_LAS unsigned*)(lds + (bufoff) + ldsw + _i * 8192), 16, 0, 0); } while (0)
#define PG8_LDA(dst, b, h) do { _Pragma("unroll") for (int m = 0; m < 4; ++m) _Pragma("unroll") for (int k = 0; k < 2; ++k) dst[m][k] = *(const PG8_LAS bf16x8*)(lds + PG8_SA(b, h) + aoff + m * 2048 + k * 1024); } while (0)
#define PG8_LDB(dst, b, h) do { _Pragma("unroll") for (int n = 0; n < 2; ++n) _Pragma("unroll") for (int k = 0; k < 2; ++k) dst[n][k] = *(const PG8_LAS bf16x8*)(lds + PG8_SB(b, h) + boff + n * 2048 + k * 1024); } while (0)
#define PG8_MMA(ai, bj, At, Bt) do { __builtin_amdgcn_s_setprio(1); _Pragma("unroll") for (int m = 0; m < 4; ++m) _Pragma("unroll") for (int n = 0; n < 2; ++n) _Pragma("unroll") for (int k = 0; k < 2; ++k) \
        acc[ai][bj][m][n] = __builtin_amdgcn_mfma_f32_16x16x32_bf16(Bt[n][k], At[m][k], acc[ai][bj][m][n], 0, 0, 0); __builtin_amdgcn_s_setprio(0); } while (0)
#define PG8_WAIT_V(n) asm volatile("s_waitcnt vmcnt(" #n ")" ::: "memory")
#define PG8_WAIT_L(n) asm volatile("s_waitcnt lgkmcnt(" #n ")" ::: "memory")
#define PG8_BAR __builtin_amdgcn_s_barrier()
#define PG8_SCHED __builtin_amdgcn_sched_barrier(0)
    Unit cur, nxt; int ui = 0;
    if (!S.next(0, cur)) return;
    f32x4 acc[2][2][4][2];
#pragma unroll
    for (int a = 0; a < 2; ++a)
#pragma unroll
        for (int b = 0; b < 2; ++b)
#pragma unroll
            for (int m = 0; m < 4; ++m)
#pragma unroll
                for (int n = 0; n < 2; ++n) acc[a][b][m][n] = (f32x4){0.f, 0.f, 0.f, 0.f};
    bf16x8 At[4][2], B0[2][2], B1[2][2];
    const char* cA = (const char*)g.A + (size_t)cur.pm * tstep; const char* cB = (const char*)g.Bt + (size_t)cur.pn * tstep;
    S.a_ready(cur);
    if constexpr (SP2) {
        PG8_STAGE(PG8_SB(0, 0), cB, voffB); PG8_STAGE(PG8_SB(0, 1), cB + hstep, voffB); PG8_STAGE(PG8_SA(0, 0), cA, voffA); PG8_STAGE(PG8_SA(0, 1), cA + hstep, voffA);
        if (wr == 1) PG8_BAR;
        PG8_WAIT_V(2); PG8_BAR;
        PG8_STAGE(PG8_SB(1, 0), cB + kstep, voffB); PG8_STAGE(PG8_SA(1, 0), cA + kstep, voffA); PG8_STAGE(PG8_SB(1, 1), cB + hstep + kstep, voffB);
        PG8_WAIT_V(6); PG8_BAR;
    } else {
        PG8_STAGE(PG8_SB(0, 0), cB, voffB); PG8_STAGE(PG8_SA(0, 0), cA, voffA); PG8_STAGE(PG8_SB(0, 1), cB + hstep, voffB); PG8_STAGE(PG8_SA(0, 1), cA + hstep, voffA);
        if (wr == 1) PG8_BAR;
        PG8_WAIT_V(4); PG8_BAR;
        PG8_STAGE(PG8_SB(1, 0), cB + kstep, voffB); PG8_STAGE(PG8_SA(1, 0), cA + kstep, voffA); PG8_STAGE(PG8_SB(1, 1), cB + hstep + kstep, voffB);
        PG8_WAIT_V(6); PG8_BAR;
    }
    for (;;) {
        const bool has_next = S.next(ui + 1, nxt);
        const char* nA = has_next ? (const char*)g.A + (size_t)nxt.pm * tstep : cA; const char* nB = has_next ? (const char*)g.Bt + (size_t)nxt.pn * tstep : cB;
        for (int t = 0; t < nt; t += 2) {
            const bool last = (t == nt - 2);
            const char* a1 = cA + (size_t)(t + 1) * kstep;
            const char* a2 = last ? nA : cA + (size_t)(t + 2) * kstep; const char* b2 = last ? nB : cB + (size_t)(t + 2) * kstep;
            const char* a3 = a2 + kstep; const char* b3 = b2 + kstep;
            if (last && has_next) S.a_ready(nxt);
            if constexpr (SP2) {
            PG8_LDB(B0, 0, 0); PG8_LDB(B1, 0, 1); PG8_SCHED; PG8_LDA(At, 0, 0); PG8_STAGE(PG8_SA(1, 1), a1 + hstep, voffA);
            PG8_WAIT_V(8); PG8_WAIT_L(0); PG8_BAR; PG8_MMA(0, 0, At, B0); PG8_MMA(0, 1, At, B1); PG8_BAR; PG8_SCHED;
            PG8_LDA(At, 0, 1); PG8_STAGE(PG8_SB(0, 0), b2, voffB); PG8_STAGE(PG8_SB(0, 1), b2 + hstep, voffB); PG8_STAGE(PG8_SA(0, 0), a2, voffA);
            PG8_WAIT_V(8); PG8_WAIT_L(0); PG8_BAR; PG8_MMA(1, 0, At, B0); PG8_MMA(1, 1, At, B1); PG8_BAR; PG8_SCHED;
            PG8_LDB(B0, 1, 0); PG8_LDB(B1, 1, 1); PG8_SCHED; PG8_LDA(At, 1, 0); PG8_STAGE(PG8_SA(0, 1), a2 + hstep, voffA);
            PG8_WAIT_V(8); PG8_WAIT_L(0); PG8_BAR; PG8_MMA(0, 0, At, B0); PG8_MMA(0, 1, At, B1); PG8_BAR; PG8_SCHED;
            PG8_LDA(At, 1, 1); PG8_STAGE(PG8_SB(1, 0), b3, voffB); PG8_STAGE(PG8_SB(1, 1), b3 + hstep, voffB); PG8_STAGE(PG8_SA(1, 0), a3, voffA);
            PG8_WAIT_V(8); PG8_WAIT_L(0); PG8_BAR; PG8_MMA(1, 0, At, B0); PG8_MMA(1, 1, At, B1); PG8_BAR; PG8_SCHED;
            } else {
            PG8_LDB(B0, 0, 0); PG8_SCHED; PG8_LDA(At, 0, 0); PG8_STAGE(PG8_SA(1, 1), a1 + hstep, voffA);
            PG8_WAIT_L(8); PG8_BAR; PG8_WAIT_L(0); PG8_MMA(0, 0, At, B0); PG8_BAR; PG8_SCHED;
            PG8_LDB(B1, 0, 1); PG8_STAGE(PG8_SB(0, 0), b2, voffB);
            PG8_BAR; PG8_WAIT_L(0); PG8_MMA(0, 1, At, B1); PG8_BAR;
            PG8_LDA(At, 0, 1); PG8_STAGE(PG8_SA(0, 0), a2, voffA);
            PG8_BAR; PG8_WAIT_L(0); PG8_MMA(1, 0, At, B0); PG8_BAR; PG8_SCHED;
            PG8_STAGE(PG8_SB(0, 1), b2 + hstep, voffB);
            PG8_WAIT_V(6); PG8_BAR; PG8_MMA(1, 1, At, B1); PG8_BAR;
            PG8_LDB(B0, 1, 0); PG8_SCHED; PG8_LDA(At, 1, 0); PG8_STAGE(PG8_SA(0, 1), a2 + hstep, voffA);
            PG8_WAIT_L(8); PG8_BAR; PG8_WAIT_L(0); PG8_MMA(0, 0, At, B0); PG8_BAR; PG8_SCHED;
            PG8_LDB(B1, 1, 1); PG8_STAGE(PG8_SB(1, 0), b3, voffB);
            PG8_BAR; PG8_WAIT_L(0); PG8_MMA(0, 1, At, B1); PG8_BAR;
            PG8_LDA(At, 1, 1); PG8_STAGE(PG8_SA(1, 0), a3, voffA);
            PG8_BAR; PG8_WAIT_L(0); PG8_MMA(1, 0, At, B0); PG8_BAR; PG8_SCHED;
            PG8_STAGE(PG8_SB(1, 1), b3 + hstep, voffB);
            PG8_WAIT_V(6); PG8_BAR; PG8_MMA(1, 1, At, B1); PG8_BAR;
            }
        }
        if constexpr (ALIGN_EPI) { if (wr == 0) PG8_BAR; }
        if constexpr (!Epi::AFTER_DRAIN) { E(acc, cur, wr, wc, fr, fq); S.done(cur); }
        if (!has_next) break;
#pragma unroll
        for (int a = 0; a < 2; ++a)
#pragma unroll
            for (int b = 0; b < 2; ++b)
#pragma unroll
                for (int m = 0; m < 4; ++m)
#pragma unroll
                    for (int n = 0; n < 2; ++n) acc[a][b][m][n] = (f32x4){0.f, 0.f, 0.f, 0.f};
        cur = nxt; cA = nA; cB = nB; ++ui;
        if constexpr (ALIGN_EPI) { if (wr == 1) PG8_BAR; }
    }
    PG8_WAIT_V(0);
    if constexpr (!ALIGN_EPI) { if (wr == 0) PG8_BAR; }
    PG8_BAR;
    if constexpr (Epi::AFTER_DRAIN) { E.fused(acc, cur, wr, wc, fr, fq, lds, wid, lane); S.done(cur); }
#undef PG8_SA
#undef PG8_SB
#undef PG8_STAGE
#undef PG8_LDA
#undef PG8_LDB
#undef PG8_MMA
#undef PG8_WAIT_V
#undef PG8_WAIT_L
#undef PG8_BAR
#undef PG8_SCHED
}
}

#ifndef PG8_SP2
#define PG8_SP2 true
#endif
#ifndef PG8_ALIGN
#define PG8_ALIGN true
#endif
#include <hip/hip_bf16.h>
#include <cmath>
namespace attn_body {
using bf16=__hip_bfloat16;
using bf16x8=__attribute__((ext_vector_type(8)))short;
using s16x4=__attribute__((ext_vector_type(4)))short;
using f32x16=__attribute__((ext_vector_type(16)))float;
using u32x4=__attribute__((ext_vector_type(4)))unsigned;
constexpr int BATCH=16,NHEAD=16,SEQ=4096,D=64,DM=NHEAD*D;
constexpr int NW=8,QBLK=32,QB=QBLK*NW,KVBLK=64,NQB=SEQ/QB;
constexpr int ATTN_PITCH=DM, ATTN_UNIT_ROWS=QB;
__device__ __forceinline__ int crow(int r,int hi){return (r&3)+8*(r>>2)+4*hi;}
#define SBAR() __builtin_amdgcn_sched_barrier(0)
__device__ __forceinline__ void cmask(f32x16&p0,f32x16&p1,int jb,int qrel,int hi){
  const float NEG=-INFINITY; int kb=64*jb+4*hi;
  #pragma unroll
  for(int r=0;r<16;++r){int kv=kb+(r&3)+8*(r>>2); if(kv>qrel)p0[r]=NEG; if(kv+32>qrel)p1[r]=NEG;}
}

constexpr int NSLOT=3, SLOTB=8192;
constexpr int LDS_K=0, LDS_V=NSLOT*SLOTB, LDS_WS=2*NSLOT*SLOTB, LDS_OST=LDS_WS+NW*64*4, LDS_BYTES=LDS_OST+NW*4096;
constexpr float C2=0.125f*1.4426950408889634f;
__device__ __forceinline__ void glds16(const void*gsrc,unsigned lds_dst){unsigned keep;
  asm volatile("s_mov_b32 %0, m0\n\ts_mov_b32 m0, %2\n\ts_nop 0\n\tglobal_load_lds_dwordx4 %1, off\n\ts_mov_b32 m0, %0":"=&s"(keep):"v"(gsrc),"s"(lds_dst):"memory");}
__device__ __forceinline__ void glds16s(const void*sbase,unsigned voff,unsigned lds_dst){unsigned keep;
  asm volatile("s_mov_b32 %0, m0\n\ts_mov_b32 m0, %3\n\ts_nop 0\n\tglobal_load_lds_dwordx4 %1, %2\n\ts_mov_b32 m0, %0":"=&s"(keep):"v"(voff),"s"(sbase),"s"(lds_dst):"memory");}
__device__ __forceinline__ float max3f(float a,float b,float c){float r;asm("v_max3_f32 %0, %1, %2, %3":"=v"(r):"v"(a),"v"(b),"v"(c));return r;}
__device__ __forceinline__ float max2f(float a,float b){float r;asm("v_max_f32_e32 %0, %1, %2":"=v"(r):"v"(a),"v"(b));return r;}
__device__ __forceinline__ float fadd_s(float a,float b){float r;asm("v_add_f32_e32 %0, %1, %2":"=v"(r):"v"(a),"v"(b));return r;}
__device__ __forceinline__ float fmul_s(float a,float b){float r;asm("v_mul_f32_e32 %0, %1, %2":"=v"(r):"v"(a),"v"(b));return r;}
__device__ __forceinline__ float fsub_s(float a,float b){float r;asm("v_sub_f32_e32 %0, %1, %2":"=v"(r):"v"(a),"v"(b));return r;}
typedef float f32x2_t __attribute__((ext_vector_type(2))); typedef __bf16 bf16x2_t __attribute__((ext_vector_type(2)));
__device__ __forceinline__ unsigned cvtpk_s(float lo,float hi){f32x2_t v={lo,hi};bf16x2_t b=__builtin_convertvector(v,bf16x2_t);return __builtin_bit_cast(unsigned,b);}
#define WAIT_BAR(N) asm volatile("s_waitcnt vmcnt(" #N ") lgkmcnt(0)\n\ts_barrier":::"memory")

__device__ __forceinline__ void qkt(f32x16&p0,f32x16&p1,const char*Kslot,const bf16x8*qr,const f32x16&negm,int r32,int hi){
  const char*kb=Kslot+hi*1024+r32*16;
  #pragma unroll
  for(int d0=0;d0<4;++d0){
    const bf16x8 b0=*reinterpret_cast<const bf16x8*>(kb+d0*2048);
    const bf16x8 b1=*reinterpret_cast<const bf16x8*>(kb+d0*2048+512);
    if(d0==0){p0=__builtin_amdgcn_mfma_f32_32x32x16_bf16(b0,qr[0],negm,0,0,0);p1=__builtin_amdgcn_mfma_f32_32x32x16_bf16(b1,qr[0],negm,0,0,0);}
    else{p0=__builtin_amdgcn_mfma_f32_32x32x16_bf16(b0,qr[d0],p0,0,0,0);p1=__builtin_amdgcn_mfma_f32_32x32x16_bf16(b1,qr[d0],p1,0,0,0);}}
}
typedef __attribute__((address_space(3))) const char* lds_cptr;
typedef short v4i16_t __attribute__((ext_vector_type(4)));
__device__ __forceinline__ void kload8(bf16x8*kf,lds_cptr kp){
  kf[0]=*(const __attribute__((address_space(3))) bf16x8*)(kp);      kf[1]=*(const __attribute__((address_space(3))) bf16x8*)(kp+512);
  kf[2]=*(const __attribute__((address_space(3))) bf16x8*)(kp+2048); kf[3]=*(const __attribute__((address_space(3))) bf16x8*)(kp+2560);
  kf[4]=*(const __attribute__((address_space(3))) bf16x8*)(kp+4096); kf[5]=*(const __attribute__((address_space(3))) bf16x8*)(kp+4608);
  kf[6]=*(const __attribute__((address_space(3))) bf16x8*)(kp+6144); kf[7]=*(const __attribute__((address_space(3))) bf16x8*)(kp+6656);
}
__device__ __forceinline__ void kload2(bf16x8*kf,lds_cptr kp,int j){ kf[2*j]=*(const __attribute__((address_space(3))) bf16x8*)(kp+j*2048); kf[2*j+1]=*(const __attribute__((address_space(3))) bf16x8*)(kp+j*2048+512); }
__device__ __forceinline__ s16x4 vtr(lds_cptr p){ return __builtin_bit_cast(s16x4,__builtin_amdgcn_ds_read_tr16_b64_v4i16((__attribute__((address_space(3))) v4i16_t*)p)); }
__device__ __forceinline__ float rowmax(const f32x16&p0,const f32x16&p1){
  float a=max3f(p0[0],p0[1],p1[0]),b=max3f(p0[2],p0[3],p1[1]);a=max3f(a,p1[2],p1[3]);
  #pragma unroll
  for(int r=4;r<16;r+=4){a=max3f(a,p0[r],p0[r+1]);b=max3f(b,p0[r+2],p0[r+3]);a=max3f(a,p1[r],p1[r+1]);b=max3f(b,p1[r+2],p1[r+3]);}
  const float m=max2f(a,b);
  auto rr=__builtin_amdgcn_permlane32_swap(__float_as_uint(m),__float_as_uint(m),false,false);
  return max2f(__uint_as_float(rr[0]),__uint_as_float(rr[1]));
}
__device__ __forceinline__ void pv(f32x16*o,int vb,bf16x8 pa0,bf16x8 pa1,bf16x8 pa2,bf16x8 pa3){
  #pragma unroll
  for(int d0=0;d0<2;++d0){s16x4 lo[4],hi[4];
    #pragma unroll
    for(int ks=0;ks<4;++ks){
      asm volatile("ds_read_b64_tr_b16 %0,%1 offset:%c2":"=&v"(lo[ks]):"v"(vb),"i"(d0*4096+ks*1024):"memory");
      asm volatile("ds_read_b64_tr_b16 %0,%1 offset:%c2":"=&v"(hi[ks]):"v"(vb),"i"(d0*4096+ks*1024+512):"memory");}
    asm volatile("s_waitcnt lgkmcnt(0)":::"memory");SBAR();
    #define PK(k) (bf16x8){lo[k][0],lo[k][1],lo[k][2],lo[k][3],hi[k][0],hi[k][1],hi[k][2],hi[k][3]}
    o[d0]=__builtin_amdgcn_mfma_f32_32x32x16_bf16(pa0,PK(0),o[d0],0,0,0);
    o[d0]=__builtin_amdgcn_mfma_f32_32x32x16_bf16(pa1,PK(1),o[d0],0,0,0);
    o[d0]=__builtin_amdgcn_mfma_f32_32x32x16_bf16(pa2,PK(2),o[d0],0,0,0);
    o[d0]=__builtin_amdgcn_mfma_f32_32x32x16_bf16(pa3,PK(3),o[d0],0,0,0);
    #undef PK
  }
}

#ifndef ATTN_STORE16
#define ATTN_STORE16(p,v) (*(u32x4*)(p)=(v))
#endif
typedef const __attribute__((address_space(3))) float* lds_cf32;
typedef float f32x4_t __attribute__((ext_vector_type(4)));
template<int THRL> __device__ __forceinline__ void attn_unit(int b,int h,int qb,const bf16*Q,const bf16*__restrict__ K,const bf16*__restrict__ V,bf16*O,const bf16*__restrict__ G,lds_cf32 cs_abs,int t0,unsigned*qhead,__attribute__((address_space(3))) unsigned*wq,const int*T0tab,const float*C2tab,unsigned csn_off,char*shm){
  const lds_cf32 cs=cs_abs+64*t0;
  int tid=threadIdx.x; asm volatile("":"+v"(tid));   const int lane=tid&63,r32=lane&31,hi=lane>>5; const int wid=__builtin_amdgcn_readfirstlane(tid>>6);
  const long rowbase=(long)b*SEQ; const int q0=qb*QB;
  const bf16*Qw=Q+(rowbase+q0+wid*QBLK)*DM+h*D;
  const bf16*Kh=K+(rowbase+(long)t0*KVBLK)*DM+h*D,*Vh=V+(rowbase+(long)t0*KVBLK)*DM+h*D;
  const unsigned lds0=(unsigned)(uintptr_t)shm;
  float*wsf=(float*)(shm+LDS_WS)+wid*64;
  const unsigned kvoff=(unsigned)((lane*DM+wid*8)*2);
  const unsigned vvoff=(unsigned)(((16*(wid&3)+(lane>>2))*DM+(wid>>2)*32+(lane&3)*8)*2);
  const unsigned kdst=lds0+LDS_K+wid*1024, vdst=lds0+LDS_V+wid*1024;
  #define DMA_K(t,slot) glds16s(Kh+(long)(t)*KVBLK*DM,kvoff,(unsigned)__builtin_amdgcn_readfirstlane(kdst+(slot)))
  #define DMA_V(t,slot) glds16s(Vh+(long)(t)*KVBLK*DM,vvoff,(unsigned)__builtin_amdgcn_readfirstlane(vdst+(slot)))
  const int vb0=(int)(lds0+LDS_V)+((lane>>4)&1)*32+(lane&3)*8+(4*hi+((lane&15)>>2))*64;
  const char*Kbase=shm+LDS_K; bf16x8 kf[8];
  const lds_cptr shm3=(lds_cptr)shm; const lds_cptr kp0=shm3+LDS_K+hi*1024+r32*16; const lds_cptr vp0=shm3+LDS_V+((lane>>4)&1)*32+(lane&3)*8+(4*hi+((lane&15)>>2))*64;
  const int NT=(q0+QB)/KVBLK-t0;
  DMA_K(0,0);DMA_V(0,0);DMA_K(1,SLOTB);
  bf16x8 qr[4];
  #pragma unroll
  for(int d0=0;d0<4;++d0)qr[d0]=*reinterpret_cast<const bf16x8*>(&Qw[(long)r32*DM+d0*16+hi*8]);
  const int qrel=wid*QBLK+r32;
  #define ct2 (cs_abs[q0+qrel])
  float mhat=0.f,l_reg=0.f;f32x16 o[2];o[0]=f32x16{};o[1]=f32x16{};f32x16 negm;
  #define KBIAS(P0,P1,t) do{ const __attribute__((address_space(3))) f32x4_t* cb_=(const __attribute__((address_space(3))) f32x4_t*)(cs+64*(t)); \
    _Pragma("unroll") for(int g_=0;g_<4;++g_){ const f32x4_t a_=cb_[2*g_+hi], b_=cb_[8+2*g_+hi]; \
      P0[4*g_+0]-=a_[0];P0[4*g_+1]-=a_[1];P0[4*g_+2]-=a_[2];P0[4*g_+3]-=a_[3]; P1[4*g_+0]-=b_[0];P1[4*g_+1]-=b_[1];P1[4*g_+2]-=b_[2];P1[4*g_+3]-=b_[3]; } }while(0)
  #define CMASK(P0,P1,t) do{int jb_=(t)-(NT-4); if(jb_>=0)cmask(P0,P1,jb_,qrel,hi);}while(0)
  bool resc=false;
  #define START(P0,P1) do{ const float rm=rowmax(P0,P1); resc=false; \
    { const float dl=rm; mhat=fadd_s(mhat,dl); \
      _Pragma("unroll") for(int r=0;r<16;++r){P0[r]=fsub_s(P0[r],dl);P1[r]=fsub_s(P1[r],dl);} \
      _Pragma("unroll") for(int r=0;r<16;++r)negm[r]=ct2-mhat; asm volatile("":"+v"(negm)); } \
    _Pragma("unroll") for(int r=0;r<16;++r)P0[r]=__builtin_amdgcn_exp2f(P0[r]); }while(0)
  #define RESC() do{ if(resc){ asm volatile("s_waitcnt lgkmcnt(0)":::"memory"); \
      asm volatile("s_nop 15\n\ts_nop 7":"+v"(o[0]),"+v"(o[1])); \
      _Pragma("unroll") for(int d_=0;d_<2;++d_) _Pragma("unroll") for(int r=0;r<16;++r)o[d_][r]=fmul_s(o[d_][r],wsf[crow(r,hi)]); } }while(0)
  f32x16 pA0,pA1,pB0,pB1;
  int sl_prev=0,sl_cur=0,sl_next=SLOTB;
  #define ROT() do{sl_prev=sl_cur;sl_cur=sl_next;sl_next=(sl_next==(NSLOT-1)*SLOTB)?0:sl_next+SLOTB;}while(0)
  DMA_K(2,2*SLOTB);
  unsigned nres_=0u; if(tid==0)nres_=__hip_atomic_fetch_add(qhead,1u,__ATOMIC_RELAXED,__HIP_MEMORY_SCOPE_AGENT);
  WAIT_BAR(3);
  _Pragma("unroll") for(int r=0;r<16;++r)negm[r]=ct2; asm volatile("":"+v"(negm));
  qkt(pA0,pA1,Kbase,qr,negm,r32,hi);asm volatile("s_nop 15\n\ts_nop 7":"+v"(pA0),"+v"(pA1));KBIAS(pA0,pA1,0);CMASK(pA0,pA1,0);
  START(pA0,pA1);
  _Pragma("unroll") for(int r=0;r<16;++r)pA1[r]=__builtin_amdgcn_exp2f(pA1[r]);
  if(tid==0)wq[2]=nres_;
  WAIT_BAR(0);
  DMA_K(3,0);DMA_V(1,SLOTB);
  ROT();
  kload8(kf,kp0+sl_cur);
  WAIT_BAR(2);
  s16x4 vlo[8],vhi[8]; u32x4 pw0,pw1,pw2,pw3;
  f32x4_t kbA0,kbA1,kbA2,kbA3,kbB0,kbB1,kbB2,kbB3;
  #define KBPTR(t) ((const __attribute__((address_space(3))) f32x4_t*)(cs+64*(t))+hi)
  #define KBLD_A(t) do{ kbA0=KBPTR(t)[0]; kbA1=KBPTR(t)[2]; kbA2=KBPTR(t)[4]; kbA3=KBPTR(t)[6]; SBAR(); }while(0)
  #define KBLD_B(t) do{ kbB0=KBPTR(t)[8]; kbB1=KBPTR(t)[10]; kbB2=KBPTR(t)[12]; kbB3=KBPTR(t)[14]; SBAR(); }while(0)
  #define KBS4(P,B,K) P[B]=fsub_s(P[B],K[0]);P[B+1]=fsub_s(P[B+1],K[1]);P[B+2]=fsub_s(P[B+2],K[2]);P[B+3]=fsub_s(P[B+3],K[3])
  #define KBSUB(C0,C1) do{ asm volatile("s_nop 15\n\ts_nop 7":"+v"(C0),"+v"(C1));   KBS4(C0,0,kbA0);KBS4(C0,4,kbA1);KBS4(C0,8,kbA2);KBS4(C0,12,kbA3);KBS4(C1,0,kbB0);KBS4(C1,4,kbB1);KBS4(C1,8,kbB2);KBS4(C1,12,kbB3); }while(0)
  #define PKW(P,B) cvtpk_s(P[B],P[B+1])
  #define PAF(k) __builtin_bit_cast(bf16x8,pw##k)
  #define VFR(i) (bf16x8){vlo[i][0],vlo[i][1],vlo[i][2],vlo[i][3],vhi[i][0],vhi[i][1],vhi[i][2],vhi[i][3]}
  #define PIN(x) asm volatile("":"+v"(x))
  #define MX3(a,b,c) __builtin_fmaxf(__builtin_fmaxf((a),(b)),(c))
  #define GAPA(MF,A0,A1,A2,A3,W0,W1,PW) do{ MF; sacc+=A0; sacc+=A1; sacc+=A2; sacc+=A3; PIN(sacc); W0; W1; PIN(PW); SBAR(); }while(0)
  #define EX(v) __builtin_amdgcn_exp2f(v)
  #define GAPB(MF,X,B) do{ MF; X[B]=EX(X[B]); X[B+1]=EX(X[B+1]); X[B+2]=EX(X[B+2]); X[B+3]=EX(X[B+3]); PIN(X); SBAR(); }while(0)
  #define VRD(i) do{ vlo[i]=vtr(vp_+(((i)>>2)*4096+((i)&3)*1024)); vhi[i]=vtr(vp_+(((i)>>2)*4096+((i)&3)*1024+512)); }while(0)
  #define KRD(G,j) do{ if(G){ kload2(kf,kp0+sl_next,j); SBAR(); } }while(0)
  #define STEP(C0,C1,P0,P1,t,GK,GV,GL) do{ SBAR(); \
    const lds_cptr vp_=vp0+sl_prev; \
    VRD(0); SBAR(); float sacc=(P0[0]+P0[1]); \
    GAPA(C0=__builtin_amdgcn_mfma_f32_32x32x16_bf16(kf[0],qr[0],negm,0,0,0), P0[2],P0[3],P0[4],P0[5],     pw0[0]=PKW(P0,0), pw0[1]=PKW(P0,2), pw0); \
    VRD(4); SBAR(); GAPA(C1=__builtin_amdgcn_mfma_f32_32x32x16_bf16(kf[1],qr[0],negm,0,0,0), P0[6],P0[7],P0[8],P0[9],     pw0[2]=PKW(P0,4), pw0[3]=PKW(P0,6), pw0); \
    VRD(1); SBAR(); GAPA(C0=__builtin_amdgcn_mfma_f32_32x32x16_bf16(kf[2],qr[1],C0,0,0,0),   P0[10],P0[11],P0[12],P0[13], pw1[0]=PKW(P0,8), pw1[1]=PKW(P0,10), pw1); \
    VRD(5); SBAR(); GAPA(C1=__builtin_amdgcn_mfma_f32_32x32x16_bf16(kf[3],qr[1],C1,0,0,0),   P0[14],P0[15],P1[0],P1[1],   pw1[2]=PKW(P0,12),pw1[3]=PKW(P0,14), pw1); \
    KBLD_A(t); \
    VRD(2); SBAR(); GAPA(C0=__builtin_amdgcn_mfma_f32_32x32x16_bf16(kf[4],qr[2],C0,0,0,0),   P1[2],P1[3],P1[4],P1[5],     pw2[0]=PKW(P1,0), pw2[1]=PKW(P1,2), pw2); \
    VRD(6); SBAR(); GAPA(C1=__builtin_amdgcn_mfma_f32_32x32x16_bf16(kf[5],qr[2],C1,0,0,0),   P1[6],P1[7],P1[8],P1[9],     pw2[2]=PKW(P1,4), pw2[3]=PKW(P1,6), pw2); \
    VRD(3); SBAR(); GAPA(C0=__builtin_amdgcn_mfma_f32_32x32x16_bf16(kf[6],qr[3],C0,0,0,0),   P1[10],P1[11],P1[12],P1[13], pw3[0]=PKW(P1,8), pw3[1]=PKW(P1,10), pw3); \
    VRD(7); SBAR(); GAPA(C1=__builtin_amdgcn_mfma_f32_32x32x16_bf16(kf[7],qr[3],C1,0,0,0),   P1[14],P1[15],0.f,0.f,       pw3[2]=PKW(P1,12),pw3[3]=PKW(P1,14), pw3); \
    KBLD_B(t); \
    l_reg+=sacc; \
    if(GK){DMA_K((t)+3,sl_cur);} if(GV){DMA_V((t)+1,sl_next);} \
    KBSUB(C0,C1); CMASK(C0,C1,t); \
    { float a=MX3(C0[0],C0[1],C1[0]),b=MX3(C0[2],C0[3],C1[1]); a=MX3(a,C1[2],C1[3]); \
      _Pragma("unroll") for(int r=4;r<16;r+=4){a=MX3(a,C0[r],C0[r+1]);b=MX3(b,C0[r+2],C0[r+3]);a=MX3(a,C1[r],C1[r+1]);b=MX3(b,C1[r+2],C1[r+3]);} \
      float rm=__builtin_fmaxf(a,b); { auto rr=__builtin_amdgcn_permlane32_swap(__float_as_uint(rm),__float_as_uint(rm),false,false); rm=__builtin_fmaxf(__uint_as_float(rr[0]),__uint_as_float(rr[1])); } \
      resc=false; \
      if(__builtin_expect(__any(rm>(float)THRL),0)){ const float dl=__builtin_fmaxf(rm,0.f); mhat+=dl; \
        _Pragma("unroll") for(int r=0;r<16;++r){C0[r]-=dl;C1[r]-=dl;} \
        _Pragma("unroll") for(int r=0;r<16;++r)negm[r]=ct2-mhat; asm volatile("":"+v"(negm)); \
        const float f=__builtin_amdgcn_exp2f(-dl); l_reg*=f; if(hi==0)wsf[r32]=f; resc=true; } } \
    SBAR(); \
    GAPB(o[0]=__builtin_amdgcn_mfma_f32_32x32x16_bf16(PAF(0),VFR(0),o[0],0,0,0), C0,0); \
    GAPB(o[1]=__builtin_amdgcn_mfma_f32_32x32x16_bf16(PAF(0),VFR(4),o[1],0,0,0), C0,4); \
    KRD(GL,0); GAPB(o[0]=__builtin_amdgcn_mfma_f32_32x32x16_bf16(PAF(1),VFR(1),o[0],0,0,0), C0,8); \
    KRD(GL,1); GAPB(o[1]=__builtin_amdgcn_mfma_f32_32x32x16_bf16(PAF(1),VFR(5),o[1],0,0,0), C0,12); \
    KRD(GL,2); GAPB(o[0]=__builtin_amdgcn_mfma_f32_32x32x16_bf16(PAF(2),VFR(2),o[0],0,0,0), C1,0); \
    KRD(GL,3); GAPB(o[1]=__builtin_amdgcn_mfma_f32_32x32x16_bf16(PAF(2),VFR(6),o[1],0,0,0), C1,4); \
    GAPB(o[0]=__builtin_amdgcn_mfma_f32_32x32x16_bf16(PAF(3),VFR(3),o[0],0,0,0), C1,8); \
    GAPB(o[1]=__builtin_amdgcn_mfma_f32_32x32x16_bf16(PAF(3),VFR(7),o[1],0,0,0), C1,12); \
    }while(0)
  int t=1;
  #undef CMASK
  #define CMASK(P0,P1,t) do{}while(0)
  for(;t+5<NT;t+=2){
    STEP(pB0,pB1,pA0,pA1,t,true,true,true);     WAIT_BAR(2); RESC(); ROT();
    STEP(pA0,pA1,pB0,pB1,t+1,true,true,true);   WAIT_BAR(2); RESC(); ROT();
  }
  #undef CMASK
  #define CMASK(P0,P1,t) do{int jb_=(t)-(NT-4); if(jb_>=0)cmask(P0,P1,jb_,qrel,hi);}while(0)
  #define ENDW(tt) do{ if((tt)+3<NT){WAIT_BAR(2);} else if((tt)+2<NT){WAIT_BAR(1);} else {WAIT_BAR(0);} }while(0)
  for(;t+1<NT;t+=2){
    STEP(pB0,pB1,pA0,pA1,t,(t+3<NT),(t+1<NT),(t+1<NT));       ENDW(t);   RESC(); ROT();
    STEP(pA0,pA1,pB0,pB1,t+1,(t+4<NT),(t+2<NT),(t+2<NT));     ENDW(t+1); RESC(); ROT();
  }
  STEP(pB0,pB1,pA0,pA1,NT-1,false,false,false); RESC();
  { float sacc=pB0[0]+pB0[1]; _Pragma("unroll") for(int r=2;r<16;++r)sacc+=pB0[r]; _Pragma("unroll") for(int r=0;r<16;++r)sacc+=pB1[r]; l_reg+=sacc;
    pw0=(u32x4){PKW(pB0,0),PKW(pB0,2),PKW(pB0,4),PKW(pB0,6)};pw1=(u32x4){PKW(pB0,8),PKW(pB0,10),PKW(pB0,12),PKW(pB0,14)};pw2=(u32x4){PKW(pB1,0),PKW(pB1,2),PKW(pB1,4),PKW(pB1,6)};pw3=(u32x4){PKW(pB1,8),PKW(pB1,10),PKW(pB1,12),PKW(pB1,14)};
    SBAR(); pv(o,vb0+sl_cur,PAF(0),PAF(1),PAF(2),PAF(3)); }
  #undef KBPTR
  #undef KBLD_A
  #undef KBLD_B
  #undef KBS4
  #undef KBSUB
  #undef PKW
  #undef PAF
  #undef VFR
  #undef PIN
  #undef MX3
  #undef GAPA
  #undef GAPB
  #undef EX
  #undef VRD
  #undef KRD
  #undef STEP
  #undef ENDW
  {auto rr=__builtin_amdgcn_permlane32_swap(__float_as_uint(l_reg),__float_as_uint(l_reg),false,false);l_reg=__uint_as_float(rr[0])+__uint_as_float(rr[1]);}
  int lane_e=lane; asm volatile("":"+v"(lane_e)); const int r32e=lane_e&31,hie=lane_e>>5;
  const unsigned nxt_=(unsigned)__builtin_amdgcn_readfirstlane((int)wq[2]); int t0n_=0; if(tid==0){ if(nxt_<4096u)t0n_=((const __attribute__((address_space(1))) int*)T0tab)[(nxt_&255u)*16u+15u-(nxt_>>8)];}
  u32x4 gpre[4]; { const bf16*Gp=G+(rowbase+q0+wid*QBLK)*DM+h*D;
    #pragma unroll
    for(int i=0;i<4;++i)gpre[i]=*(const u32x4*)(Gp+(long)(i*8+(lane_e>>3))*DM+(lane_e&7)*8); }
  if(hie==0)wsf[32+r32e]=l_reg;asm volatile("s_waitcnt lgkmcnt(0)":::"memory");
  float rli[16];
  #pragma unroll
  for(int r=0;r<16;++r)rli[r]=__builtin_amdgcn_rcpf(wsf[32+crow(r,hie)]);
  bf16*Ow=O+(rowbase+q0+wid*QBLK)*DM+h*D;
  { bf16*stg=(bf16*)(shm+LDS_OST)+wid*2048;
    #pragma unroll
    for(int r=0;r<16;++r){const int orow=crow(r,hie);
      #pragma unroll
      for(int d0=0;d0<2;++d0)stg[orow*64+d0*32+r32e]=__float2bfloat16(o[d0][r]*rli[r]);}
    asm volatile("s_waitcnt lgkmcnt(0)":::"memory");
    const bf16*Gw=G+(rowbase+q0+wid*QBLK)*DM+h*D;
    #pragma unroll
    for(int i=0;i<4;++i){const int row=i*8+(lane_e>>3),ch=lane_e&7; const u32x4 v=*(const u32x4*)(stg+row*64+ch*8); const u32x4 gv=gpre[i]; u32x4 w;
      #pragma unroll
      for(int e=0;e<4;++e){ const float o0=__uint_as_float(v[e]<<16),o1=__uint_as_float(v[e]&0xffff0000u),g0=__uint_as_float(gv[e]<<16),g1=__uint_as_float(gv[e]&0xffff0000u);
        const float s0=__builtin_amdgcn_rcpf(1.f+__builtin_amdgcn_exp2f(-1.4426950408889634f*g0)),s1=__builtin_amdgcn_rcpf(1.f+__builtin_amdgcn_exp2f(-1.4426950408889634f*g1)); w[e]=cvtpk_s(o0*s0,o1*s1); }
      ATTN_STORE16(Ow+(long)row*DM+ch*8,w);} }
  if(nxt_<4096u){ const char*c2n_=(const char*)(C2tab+(size_t)(nxt_&255u)*4096u); const unsigned cd_=(unsigned)__builtin_amdgcn_readfirstlane((int)(lds0+csn_off+(unsigned)wid*2048u));
    glds16s(c2n_,(unsigned)(wid*2048+lane_e*16),cd_); glds16s(c2n_,(unsigned)(wid*2048+1024+lane_e*16),cd_+1024u); }
  if(tid==0){wq[0]=nxt_;wq[1]=(unsigned)t0n_;}
  asm volatile("s_waitcnt lgkmcnt(0)\n\ts_barrier":::"memory");
  #undef KBIAS
  #undef ct2
  #undef DMA_K
  #undef DMA_V
  #undef CMASK
  #undef START
  #undef RESC
  #undef ROT
}
constexpr int ATTN_LDS_BYTES=LDS_BYTES;
struct AttnTensors { const bf16* Q; const bf16* K; const bf16* V; bf16* O; const bf16* G; };
struct AttnUnit { int bh; int qb; };
#undef SBAR
#undef WAIT_BAR
}
#define GAS __attribute__((address_space(1)))
#define LAS __attribute__((address_space(3)))
typedef unsigned short bf16;
typedef unsigned v4u __attribute__((ext_vector_type(4)));
typedef float f32x4 __attribute__((ext_vector_type(4)));
typedef short bf16x8 __attribute__((ext_vector_type(8)));
typedef GAS unsigned gu32;
typedef GAS unsigned long long gu64;
#define RLX_AGENT __ATOMIC_RELAXED, __HIP_MEMORY_SCOPE_AGENT
#define LDS_WAIT() asm volatile("s_waitcnt lgkmcnt(0)" ::: "memory")
#define VM_WAIT() asm volatile("s_waitcnt vmcnt(0)" ::: "memory")
__device__ __forceinline__ unsigned long long rt() { return __builtin_amdgcn_s_memrealtime(); }
__device__ __forceinline__ unsigned f2bf(float f) { unsigned u = __builtin_bit_cast(unsigned, f); return (u + 0x7fffu + ((u >> 16) & 1u)) >> 16; }
__device__ __forceinline__ unsigned pk2(float lo, float hi) { return f2bf(lo) | (f2bf(hi) << 16); }

#define XB_TMO      128
#define XB_XCNT(j)  (256  + 64 * (j))
#define XB_XSUB(j)  (1280 + 64 * (j))
#define XB_XGEN(j)  (2304 + 64 * (j))
#define XB_TOP      3328
#define XB_TOPGEN   3392
#define XCD_BAR_WORDS 3456
#define XB_SPIN_CAP (1u << 18)

__device__ __forceinline__ unsigned xb_ld(unsigned* p)              { return __hip_atomic_load(p, __ATOMIC_RELAXED, __HIP_MEMORY_SCOPE_AGENT); }
__device__ __forceinline__ unsigned xb_add(unsigned* p, unsigned v) { return __hip_atomic_fetch_add(p, v, __ATOMIC_RELAXED, __HIP_MEMORY_SCOPE_AGENT); }
__device__ __forceinline__ unsigned xb_xcc_id() { return (unsigned)__builtin_amdgcn_s_getreg((3 << 11) | 20) & 0xFu; }
#define XB_SPIN(cond, bar) do { unsigned _sp = 0; while (cond) { __builtin_amdgcn_s_sleep(1); \
    if ((++_sp & 255u) == 0u) { if (xb_ld(&(bar)[XB_TMO])) break; if (_sp > XB_SPIN_CAP) { atomicAdd(&(bar)[XB_TMO], 1u); break; } } } } while (0)

struct XcdBarrier {
    unsigned* bar; unsigned x;
    volatile LAS unsigned* st;
};

__device__ __forceinline__ XcdBarrier xcd_barrier_post(unsigned* bar, volatile LAS unsigned* st) {
    XcdBarrier b; b.bar = bar; b.x = xb_xcc_id(); b.st = st;
    if (threadIdx.x == 0) (void)xb_add(&bar[XB_XCNT(b.x)], 1u);
    return b;
}
__device__ __forceinline__ void xcd_barrier_complete(unsigned* bar, unsigned x, unsigned& nloc, unsigned& nx) {
    const unsigned G = gridDim.x * gridDim.y * gridDim.z;
    unsigned sum, cnt, mine, sp = 0u;
    for (;;) {
        sum = 0u; cnt = 0u; mine = 0u;
#pragma unroll
        for (unsigned j = 0; j < 16; ++j) { const unsigned c = xb_ld(&bar[XB_XCNT(j)]); sum += c; cnt += (c > 0u) ? 1u : 0u; mine = (j == x) ? c : mine; }
        if (sum == G) break;
        __builtin_amdgcn_s_sleep(1);
        if ((++sp & 255u) == 0u) { if (xb_ld(&bar[XB_TMO])) break; if (sp > XB_SPIN_CAP) { atomicAdd(&bar[XB_TMO], 1u); break; } }
    }
    nloc = mine > 0u ? mine : 1u; nx = cnt > 0u ? cnt : 1u;
}

#define XB_LSUB(j)  (3520 + 64 * (j))
#define XB_LGEN(j)  (4096 + 64 * (j))
__device__ __forceinline__ void xcc_local_barrier(unsigned* bar, unsigned x, unsigned nloc) {
    asm volatile("s_waitcnt vmcnt(0)" ::: "memory");
    __syncthreads();
    if (threadIdx.x == 0) {
        __builtin_amdgcn_s_waitcnt(0);
        const unsigned old = xb_add(&bar[XB_LSUB(x)], 1u);
        const unsigned gen = old / nloc;
        if (old + 1u == (gen + 1u) * nloc) xb_add(&bar[XB_LGEN(x)], 1u);
        else XB_SPIN(xb_ld(&bar[XB_LGEN(x)]) == gen, bar);
        __builtin_amdgcn_fence(__ATOMIC_ACQUIRE, "agent");
        asm volatile("s_waitcnt vmcnt(0)" ::: "memory");
    }
    __syncthreads();
}

__device__ __forceinline__ void xcd_barrier(const XcdBarrier& b) {
    asm volatile("s_waitcnt vmcnt(0)" ::: "memory");
    __syncthreads();
    if (threadIdx.x == 0) {
        unsigned* bar = b.bar;
        __builtin_amdgcn_s_waitcnt(0);
        unsigned nloc = b.st[0], nx = b.st[1];
        if (nloc == 0u) { xcd_barrier_complete(bar, b.x, nloc, nx); b.st[0] = nloc; b.st[1] = nx; }
        const unsigned old = xb_add(&bar[XB_XSUB(b.x)], 1u);
        const unsigned gen = old / nloc;
        if (old + 1u == (gen + 1u) * nloc) {
            __builtin_amdgcn_fence(__ATOMIC_RELEASE, "agent");
            asm volatile("s_waitcnt vmcnt(0)" ::: "memory");
            const unsigned og = xb_add(&bar[XB_TOP], 1u);
            const unsigned tg = og / nx;
            if (og + 1u == (tg + 1u) * nx) xb_add(&bar[XB_TOPGEN], 1u);
            else XB_SPIN(xb_ld(&bar[XB_TOPGEN]) == tg, bar);
            __builtin_amdgcn_fence(__ATOMIC_ACQUIRE, "agent");
            xb_add(&bar[XB_XGEN(b.x)], 1u);
            asm volatile("s_waitcnt vmcnt(0)" ::: "memory");
        } else {
            XB_SPIN(xb_ld(&bar[XB_XGEN(b.x)]) == gen, bar);
            __builtin_amdgcn_fence(__ATOMIC_ACQUIRE, "agent");
            asm volatile("s_waitcnt vmcnt(0)" ::: "memory");
        }
    }
    __syncthreads();
}

#ifndef GROUP_LOCAL_SYNC
#define GROUP_LOCAL_SYNC 0
#endif
constexpr int NWAVES = 8;
constexpr int BATCH = 16, SEQ = 4096, D = 1024, M = BATCH * SEQ;
constexpr int MH = 8, DK = 64, DV = 128, LCH = 64, NCH = SEQ / LCH;
constexpr int MIN_N = 3088, MIN_NP = 3328, MIN_LD = 3072;
constexpr int FH = 16;
constexpr int DFF = 2816, DFF2 = 5632;
constexpr int KV_N = 2064, KV_NP = 2304;
constexpr int MHALF = M / 2;
constexpr float EPS = 1e-6f;
constexpr float LOG2E = 1.4426950408889634f;

constexpr size_t MiB = 1u << 20;
constexpr size_t WS_CTL = 0, CTL_ZERO_BYTES = 1 * MiB;
constexpr size_t WS_GATES = 2 * MiB;
constexpr size_t WS_RSTD = 6 * MiB;
constexpr size_t WS_KMAX = 6 * MiB + 512 * 1024, WS_QMAX = WS_KMAX + 65536;
constexpr size_t WS_T0 = WS_QMAX + 32768;
constexpr size_t WS_W = 8 * MiB;
constexpr size_t SZ_WIN = (size_t)MIN_NP * D * 2, SZ_SQ = (size_t)D * D * 2, SZ_WKV = (size_t)KV_NP * D * 2, SZ_WQG = (size_t)2 * D * D * 2, SZ_WUP = (size_t)DFF2 * D * 2, SZ_WDN = (size_t)D * DFF * 2;
constexpr size_t WS_WIN = WS_W, WS_WMOUT = WS_WIN + 2 * SZ_WIN, WS_WKV = WS_WMOUT + 2 * SZ_SQ, WS_WQG = WS_WKV + SZ_WKV, WS_WFOUT = WS_WQG + 2 * SZ_WQG,
                 WS_WUP = WS_WFOUT + 2 * SZ_SQ, WS_WDN = WS_WUP + 4 * SZ_WUP, WS_WEND = WS_WDN + 4 * SZ_WDN;
constexpr size_t WS_C2 = 108 * MiB;
constexpr size_t WS_XH = 112 * MiB;
constexpr size_t WS_KB = 240 * MiB, WS_VB = 368 * MiB;
constexpr size_t WS_S = 496 * MiB;
constexpr size_t SLAB_BYTES = 64 * MiB;
constexpr size_t SO_QKVO = 0, SO_HA = 48 * MiB;
constexpr size_t SO_FQ = 0, SO_FG = 16 * MiB;
constexpr size_t SO_YM_A = 0, SO_YM_B = 32 * MiB, SO_YF = 48 * MiB;
constexpr size_t SO_ACT = 0, SO_HALO = 44 * MiB;
constexpr size_t SH_ROW1K = (size_t)8192 * D * 2, SH_QKVO = (size_t)8192 * MIN_LD * 2, SH_ACT = (size_t)8192 * DFF * 2, SH_HALO = (size_t)32 * 4 * DFF2 * 4;
static_assert(SH_QKVO <= SO_HA && SH_ACT <= SO_HALO && SO_HALO + SH_HALO <= SO_YF && SO_YF + SH_ROW1K <= SLAB_BYTES && SO_FG + SH_ROW1K <= SO_YM_B, "slab map");
#define SLAB(off, share) (ws + WS_S + (size_t)(off) + (size_t)xg * (SLAB_BYTES - (size_t)(share)))
constexpr size_t WS_SUMS = 1008 * MiB;
constexpr size_t WS_END = 1024 * MiB;
static_assert(WS_WEND <= WS_C2 && WS_S + 8 * SLAB_BYTES <= WS_END, "d_ws map");
constexpr int CW_TMO = 0, CW_BAR = 4096, CW_NCNT = 32768, CW_QUEUE = 65536;

constexpr int RING_OFF = 0, RING_BYTES = 131072;
constexpr int LDSCTL_OFF = RING_BYTES, MISC_OFF = LDSCTL_OFF + 320;
constexpr int LDS_BYTES = 147456;
constexpr int XCH_OFF = RING_BYTES + 1024;
static_assert(XCH_OFF + 8192 + 512 <= LDS_BYTES, "lds map");

__device__ __forceinline__ float wave_sum(float v) {
#pragma unroll
    for (int o = 1; o < 64; o <<= 1) v += __shfl_xor(v, o);
    return v;
}
__device__ __forceinline__ float bf_lo(unsigned w) { return __uint_as_float(w << 16); }
__device__ __forceinline__ float bf_hi(unsigned w) { return __uint_as_float(w & 0xffff0000u); }
__device__ __forceinline__ unsigned cvtpk(float lo, float hi) { typedef float f2 __attribute__((ext_vector_type(2))); typedef __bf16 b2 __attribute__((ext_vector_type(2))); f2 v = {lo, hi}; b2 b = __builtin_convertvector(v, b2); return __builtin_bit_cast(unsigned, b); }
#define BAR_LDS() do { asm volatile("s_waitcnt lgkmcnt(0)" ::: "memory"); __builtin_amdgcn_s_barrier(); asm volatile("" ::: "memory"); } while (0)

namespace pg8 {
struct EpiOut {
    static constexpr bool PERM = true, AFTER_DRAIN = false;
    bf16_t* O; int ldc; int split_cols; size_t split_stride; float scale0; int gate_tile; float* Gt; const float* rs;
    int* T0 = nullptr; const float* C2v = nullptr; const float* KMX = nullptr; PG8_LAS float* P = nullptr;
    __device__ __forceinline__ void operator()(const f32x4 (&acc)[2][2][4][2], const Unit& u, int wr, int wc, int fr, int fq) const {
        const int row0 = u.pm * BM + wr * 64 + fr;
        float rsc[2][4];
#pragma unroll
        for (int ai = 0; ai < 2; ++ai)
#pragma unroll
            for (int m = 0; m < 4; ++m) rsc[ai][m] = rs ? rs[row0 + ai * HALF + m * 16] : 1.f;
        if (u.pn == gate_tile) {
            if (wc == 0 && fq < 2) {
#pragma unroll
                for (int ai = 0; ai < 2; ++ai)
#pragma unroll
                    for (int m = 0; m < 4; ++m) { GAS float* gp = (GAS float*)Gt + (size_t)(row0 + ai * HALF + m * 16) * 16 + 8 * fq; *(GAS f32x4*)gp = acc[ai][0][m][0] * rsc[ai][m]; *(GAS f32x4*)(gp + 4) = acc[ai][0][m][1] * rsc[ai][m]; }
            }
            return;
        }
        int colt = u.pn * BM; bf16_t* base = O; float sc = 1.f; bool qtile = false;
        if (split_cols) { const int t = colt / split_cols; base += (size_t)t * split_stride; colt -= t * split_cols; if (t == 0) { sc = scale0; qtile = (T0 != nullptr); } }
        const int col0 = colt + wc * 32 + 8 * fq;
        const int px16 = ((fq ^ 1) * 16 + fr) * 4, px32 = ((fq ^ 2) * 16 + fr) * 4;
#pragma unroll
        for (int ai = 0; ai < 2; ++ai)
#pragma unroll
            for (int m = 0; m < 4; ++m) { bf16_t* rowp = base + (size_t)(row0 + ai * HALF + m * 16) * ldc + col0;
#pragma unroll
                for (int bj = 0; bj < 2; ++bj) { const float sr = sc * rsc[ai][m]; const f32x4 v0 = acc[ai][bj][m][0] * sr, v1 = acc[ai][bj][m][1] * sr;
                    u32x4 w; w.x = cvt_pk_bf16(v0[0], v0[1]); w.y = cvt_pk_bf16(v0[2], v0[3]); w.z = cvt_pk_bf16(v1[0], v1[1]); w.w = cvt_pk_bf16(v1[2], v1[3]);
                    *(u32x4*)(rowp + bj * HALF) = w;
                    if (qtile) {
                        float q = (bf_lo(w.x) * bf_lo(w.x) + bf_hi(w.x) * bf_hi(w.x)) + (bf_lo(w.y) * bf_lo(w.y) + bf_hi(w.y) * bf_hi(w.y)) + (bf_lo(w.z) * bf_lo(w.z) + bf_hi(w.z) * bf_hi(w.z)) + (bf_lo(w.w) * bf_lo(w.w) + bf_hi(w.w) * bf_hi(w.w));
                        q += __builtin_bit_cast(float, __builtin_amdgcn_ds_bpermute(px16, __builtin_bit_cast(int, q))); q += __builtin_bit_cast(float, __builtin_amdgcn_ds_bpermute(px32, __builtin_bit_cast(int, q)));
                        if (fq == 0) P[(bj * 4 + wc) * 256 + ai * HALF + wr * 64 + m * 16 + fr] = q; } } }
        if (qtile) {
            asm volatile("s_waitcnt lgkmcnt(0)" ::: "memory"); __builtin_amdgcn_s_barrier(); asm volatile("" ::: "memory");
            const int hd = wr * 4 + wc;
            if (hd < 4) {
                const int lane = fq * 16 + fr; const PG8_LAS float* p0 = P + ((hd >> 1) * 4 + 2 * (hd & 1)) * 256;
                float mx = 0.f;
#pragma unroll
                for (int k = 0; k < 4; ++k) mx = fmaxf(mx, p0[lane + 64 * k] + p0[256 + lane + 64 * k]);
#pragma unroll
                for (int o = 1; o < 64; o <<= 1) mx = fmaxf(mx, __builtin_bit_cast(float, __builtin_amdgcn_ds_bpermute((lane ^ o) * 4, __builtin_bit_cast(int, mx))));
                const int bh = (u.pm >> 4) * 16 + (colt >> 6) + hd, qb = u.pm & 15, NT = 4 * (qb + 1);
                const __attribute__((address_space(1))) float* c2 = (const __attribute__((address_space(1))) float*)C2v + (size_t)bh * 4096; const __attribute__((address_space(1))) float* km = (const __attribute__((address_space(1))) float*)KMX + bh * 64;
                const float cend = c2[64 * lane + 63], kt = sqrtf(km[lane]) * 1.0001f, qu = sqrtf(mx) * 1.0001f;
                const float kband = fmaxf(fmaxf(sqrtf(km[NT - 4]), sqrtf(km[NT - 3])), fmaxf(sqrtf(km[NT - 2]), sqrtf(km[NT - 1]))) * 1.0001f;
                const bool keep = (lane >= NT - 4) || (c2[256 * qb] - cend >= -(qu * (kt + kband) + 48.f));
                int t0 = __builtin_ctzll(__ballot(keep)); t0 = (t0 > NT - 4 ? NT - 4 : t0) & ~1;
                if (lane == 0) ((__attribute__((address_space(1))) int*)T0)[bh * 16 + qb] = t0;
            }
            asm volatile("s_waitcnt lgkmcnt(0)" ::: "memory"); __builtin_amdgcn_s_barrier(); asm volatile("" ::: "memory");
        }
    }
};

static_assert(WGM * 4 == 32, "EpiNormRes: the four column tiles of a token tile must be dealt to four workgroups of the SAME round (StaticOrder, N = 1024, 32 workgroups per group): WGM = 8");
struct EpiNormRes {
    static constexpr bool PERM = true, AFTER_DRAIN = false;
    bf16_t* XH; float* RSTD; const float* wpost; float* xout; bool last; float* SUMS; unsigned* CNT; unsigned* tmo; int kidx; PG8_LAS unsigned char* tl;
    __device__ __forceinline__ void exchange(int e, int pm, int pn, int tid, PG8_LAS float* T, PG8_LAS float* R) const {
        typedef __attribute__((address_space(1))) float gfloat; typedef __attribute__((address_space(1))) unsigned gunsigned; typedef __attribute__((address_space(1))) unsigned long long gu64t;
        asm volatile("s_waitcnt lgkmcnt(0)" ::: "memory"); __builtin_amdgcn_s_barrier(); asm volatile("" ::: "memory");
        if (tid < 256) {
            gu64t* slot = (gu64t*)SUMS + ((size_t)(e * 256 + pm) * 4) * 256;
            const unsigned tag = (unsigned)(2 * kidx + e + 1);
            const float own = (T[tid] + T[256 + tid]) + (T[512 + tid] + T[768 + tid]);
            __hip_atomic_store(slot + pn * 256 + tid, ((unsigned long long)tag << 32) | (unsigned long long)__builtin_bit_cast(unsigned, own), __ATOMIC_RELAXED, __HIP_MEMORY_SCOPE_AGENT);
            float rs_old = 1.f, wg = 0.f;
            if (e == 0) { rs_old = ((const gfloat*)RSTD)[pm * 256 + tid]; wg = ((const gfloat*)wpost)[pn * 256 + tid]; }
#ifdef PROBE_K
            const unsigned long long tq0_ = __builtin_amdgcn_s_memrealtime();
#endif
            unsigned long long w[4]; unsigned sp = 0;
            for (;;) {
#pragma unroll
                for (int q = 0; q < 4; ++q) w[q] = __hip_atomic_load(slot + q * 256 + tid, __ATOMIC_RELAXED, __HIP_MEMORY_SCOPE_AGENT);
                if ((unsigned)(w[0] >> 32) == tag && (unsigned)(w[1] >> 32) == tag && (unsigned)(w[2] >> 32) == tag && (unsigned)(w[3] >> 32) == tag) break;
                __builtin_amdgcn_s_sleep(1);
                if ((++sp & 255u) == 0u) { if (__hip_atomic_load((gunsigned*)tmo, __ATOMIC_RELAXED, __HIP_MEMORY_SCOPE_AGENT)) break; if (sp > (1u << 18)) { __hip_atomic_fetch_add((gunsigned*)tmo, 1u, __ATOMIC_RELAXED, __HIP_MEMORY_SCOPE_AGENT); break; } }
            }
#ifdef PROBE_K
            if (blockIdx.x == 0 && tid == 0) __hip_atomic_fetch_add((__attribute__((address_space(1))) unsigned long long*)(tmo - XB_TMO - CW_BAR + (512 * 1024 / 4) + 2 * (113 + 2 * e)), __builtin_amdgcn_s_memrealtime() - tq0_, __ATOMIC_RELAXED, __HIP_MEMORY_SCOPE_AGENT);
#endif
            float s = 0.f;
#pragma unroll
            for (int q = 0; q < 4; ++q) s += (q == pn) ? own : __builtin_bit_cast(float, (unsigned)w[q]);
            const float r = __builtin_amdgcn_rsqf(s * (1.f / 1024.f) + 1e-6f);
            R[tid] = r;
            if (e == 0) { R[256 + tid] = 1.0f / rs_old; R[512 + tid] = wg; }
            if (e == 1 && pn == 0) ((gfloat*)RSTD)[pm * 256 + tid] = r;
        }
        asm volatile("s_waitcnt lgkmcnt(0)" ::: "memory"); __builtin_amdgcn_s_barrier(); asm volatile("" ::: "memory");
    }
    __device__ __forceinline__ void operator()(f32x4 (&acc)[2][2][4][2], const Unit& u, int wr, int wc, int fr_in, int fq_in) const {
        typedef __attribute__((address_space(1))) float gfloat;
        int fr = fr_in, fq = fq_in; asm volatile("" : "+v"(fr), "+v"(fq));
        const int tid = (wr * 4 + wc) * 64 + fq * 16 + fr;
#ifdef PROBE_K
        const unsigned long long tp0_ = __builtin_amdgcn_s_memrealtime();
#endif
        const int px16 = ((fq ^ 1) * 16 + fr) * 4, px32 = ((fq ^ 2) * 16 + fr) * 4;
#define NR_XSUM(p) do { p += __builtin_bit_cast(float, __builtin_amdgcn_ds_bpermute(px16, __builtin_bit_cast(int, p))); p += __builtin_bit_cast(float, __builtin_amdgcn_ds_bpermute(px32, __builtin_bit_cast(int, p))); } while (0)
        PG8_LAS float* T = (PG8_LAS float*)tl; PG8_LAS float* R = T + 1024;
        const int rl0 = wr * 64 + fr;
#pragma unroll
        for (int ai = 0; ai < 2; ++ai)
#pragma unroll
            for (int m = 0; m < 4; ++m) {
                float p = 0.f;
#pragma unroll
                for (int bj = 0; bj < 2; ++bj)
#pragma unroll
                    for (int n = 0; n < 2; ++n) { const f32x4 a = acc[ai][bj][m][n]; p += (a[0] * a[0] + a[1] * a[1]) + (a[2] * a[2] + a[3] * a[3]); }
                NR_XSUM(p);
                if (fq == 0) T[wc * 256 + ai * HALF + m * 16 + rl0] = p;
            }
        u32x4 xh[2][4][2];
        const unsigned voff = (unsigned)((rl0 * 1024 + wc * 32 + 8 * fq) * 2);
        const char* xu = (const char*)(XH + (size_t)u.pm * BM * 1024 + u.pn * BM);
        {
#pragma unroll
            for (int ai = 0; ai < 2; ++ai)
#pragma unroll
                for (int m = 0; m < 4; ++m) {
#pragma unroll
                    for (int bj = 0; bj < 2; ++bj) xh[ai][m][bj] = *(const __attribute__((address_space(1))) u32x4*)(xu + ((ai * HALF + m * 16) * 1024 + bj * HALF) * 2 + voff);
                }
        }
        exchange(0, u.pm, u.pn, tid, T, R);
#pragma unroll
        for (int ai = 0; ai < 2; ++ai)
#pragma unroll
            for (int m = 0; m < 4; ++m) {
                const float ry = R[ai * HALF + m * 16 + rl0], rinv = R[256 + ai * HALF + m * 16 + rl0];
                float p = 0.f;
#pragma unroll
                for (int bj = 0; bj < 2; ++bj) {
                    const u32x4 w = xh[ai][m][bj];
                    const f32x4 x0 = (f32x4){bf_lo(w.x), bf_hi(w.x), bf_lo(w.y), bf_hi(w.y)} * rinv, x1 = (f32x4){bf_lo(w.z), bf_hi(w.z), bf_lo(w.w), bf_hi(w.w)} * rinv;
                    const f32x4 wp0 = *(const PG8_LAS f32x4*)(R + 512 + bj * HALF + wc * 32 + 8 * fq), wp1 = *(const PG8_LAS f32x4*)(R + 512 + bj * HALF + wc * 32 + 8 * fq + 4);
                    const f32x4 a0 = x0 + (acc[ai][bj][m][0] * ry) * wp0, a1 = x1 + (acc[ai][bj][m][1] * ry) * wp1;
                    acc[ai][bj][m][0] = a0; acc[ai][bj][m][1] = a1;
                    p += ((a0[0] * a0[0] + a0[1] * a0[1]) + (a0[2] * a0[2] + a0[3] * a0[3])) + ((a1[0] * a1[0] + a1[1] * a1[1]) + (a1[2] * a1[2] + a1[3] * a1[3]));
                }
                if (!last) { NR_XSUM(p); if (fq == 0) T[wc * 256 + ai * HALF + m * 16 + rl0] = p; }
            }
        if (last) {
            char* ou = (char*)(xout + (size_t)u.pm * BM * 1024 + u.pn * BM); unsigned vo2 = voff * 2u; asm volatile("" : "+v"(vo2));
#pragma unroll
            for (int ai = 0; ai < 2; ++ai)
#pragma unroll
                for (int m = 0; m < 4; ++m)
#pragma unroll
                    for (int bj = 0; bj < 2; ++bj)
#pragma unroll
                        for (int n = 0; n < 2; ++n) *(__attribute__((address_space(1))) f32x4*)(ou + ((ai * HALF + m * 16) * 1024 + bj * HALF + 4 * n) * 4 + vo2) = acc[ai][bj][m][n];
            return;
        }
        exchange(1, u.pm, u.pn, tid, T, R);
        {
            unsigned vo1 = voff; asm volatile("" : "+v"(vo1));
#pragma unroll
            for (int ai = 0; ai < 2; ++ai)
#pragma unroll
                for (int m = 0; m < 4; ++m) {
                    const float rx = R[ai * HALF + m * 16 + rl0];
#pragma unroll
                    for (int bj = 0; bj < 2; ++bj) { const f32x4 v0 = acc[ai][bj][m][0] * rx, v1 = acc[ai][bj][m][1] * rx;
                        u32x4 w; w.x = cvt_pk_bf16(v0[0], v0[1]); w.y = cvt_pk_bf16(v0[2], v0[3]); w.z = cvt_pk_bf16(v1[0], v1[1]); w.w = cvt_pk_bf16(v1[2], v1[3]);
                        *(__attribute__((address_space(1))) u32x4*)((char*)xu + ((ai * HALF + m * 16) * 1024 + bj * HALF) * 2 + vo1) = w; }
                }
        }
#ifdef PROBE_K
        if (blockIdx.x == 0 && tid == 0) __hip_atomic_fetch_add((__attribute__((address_space(1))) unsigned long long*)(tmo - XB_TMO - CW_BAR + (512 * 1024 / 4) + 2 * 111), __builtin_amdgcn_s_memrealtime() - tp0_, __ATOMIC_RELAXED, __HIP_MEMORY_SCOPE_AGENT);
#endif
#undef NR_XSUM
    }
};

template <int N> __device__ __forceinline__ float dpp_ror(float v) { return __builtin_bit_cast(float, __builtin_amdgcn_mov_dpp(__builtin_bit_cast(int, v), 0x120 + N, 0xf, 0xf, false)); }
__device__ __forceinline__ float dpp_ror1(float v) { return dpp_ror<1>(v); }
__device__ __forceinline__ float dpp_ror2(float v) { return dpp_ror<2>(v); }
__device__ __forceinline__ float fmac_shr1(float acc, float src, float w) { asm("v_fmac_f32_dpp %0, %1, %2 row_shr:1 row_mask:0xf bank_mask:0xf bound_ctrl:1" : "+v"(acc) : "v"(src), "v"(w)); return acc; }
__device__ __forceinline__ float fmac_shr2(float acc, float src, float w) { asm("v_fmac_f32_dpp %0, %1, %2 row_shr:2 row_mask:0xf bank_mask:0xf bound_ctrl:1" : "+v"(acc) : "v"(src), "v"(w)); return acc; }
__device__ __forceinline__ float fmac_shl15(float acc, float src, float w) { asm("v_fmac_f32_dpp %0, %1, %2 row_shl:15 row_mask:0xf bank_mask:0xf bound_ctrl:1" : "+v"(acc) : "v"(src), "v"(w)); return acc; }
__device__ __forceinline__ float fmac_shl14(float acc, float src, float w) { asm("v_fmac_f32_dpp %0, %1, %2 row_shl:14 row_mask:0xf bank_mask:0xf bound_ctrl:1" : "+v"(acc) : "v"(src), "v"(w)); return acc; }
template <int N> __device__ __forceinline__ float dpp_shr_old(float old, float v) { return __builtin_bit_cast(float, __builtin_amdgcn_update_dpp(__builtin_bit_cast(int, old), __builtin_bit_cast(int, v), 0x110 + N, 0xf, 0xf, false)); }
struct EpiConv {
    static constexpr bool PERM = true, AFTER_DRAIN = false, APERM = true;
    bf16_t* ACT; const float* cw; const float* cb; float* HALO; PG8_LAS unsigned char* xch; int dff; const float* rs;
    __device__ __forceinline__ void operator()(const f32x4 (&acc)[2][2][4][2], const Unit& u, int wr, int wc, int fr_in, int fq_in) const {
        typedef PG8_LAS f32x4 las4;
        int fr = fr_in, fq = fq_in; asm volatile("" : "+v"(fr), "+v"(fq));
        (void)rs;
        if (fr == 15) {
#pragma unroll
            for (int ai = 0; ai < 2; ++ai)
#pragma unroll
                for (int bj = 0; bj < 2; ++bj)
#pragma unroll
                    for (int mm = 0; mm < 2; ++mm)
#pragma unroll
                        for (int n = 0; n < 2; ++n) *(las4*)(xch + (((((wc * 4 + 2 * ai + wr) * 2 + mm) * 2 + bj) * 32) + 8 * fq + 4 * n) * 4) = acc[ai][bj][2 + mm][n];
        }
        {
            const int colu = u.pn * BM + wc * 32 + 8 * fq;
            if (wr == 0 && fr == 0) {
#pragma unroll
                for (int mm = 0; mm < 2; ++mm)
#pragma unroll
                    for (int bj = 0; bj < 2; ++bj)
#pragma unroll
                        for (int n = 0; n < 2; ++n) *(__attribute__((address_space(1))) f32x4*)(HALO + ((size_t)u.pm * 4 + mm) * (2 * dff) + colu + bj * HALF + 4 * n) = acc[0][bj][mm][n];
            }
            if (wr == 1 && fr == 15) {
#pragma unroll
                for (int mm = 0; mm < 2; ++mm)
#pragma unroll
                    for (int bj = 0; bj < 2; ++bj)
#pragma unroll
                        for (int n = 0; n < 2; ++n) *(__attribute__((address_space(1))) f32x4*)(HALO + ((size_t)u.pm * 4 + 2 + mm) * (2 * dff) + colu + bj * HALF + 4 * n) = acc[1][bj][2 + mm][n];
            }
        }
        asm volatile("s_waitcnt lgkmcnt(0)" ::: "memory"); __builtin_amdgcn_s_barrier(); asm volatile("" ::: "memory");
        const int ca = u.pn * HALF + wc * 32 + 8 * fq;
        unsigned pk0[2][4][2];
#pragma unroll
        for (int n = 0; n < 2; ++n) {
            const f32x4 wg0 = *(const f32x4*)(cw + ca + 4 * n), wg1 = *(const f32x4*)(cw + 2 * dff + ca + 4 * n), wg2 = *(const f32x4*)(cw + 4 * dff + ca + 4 * n), bg = *(const f32x4*)(cb + ca + 4 * n);
            const f32x4 wv0 = *(const f32x4*)(cw + dff + ca + 4 * n), wv1 = *(const f32x4*)(cw + 3 * dff + ca + 4 * n), wv2 = *(const f32x4*)(cw + 5 * dff + ca + 4 * n), bv = *(const f32x4*)(cb + dff + ca + 4 * n);
#pragma unroll
            for (int ai = 0; ai < 2; ++ai) {
                const int g = 2 * ai + wr;
                const PG8_LAS unsigned char* hb = xch + (g > 0 ? ((wc * 4 + (g - 1)) * 2) * 2 * 32 * 4 : 8192) + (8 * fq + 4 * n) * 4;
                const int hrow = g > 0 ? 2 * 32 * 4 : 0;
                f32x4 s2g = *(const las4*)(hb), s2v = *(const las4*)(hb + 32 * 4), s3g = *(const las4*)(hb + hrow), s3v = *(const las4*)(hb + hrow + 32 * 4);
#pragma unroll
                for (int j = 0; j < 4; ++j) {
                    s3g[j] = dpp_shr_old<1>(s3g[j], acc[ai][0][3][n][j]); s2g[j] = dpp_shr_old<1>(s2g[j], acc[ai][0][2][n][j]);
                    s3v[j] = dpp_shr_old<1>(s3v[j], acc[ai][1][3][n][j]); s2v[j] = dpp_shr_old<1>(s2v[j], acc[ai][1][2][n][j]);
                }
#pragma unroll
                for (int m = 0; m < 4; ++m) {
                    const f32x4 cg = acc[ai][0][m][n], cv = acc[ai][1][m][n];
                    const f32x4 g1 = (m == 0) ? s3g : acc[ai][0][m == 0 ? 0 : m - 1][n], v1 = (m == 0) ? s3v : acc[ai][1][m == 0 ? 0 : m - 1][n];
                    const f32x4 g2 = (m == 0) ? s2g : (m == 1) ? s3g : acc[ai][0][m < 2 ? 0 : m - 2][n], v2 = (m == 0) ? s2v : (m == 1) ? s3v : acc[ai][1][m < 2 ? 0 : m - 2][n];
                    const f32x4 yg = wg2 * cg + bg + wg1 * g1 + wg0 * g2, yv = wv2 * cv + bv + wv1 * v1 + wv0 * v2;
                    const f32x4 ea = yg * ((yg * yg) * (-2.302208198f * 0.044715f) + (-2.302208198f));
                    f32x4 e;
#pragma unroll
                    for (int j = 0; j < 4; ++j) e[j] = __builtin_amdgcn_exp2f(ea[j]);
                    const f32x4 d = e + 1.0f;
                    f32x4 r;
#pragma unroll
                    for (int j = 0; j < 4; ++j) r[j] = __builtin_amdgcn_rcpf(d[j]);
                    const f32x4 o = (yg * r) * yv;
                    const unsigned w0 = cvt_pk_bf16(o[0], o[1]), w1 = cvt_pk_bf16(o[2], o[3]);
                    if (n == 0) { pk0[ai][m][0] = w0; pk0[ai][m][1] = w1; }
                    else { u32x4 w; w.x = pk0[ai][m][0]; w.y = pk0[ai][m][1]; w.z = w0; w.w = w1;
                        *(__attribute__((address_space(1))) u32x4*)(ACT + (size_t)(u.pm * BM + ai * HALF + wr * 64 + 4 * fr + m) * dff + ca) = w; }
                }
            }
        }
    }
};
}

__device__ __forceinline__ void wt_item(const float* W, int Ns, const float* gain, bf16* WT, int Kd, int dst_row0, int k0, int n0, LAS float* scr, int lane) {
    const int nn = lane & 31; const bool inb = (n0 + nn) < Ns; const int ncl = inb ? n0 + nn : Ns - 1;
    const GAS float* src = (const GAS float*)W + (size_t)(k0 + (lane >> 5)) * Ns + ncl;
    float v[32];
#pragma unroll
    for (int i = 0; i < 32; ++i) v[i] = src[(size_t)(2 * i) * Ns];
    const int c = lane & 7;
    f32x4 g0 = (f32x4){1.f, 1.f, 1.f, 1.f}, g1 = g0;
    if (gain) { g0 = *(const GAS f32x4*)(gain + k0 + 8 * c); g1 = *(const GAS f32x4*)(gain + k0 + 8 * c + 4); }
#pragma unroll
    for (int i = 0; i < 32; ++i) scr[(2 * i + (lane >> 5)) * 33 + nn] = inb ? v[i] : 0.f;
    LDS_WAIT(); asm volatile("" ::: "memory");
#pragma unroll
    for (int j = 0; j < 4; ++j) { const int n = (lane >> 3) + 8 * j; const LAS float* s = scr + (8 * c) * 33 + n;
        v4u o; o.x = cvtpk(s[0 * 33] * g0[0], s[1 * 33] * g0[1]); o.y = cvtpk(s[2 * 33] * g0[2], s[3 * 33] * g0[3]); o.z = cvtpk(s[4 * 33] * g1[0], s[5 * 33] * g1[1]); o.w = cvtpk(s[6 * 33] * g1[2], s[7 * 33] * g1[3]);
        *(GAS v4u*)(WT + (size_t)(dst_row0 + n) * Kd + k0 + 8 * c) = o; }
    LDS_WAIT(); asm volatile("" ::: "memory");
}
struct Ins { const float* p[18]; };
__device__ __forceinline__ void prologue_weights(const Ins& in, unsigned char* ws, LAS unsigned char* lds, int gw, int NGW, int wave, int lane) {
    LAS float* scr = (LAS float*)(lds + RING_OFF + wave * 16384);
    constexpr int I_IN = 16 * (MIN_NP / 32), I_SQ = 16 * 32, I_KV = 16 * (KV_NP / 32), I_QG = 16 * 64, I_UP = 16 * (DFF2 / 32), I_DN = (DFF / 64) * 32;
    constexpr int E0 = 2 * I_IN, E1 = E0 + 2 * I_SQ, E2 = E1 + I_KV, E3 = E2 + 2 * I_QG, E4 = E3 + 2 * I_SQ, E5 = E4 + 4 * I_UP, E6 = E5 + 4 * I_DN;
    for (int it = gw; it < E6; it += NGW) {
        const float* W; const float* gain = nullptr; bf16* WT; int Ns, Kd = D, nblk, r, kind = 0;
        if (it < E0)      { r = it;      const int L = r / I_IN; r -= L * I_IN; W = in.p[5] + (size_t)L * D * MIN_N; gain = in.p[1] + L * D; WT = (bf16*)(ws + WS_WIN + L * SZ_WIN); Ns = MIN_N; nblk = MIN_NP / 32; }
        else if (it < E1) { r = it - E0; const int L = r / I_SQ; r -= L * I_SQ; W = in.p[8] + (size_t)L * D * D; WT = (bf16*)(ws + WS_WMOUT + L * SZ_SQ); Ns = D; nblk = 32; }
        else if (it < E2) { r = it - E1; W = in.p[10]; gain = in.p[9]; WT = (bf16*)(ws + WS_WKV); Ns = KV_N; nblk = KV_NP / 32; }
        else if (it < E3) { r = it - E2; const int L = r / I_QG; r -= L * I_QG; W = in.p[12] + (size_t)L * D * 2 * D; gain = in.p[1] + (2 + L) * D; WT = (bf16*)(ws + WS_WQG + L * SZ_WQG); Ns = 2 * D; nblk = 64; }
        else if (it < E4) { r = it - E3; const int L = r / I_SQ; r -= L * I_SQ; W = in.p[13] + (size_t)L * D * D; WT = (bf16*)(ws + WS_WFOUT + L * SZ_SQ); Ns = D; nblk = 32; }
        else if (it < E5) { r = it - E4; const int L = r / I_UP; r -= L * I_UP; W = in.p[14] + (size_t)L * D * DFF2; gain = in.p[3] + L * D; WT = (bf16*)(ws + WS_WUP + L * SZ_WUP); Ns = DFF2; nblk = DFF2 / 32; kind = 1; }
        else              { r = it - E5; const int L = r / I_DN; r -= L * I_DN; W = in.p[17] + (size_t)L * DFF * D; WT = (bf16*)(ws + WS_WDN + L * SZ_WDN); Ns = D; nblk = 32; Kd = DFF; }
        const int kb = r / nblk, nb = r - kb * nblk, n0 = 32 * nb;
        int drow = n0;
        if (kind == 1) drow = (n0 < DFF) ? 256 * (n0 >> 7) + (n0 & 127) : 256 * ((n0 - DFF) >> 7) + 128 + ((n0 - DFF) & 127);
        wt_item(W, Ns, gain, WT, Kd, drow, 64 * kb, n0, scr, lane);
    }
}

__device__ __forceinline__ void norm_first(const float* x, bf16* XH, float* RSTD, int gw, int NGW, int lane) {
    for (int m = gw; m < M; m += NGW) {
        const GAS f32x4* xr = (const GAS f32x4*)(x + (size_t)m * D) + lane;
        f32x4 v[4]; float s = 0.f;
#pragma unroll
        for (int j = 0; j < 4; ++j) { v[j] = xr[64 * j]; s += (v[j].x * v[j].x + v[j].y * v[j].y) + (v[j].z * v[j].z + v[j].w * v[j].w); }
        const float r = __builtin_amdgcn_rsqf(wave_sum(s) * (1.f / D) + EPS);
        GAS unsigned long long* o8 = (GAS unsigned long long*)(XH + (size_t)m * D) + lane;
#pragma unroll
        for (int j = 0; j < 4; ++j) o8[64 * j] = (unsigned long long)cvtpk(v[j].x * r, v[j].y * r) | ((unsigned long long)cvtpk(v[j].z * r, v[j].w * r) << 32);
        if (lane == 0) RSTD[m] = r;
    }
}
__device__ __forceinline__ void norm_res(bf16* XH, const bf16* Y, const float* wpost, float* RSTD, float* xout, bool last, int vcu, int wave, int lane) {
    f32x4 wp[4];
#pragma unroll
    for (int j = 0; j < 4; ++j) wp[j] = ((const GAS f32x4*)wpost)[lane + 64 * j];
    for (int m = 256 * vcu + wave; m < 256 * vcu + 256; m += NWAVES) {
        GAS unsigned long long* xr = (GAS unsigned long long*)(XH + (size_t)m * D) + lane;
        const GAS unsigned long long* yr = (const GAS unsigned long long*)(Y + (size_t)m * D) + lane;
        const float rinv = 1.0f / ((const GAS float*)RSTD)[m];
        f32x4 xv[4], yv[4]; float sy = 0.f;
#pragma unroll
        for (int j = 0; j < 4; ++j) { const unsigned long long a = xr[64 * j], w = yr[64 * j]; const unsigned alo = (unsigned)a, ahi = (unsigned)(a >> 32), lo = (unsigned)w, hi = (unsigned)(w >> 32);
            xv[j] = (f32x4){bf_lo(alo), bf_hi(alo), bf_lo(ahi), bf_hi(ahi)} * rinv;
            yv[j] = (f32x4){bf_lo(lo), bf_hi(lo), bf_lo(hi), bf_hi(hi)}; sy += (yv[j].x * yv[j].x + yv[j].y * yv[j].y) + (yv[j].z * yv[j].z + yv[j].w * yv[j].w); }
        const float ry = __builtin_amdgcn_rsqf(wave_sum(sy) * (1.f / D) + EPS); float sx = 0.f;
#pragma unroll
        for (int j = 0; j < 4; ++j) { xv[j] = xv[j] + (yv[j] * ry) * wp[j]; sx += (xv[j].x * xv[j].x + xv[j].y * xv[j].y) + (xv[j].z * xv[j].z + xv[j].w * xv[j].w); }
        if (last) {
            GAS f32x4* xo = (GAS f32x4*)(xout + (size_t)m * D) + lane;
#pragma unroll
            for (int j = 0; j < 4; ++j) xo[64 * j] = xv[j];
        } else {
            const float rx = __builtin_amdgcn_rsqf(wave_sum(sx) * (1.f / D) + EPS);
#pragma unroll
            for (int j = 0; j < 4; ++j) xr[64 * j] = (unsigned long long)cvtpk(xv[j].x * rx, xv[j].y * rx) | ((unsigned long long)cvtpk(xv[j].z * rx, xv[j].w * rx) << 32);
            if (lane == 0) RSTD[m] = rx;
        }
    }
}

__device__ __forceinline__ float gelu_tanh(float x) {
    const float z = x + 0.044715f * x * x * x;
    return x * __builtin_amdgcn_rcpf(1.f + __builtin_amdgcn_exp2f(-2.0f * 0.7978845608028654f * LOG2E * z));
}
__device__ __forceinline__ void conv_phase(const bf16* U, const float* cw, const float* cb, bf16* ACT, int gtid, int NT) {
    constexpr int RG = 16, NRG = MHALF / RG, NCG = DFF / 8;
    for (int task = gtid; task < NRG * NCG; task += NT) {
        const int rg = task / NCG, cg = task - rg * NCG, r0 = rg * RG, c0 = cg * 8;
        const int ucol = 256 * (c0 >> 7) + (c0 & 127);
        float wg[3][8], wv[3][8], bg[8], bv[8];
#pragma unroll
        for (int j = 0; j < 3; ++j)
#pragma unroll
            for (int e = 0; e < 8; ++e) { wg[j][e] = cw[j * DFF2 + c0 + e]; wv[j][e] = cw[j * DFF2 + DFF + c0 + e]; }
#pragma unroll
        for (int e = 0; e < 8; ++e) { bg[e] = cb[c0 + e]; bv[e] = cb[DFF + c0 + e]; }
        float g2[8], g1[8], v2[8], v1[8];
        const bool has_prev = (r0 % SEQ) != 0;
        if (has_prev) {
            const v4u a = *(const GAS v4u*)(U + (size_t)(r0 - 2) * DFF2 + ucol), b = *(const GAS v4u*)(U + (size_t)(r0 - 2) * DFF2 + ucol + 128);
            const v4u c = *(const GAS v4u*)(U + (size_t)(r0 - 1) * DFF2 + ucol), d = *(const GAS v4u*)(U + (size_t)(r0 - 1) * DFF2 + ucol + 128);
#pragma unroll
            for (int e = 0; e < 4; ++e) { g2[2 * e] = bf_lo(a[e]); g2[2 * e + 1] = bf_hi(a[e]); v2[2 * e] = bf_lo(b[e]); v2[2 * e + 1] = bf_hi(b[e]);
                                          g1[2 * e] = bf_lo(c[e]); g1[2 * e + 1] = bf_hi(c[e]); v1[2 * e] = bf_lo(d[e]); v1[2 * e + 1] = bf_hi(d[e]); }
        } else {
#pragma unroll
            for (int e = 0; e < 8; ++e) { g2[e] = 0.f; g1[e] = 0.f; v2[e] = 0.f; v1[e] = 0.f; }
        }
#pragma unroll 4
        for (int i = 0; i < RG; ++i) {
            const v4u a = *(const GAS v4u*)(U + (size_t)(r0 + i) * DFF2 + ucol), b = *(const GAS v4u*)(U + (size_t)(r0 + i) * DFF2 + ucol + 128);
            float g0[8], v0[8]; v4u o;
#pragma unroll
            for (int e = 0; e < 4; ++e) { g0[2 * e] = bf_lo(a[e]); g0[2 * e + 1] = bf_hi(a[e]); v0[2 * e] = bf_lo(b[e]); v0[2 * e + 1] = bf_hi(b[e]); }
            float r[8];
#pragma unroll
            for (int e = 0; e < 8; ++e) { const float yg = bg[e] + wg[0][e] * g2[e] + wg[1][e] * g1[e] + wg[2][e] * g0[e]; const float yv = bv[e] + wv[0][e] * v2[e] + wv[1][e] * v1[e] + wv[2][e] * v0[e];
                r[e] = gelu_tanh(yg) * yv; g2[e] = g1[e]; g1[e] = g0[e]; v2[e] = v1[e]; v1[e] = v0[e]; }
            o.x = cvtpk(r[0], r[1]); o.y = cvtpk(r[2], r[3]); o.z = cvtpk(r[4], r[5]); o.w = cvtpk(r[6], r[7]);
            *(GAS v4u*)(ACT + (size_t)(r0 + i) * DFF + c0) = o;
        }
    }
}

__device__ __forceinline__ void ffn_fixup_phase(const float* HALO, const float* cw, const float* cb, bf16* ACT, int vcu, int tid) {
    constexpr int NCG = DFF / 4;
    const int pm = vcu;
    if ((pm & 15) == 0) return;
    for (int rem = tid; rem < 2 * NCG; rem += NWAVES * 64) {
        const int row = rem / NCG, c0 = (rem - row * NCG) * 4;
        const int ucol = 256 * (c0 >> 7) + (c0 & 127);
        const GAS float* Hp = (const GAS float*)HALO + (size_t)(pm - 1) * 4 * DFF2; const GAS float* Hc = (const GAS float*)HALO + (size_t)pm * 4 * DFF2;
        f32x4 o;
#pragma unroll
        for (int half = 0; half < 2; ++half) {
            const int uc = ucol + 128 * half, pc = c0 + DFF * half;
            const f32x4 a254 = *(const GAS f32x4*)(Hp + 2 * DFF2 + uc), a255 = *(const GAS f32x4*)(Hp + 3 * DFF2 + uc), c0v = *(const GAS f32x4*)(Hc + uc), c1v = *(const GAS f32x4*)(Hc + DFF2 + uc);
            const f32x4 w0 = *(const GAS f32x4*)(cw + pc), w1 = *(const GAS f32x4*)(cw + DFF2 + pc), w2 = *(const GAS f32x4*)(cw + 2 * DFF2 + pc), bb = *(const GAS f32x4*)(cb + pc);
            const f32x4 y = (row == 0) ? bb + w0 * a254 + w1 * a255 + w2 * c0v : bb + w0 * a255 + w1 * c0v + w2 * c1v;
            if (half == 0) { o[0] = gelu_tanh(y[0]); o[1] = gelu_tanh(y[1]); o[2] = gelu_tanh(y[2]); o[3] = gelu_tanh(y[3]); } else o = o * y;
        }
        typedef unsigned u32x2 __attribute__((ext_vector_type(2)));
        u32x2 w; w.x = cvtpk(o[0], o[1]); w.y = cvtpk(o[2], o[3]);
        *(GAS u32x2*)(ACT + (size_t)(pm * 256 + row) * DFF + c0) = w;
    }
}

typedef short s16x4 __attribute__((ext_vector_type(4)));
typedef LAS s16x4 las_s16x4; typedef LAS bf16x8 las_bf16x8; typedef LAS f32x4 las_f32x4;
__device__ __forceinline__ s16x4 tr16(const LAS bf16* p) { typedef short v4i16_t __attribute__((ext_vector_type(4))); return __builtin_bit_cast(s16x4, __builtin_amdgcn_ds_read_tr16_b64_v4i16((LAS v4i16_t*)p)); }
__device__ __forceinline__ float wscan_add(float v, int lane) {
#pragma unroll
    for (int o = 1; o < 64; o <<= 1) { const float t = __shfl_up(v, o); if (lane >= o) v += t; }
    return v;
}
__device__ __forceinline__ float wscan_max(float v, int lane) {
#pragma unroll
    for (int o = 1; o < 64; o <<= 1) { const float t = __shfl_up(v, o); if (lane >= o) v = fmaxf(v, t); }
    return v;
}
constexpr int ML_A2 = 0, ML_M2 = 16384, ML_MT2 = 32768, ML_CH = 49152, ML_RS = 50176, ML_HSQ = 50688, ML_PS = 51712, ML_BUF = 56320;
constexpr int ML_QP = 72, ML_KP = 72, ML_VP = 136, ML_PP = 72;
constexpr int ML_QS = 0, ML_KS = 32 * ML_QP * 2, ML_VS = ML_KS + 64 * ML_KP * 2, ML_BUFB = ML_VS + 64 * ML_VP * 2;
static_assert(ML_BUF + 2 * ML_BUFB <= RING_BYTES && ML_BUFB % 16 == 0 && ML_KS % 16 == 0 && ML_VS % 16 == 0, "mlstm lds map");

__device__ __forceinline__ void mlstm_phase(LAS unsigned char* lds, const bf16* QKVO, const float* GT, const float* bgate, const float* whn, bf16* HA, int vcu, int G, int tid, int wave, int lane) {
    LAS float* A2 = (LAS float*)(lds + ML_A2); LAS float* M2 = (LAS float*)(lds + ML_M2); LAS float* MT2 = (LAS float*)(lds + ML_MT2);
    LAS float* blast = (LAS float*)(lds + ML_CH); LAS float* amaxc = blast + 64; LAS float* m2c = blast + 128; LAS float* Mlc = blast + 192;
    LAS float* RS = (LAS float*)(lds + ML_RS); LAS float* HSQ = (LAS float*)(lds + ML_HSQ);
    LAS bf16* Ps = (LAS bf16*)(lds + ML_PS);
    const int fr = lane & 15, fq = lane >> 4, q4 = fr >> 2, p4 = fr & 3;
    const int tt_s = wave >> 2, st_s = wave & 3, e0 = 16 * wave;
    for (int unit = vcu; unit < BATCH * MH * 2; unit += G) {
        const int bh = unit >> 1, rh = unit & 1, b = bh >> 3, h = bh & 7;
        {
            const float bi = bgate[h], bfg = bgate[MH + h];
            int lane_s = lane; asm volatile("" : "+v"(lane_s));
            for (int c = wave; c < NCH; c += NWAVES) {
                const size_t row = (size_t)b * SEQ + c * LCH + lane;
                const float iv = GT[row * 16 + h] + bi, fv = GT[row * 16 + MH + h] + bfg;
                const float lf = fminf(fv, 0.f) - log1pf(expf(-fabsf(fv)));
                const float b2 = wscan_add(lf * LOG2E, lane_s);
                const float a2 = iv * LOG2E - b2;
                const float lam = wscan_max(a2, lane_s);
                A2[c * LCH + lane] = a2; M2[c * LCH + lane] = lam; MT2[c * LCH + lane] = b2;
                if (lane == 63) { blast[c] = b2; amaxc[c] = lam; }
            }
            __syncthreads();
            if (tid == 0) { float m2 = 0.f; for (int c = 0; c < NCH; ++c) { m2c[c] = m2; const float Ml = fmaxf(m2, amaxc[c]); Mlc[c] = Ml; m2 = blast[c] + Ml; } }
            __syncthreads();
            for (int t = tid; t < SEQ; t += NWAVES * 64) { const float Mv = fmaxf(m2c[t >> 6], M2[t]); M2[t] = Mv; MT2[t] = MT2[t] + Mv; }
            __syncthreads();
        }
        const bf16* Qg = QKVO + (size_t)b * SEQ * MIN_LD + h * DK;
        const bf16* Kg = Qg + 512;
        const bf16* Vg = QKVO + (size_t)b * SEQ * MIN_LD + 1024 + h * DV;
        const bf16* Og = Vg + 1024;
        const float whn_l = whn[h * DV + e0 + fr];
        f32x4 Cst[4], Nst[4];
#pragma unroll
        for (int i = 0; i < 4; ++i) { Cst[i] = (f32x4){0.f, 0.f, 0.f, 0.f}; Nst[i] = (f32x4){0.f, 0.f, 0.f, 0.f}; }
        v4u kreg, vreg0, vreg1, qreg = (v4u){0u, 0u, 0u, 0u};
#define ML_LOAD(c) do { const size_t r_ = (size_t)(c) * LCH; \
            kreg = *(const GAS v4u*)(Kg + (r_ + (tid >> 3)) * MIN_LD + (tid & 7) * 8); \
            vreg0 = *(const GAS v4u*)(Vg + (r_ + (tid >> 4)) * MIN_LD + (tid & 15) * 8); \
            vreg1 = *(const GAS v4u*)(Vg + (r_ + 32 + (tid >> 4)) * MIN_LD + (tid & 15) * 8); \
            if (tid < 256) qreg = *(const GAS v4u*)(Qg + (r_ + 32 * rh + (tid >> 3)) * MIN_LD + (tid & 7) * 8); } while (0)
#define ML_STORE(bufp) do { \
            *(LAS v4u*)((bufp) + ML_KS + ((tid >> 3) * ML_KP + (tid & 7) * 8) * 2) = kreg; \
            *(LAS v4u*)((bufp) + ML_VS + ((tid >> 4) * ML_VP + (tid & 15) * 8) * 2) = vreg0; \
            *(LAS v4u*)((bufp) + ML_VS + ((32 + (tid >> 4)) * ML_VP + (tid & 15) * 8) * 2) = vreg1; \
            if (tid < 256) *(LAS v4u*)((bufp) + ML_QS + ((tid >> 3) * ML_QP + (tid & 7) * 8) * 2) = qreg; } while (0)
        ML_LOAD(0);
        ML_STORE(lds + ML_BUF);
        BAR_LDS();
#pragma unroll 1
        for (int c = 0; c < NCH; ++c) {
            LAS unsigned char* buf = lds + ML_BUF + (c & 1) * ML_BUFB;
            LAS unsigned char* nbuf = lds + ML_BUF + ((c & 1) ^ 1) * ML_BUFB;
            const LAS bf16* Qs = (const LAS bf16*)(buf + ML_QS); const LAS bf16* Ks = (const LAS bf16*)(buf + ML_KS); const LAS bf16* Vs = (const LAS bf16*)(buf + ML_VS);
            if (c + 1 < NCH) ML_LOAD(c + 1);
            unsigned short og[2][4];
#pragma unroll
            for (int tt = 0; tt < 2; ++tt)
#pragma unroll
                for (int j = 0; j < 4; ++j) og[tt][j] = *(const GAS unsigned short*)(Og + ((size_t)c * LCH + 32 * rh + 16 * tt + 4 * fq + j) * MIN_LD + e0 + fr);
            const int cb = c * LCH;
            {
                const LAS bf16* Kt = Ks + (16 * st_s + fr) * ML_KP + 8 * fq;
                const LAS bf16* Qt = Qs + (16 * tt_s + fr) * ML_QP + 8 * fq;
                f32x4 sacc = (f32x4){0.f, 0.f, 0.f, 0.f};
#pragma unroll
                for (int g = 0; g < 2; ++g) { const bf16x8 ka = *(const las_bf16x8*)(Kt + 32 * g), qb = *(const las_bf16x8*)(Qt + 32 * g); sacc = __builtin_amdgcn_mfma_f32_16x16x32_bf16(ka, qb, sacc, 0, 0, 0); }
                const int t_loc = 16 * tt_s + fr, t_pos = 32 * rh + t_loc;
                const float Mt = M2[cb + t_pos];
                const f32x4 av = *(const las_f32x4*)(A2 + cb + 16 * st_s + 4 * fq);
                float p[4];
#pragma unroll
                for (int j = 0; j < 4; ++j) { const int s_pos = 16 * st_s + 4 * fq + j; const float w = __builtin_amdgcn_exp2f(av[j] - Mt - 3.0f); p[j] = (s_pos <= t_pos) ? sacc[j] * w : 0.f; }
                typedef unsigned u32x2 __attribute__((ext_vector_type(2)));
                u32x2 pk; pk.x = cvtpk(p[0], p[1]); pk.y = cvtpk(p[2], p[3]);
                *(LAS u32x2*)(Ps + t_loc * ML_PP + 16 * st_s + 4 * fq) = pk;
            }
            BAR_LDS();
            bf16x8 vf[2];
            {
                const LAS bf16* Vt = Vs + (8 * fq + q4) * ML_VP + e0 + 4 * p4;
#pragma unroll
                for (int g = 0; g < 2; ++g) { const s16x4 lo = tr16(Vt + 32 * g * ML_VP), hi = tr16(Vt + (32 * g + 4) * ML_VP); vf[g] = (bf16x8){lo[0], lo[1], lo[2], lo[3], hi[0], hi[1], hi[2], hi[3]}; }
            }
            float hval[2][4];
            bf16x8 cbf[2], nbf[2];
                const bf16x8 ones = (bf16x8){0x3f80, 0x3f80, 0x3f80, 0x3f80, 0x3f80, 0x3f80, 0x3f80, 0x3f80};
#pragma unroll
                for (int g = 0; g < 2; ++g) {
                    typedef unsigned u32x4v __attribute__((ext_vector_type(4)));
                    u32x4v a, n;
                    a.x = cvtpk(Cst[2 * g][0], Cst[2 * g][1]); a.y = cvtpk(Cst[2 * g][2], Cst[2 * g][3]); a.z = cvtpk(Cst[2 * g + 1][0], Cst[2 * g + 1][1]); a.w = cvtpk(Cst[2 * g + 1][2], Cst[2 * g + 1][3]);
                    n.x = cvtpk(Nst[2 * g][0], Nst[2 * g][1]); n.y = cvtpk(Nst[2 * g][2], Nst[2 * g][3]); n.z = cvtpk(Nst[2 * g + 1][0], Nst[2 * g + 1][1]); n.w = cvtpk(Nst[2 * g + 1][2], Nst[2 * g + 1][3]);
                    cbf[g] = __builtin_bit_cast(bf16x8, a); nbf[g] = __builtin_bit_cast(bf16x8, n);
                }
            auto SB = [&]() __attribute__((always_inline)) {
                f32x4 hi_acc[2], he_acc[2], qn_acc[2], rs_acc[2];
#pragma unroll
                for (int tt = 0; tt < 2; ++tt) {
                    hi_acc[tt] = (f32x4){0.f, 0.f, 0.f, 0.f}; he_acc[tt] = (f32x4){0.f, 0.f, 0.f, 0.f}; qn_acc[tt] = (f32x4){0.f, 0.f, 0.f, 0.f}; rs_acc[tt] = (f32x4){0.f, 0.f, 0.f, 0.f};
#pragma unroll
                    for (int g = 0; g < 2; ++g) {
                        const bf16x8 pf = *(const las_bf16x8*)(Ps + (16 * tt + fr) * ML_PP + 32 * g + 8 * fq);
                        hi_acc[tt] = __builtin_amdgcn_mfma_f32_16x16x32_bf16(pf, vf[g], hi_acc[tt], 0, 0, 0);
                        rs_acc[tt] = __builtin_amdgcn_mfma_f32_16x16x32_bf16(pf, ones, rs_acc[tt], 0, 0, 0);
                        const s16x4 qlo = *(const las_s16x4*)(Qs + (16 * tt + fr) * ML_QP + 32 * g + 4 * fq), qhi = *(const las_s16x4*)(Qs + (16 * tt + fr) * ML_QP + 32 * g + 16 + 4 * fq);
                        const bf16x8 qp = (bf16x8){qlo[0], qlo[1], qlo[2], qlo[3], qhi[0], qhi[1], qhi[2], qhi[3]};
                        he_acc[tt] = __builtin_amdgcn_mfma_f32_16x16x32_bf16(qp, cbf[g], he_acc[tt], 0, 0, 0);
                        qn_acc[tt] = __builtin_amdgcn_mfma_f32_16x16x32_bf16(qp, nbf[g], qn_acc[tt], 0, 0, 0);
                    }
                }
                const float m2cc = m2c[c];
                float qs[2][4];
#pragma unroll
                for (int tt = 0; tt < 2; ++tt) {
                    const int tl0 = 16 * tt + 4 * fq;
                    const f32x4 Mv = *(const las_f32x4*)(M2 + cb + 32 * rh + tl0), MTv = *(const las_f32x4*)(MT2 + cb + 32 * rh + tl0);
#pragma unroll
                    for (int j = 0; j < 4; ++j) {
                        const float w = __builtin_amdgcn_exp2f(m2cc - Mv[j] - 3.0f);
                        const float num = hi_acc[tt][j] + w * he_acc[tt][j];
                        const float den = rs_acc[tt][j] + w * qn_acc[tt][j];
                        const float dd = fmaxf(fabsf(den), __builtin_amdgcn_exp2f(-MTv[j]));
                        const float hv = num * __builtin_amdgcn_rcpf(dd);
                        hval[tt][j] = hv;
                        float q = hv * hv;
                        q += pg8::dpp_ror<8>(q); q += pg8::dpp_ror<4>(q); q += pg8::dpp_ror<2>(q); q += pg8::dpp_ror<1>(q);
                        qs[tt][j] = q;
                    }
                }
                if (fr == 0) {
#pragma unroll
                    for (int tt = 0; tt < 2; ++tt) *(las_f32x4*)(HSQ + wave * 32 + 16 * tt + 4 * fq) = (f32x4){qs[tt][0], qs[tt][1], qs[tt][2], qs[tt][3]};
                }
            };
            auto SD = [&]() __attribute__((always_inline)) {
                const float Ml = Mlc[c], decay = __builtin_amdgcn_exp2f(m2c[c] - Ml);
                bf16x8 vfs[2], wkf[2];
#pragma unroll
                for (int g = 0; g < 2; ++g) {
                    const f32x4 a0 = *(const las_f32x4*)(A2 + cb + 32 * g + 8 * fq), a1 = *(const las_f32x4*)(A2 + cb + 32 * g + 8 * fq + 4);
                    float wk[8];
#pragma unroll
                    for (int j = 0; j < 4; ++j) { wk[j] = __builtin_amdgcn_exp2f(a0[j] - Ml); wk[4 + j] = __builtin_amdgcn_exp2f(a1[j] - Ml); }
                    typedef unsigned u32x4v __attribute__((ext_vector_type(4)));
                    const u32x4v vr = __builtin_bit_cast(u32x4v, vf[g]); u32x4v vs, ws_;
#pragma unroll
                    for (int e = 0; e < 4; ++e) { vs[e] = cvtpk(bf_lo(vr[e]) * wk[2 * e], bf_hi(vr[e]) * wk[2 * e + 1]); ws_[e] = cvtpk(wk[2 * e], wk[2 * e + 1]); }
                    vfs[g] = __builtin_bit_cast(bf16x8, vs); wkf[g] = __builtin_bit_cast(bf16x8, ws_);
                }
                const LAS bf16* Kt2 = Ks + (8 * fq + q4) * ML_KP + 4 * p4;
#pragma unroll
                for (int dt = 0; dt < 4; ++dt) {
                    Cst[dt] = Cst[dt] * decay; Nst[dt] = Nst[dt] * decay;
#pragma unroll
                    for (int g = 0; g < 2; ++g) {
                        const s16x4 lo = tr16(Kt2 + 32 * g * ML_KP + 16 * dt), hi = tr16(Kt2 + (32 * g + 4) * ML_KP + 16 * dt);
                        const bf16x8 kf = (bf16x8){lo[0], lo[1], lo[2], lo[3], hi[0], hi[1], hi[2], hi[3]};
                        Cst[dt] = __builtin_amdgcn_mfma_f32_16x16x32_bf16(kf, vfs[g], Cst[dt], 0, 0, 0);
                        Nst[dt] = __builtin_amdgcn_mfma_f32_16x16x32_bf16(kf, wkf[g], Nst[dt], 0, 0, 0);
                    }
                }
            };
            if (wave < 4) { SB(); __builtin_amdgcn_sched_barrier(0); SD(); } else { SD(); __builtin_amdgcn_sched_barrier(0); SB(); }
            if (c + 1 < NCH) ML_STORE(nbuf);
            BAR_LDS();
#pragma unroll
            for (int tt = 0; tt < 2; ++tt) {
                const int tl0 = 16 * tt + 4 * fq;
                f32x4 sp[NWAVES];
#pragma unroll
                for (int w = 0; w < NWAVES; ++w) sp[w] = *(const las_f32x4*)(HSQ + w * 32 + tl0);
                const f32x4 ss = ((sp[0] + sp[1]) + (sp[2] + sp[3])) + ((sp[4] + sp[5]) + (sp[6] + sp[7]));
#pragma unroll
                for (int j = 0; j < 4; ++j) {
                    const float r = __builtin_amdgcn_rsqf(ss[j] * (1.f / DV) + EPS);
                    const float ogf = __uint_as_float((unsigned)og[tt][j] << 16);
                    const float sg = __builtin_amdgcn_rcpf(1.f + __builtin_amdgcn_exp2f(-LOG2E * ogf));
                    const float ov = hval[tt][j] * r * whn_l * sg;
                    const size_t row = (size_t)b * SEQ + cb + 32 * rh + tl0 + j;
                    *(GAS unsigned short*)(HA + row * D + h * DV + e0 + fr) = (unsigned short)(cvtpk(ov, 0.f) & 0xffffu);
                }
            }
        }
#undef ML_LOAD
#undef ML_STORE
        __syncthreads();
    }
}

constexpr int FX_CS = 86016, FX_WT = FX_CS + 2 * SEQ * 4;
static_assert(attn_body::ATTN_LDS_BYTES <= FX_CS && FX_WT + 128 <= RING_BYTES, "fox lds map");
template <int BLK> __device__ __forceinline__ void fox_rownorm2_blocks(const bf16* T, int bh, LAS float* rown, float* out, int tid) {
    const int b = bh >> 4, h = bh & 15, sub = tid & 7, r0 = tid >> 3;
    const GAS v4u* src = (const GAS v4u*)(T + ((size_t)b * SEQ + r0) * D + h * 64 + sub * 8);
    __syncthreads();
#pragma unroll 1
    for (int it = 0; it < 64; it += 8) {
        v4u v[8];
#pragma unroll
        for (int k = 0; k < 8; ++k) v[k] = src[(size_t)(it + k) * 64 * (D / 8)];
#pragma unroll
        for (int k = 0; k < 8; ++k) {
            float q = 0.f;
#pragma unroll
            for (int e = 0; e < 4; ++e) { const float lo = bf_lo(v[k][e]), hi = bf_hi(v[k][e]); q += lo * lo + hi * hi; }
            q += __shfl_xor(q, 1); q += __shfl_xor(q, 2); q += __shfl_xor(q, 4);
            if (sub == 0) rown[(it + k) * 64 + r0] = q;
        }
    }
    __syncthreads();
    {
        const f32x4 a = *(const LAS f32x4*)(rown + 8 * tid), c = *(const LAS f32x4*)(rown + 8 * tid + 4);
        float mx = fmaxf(fmaxf(fmaxf(a[0], a[1]), fmaxf(a[2], a[3])), fmaxf(fmaxf(c[0], c[1]), fmaxf(c[2], c[3])));
#pragma unroll
        for (int o = 1; o < BLK / 8; o <<= 1) mx = fmaxf(mx, __shfl_xor(mx, o));
        if ((tid & (BLK / 8 - 1)) == 0) out[bh * (SEQ / BLK) + tid / (BLK / 8)] = mx;
    }
}
__device__ __forceinline__ void fox_cscan_phase(LAS unsigned char* lds, const float* FG, const float* kvbf, float* C2, const bf16* Kb, float* KMAX, int vcu, int G) {
    LAS float* wt = (LAS float*)(lds + FX_WT);
    for (int bh = vcu; bh < BATCH * FH; bh += G) {
        const int b = bh >> 4, h = bh & 15;
        int tid = threadIdx.x; asm volatile("" : "+v"(tid)); const int lane = tid & 63, wave = __builtin_amdgcn_readfirstlane(tid >> 6);
        const float bb = kvbf[h]; float pre[8]; float run = 0.f;
#pragma unroll
        for (int k = 0; k < 8; ++k) { const float fv = FG[((size_t)b * SEQ + 8 * tid + k) * 16 + h] + bb; const float lf = fminf(fv, 0.f) - log1pf(expf(-fabsf(fv))); run += lf * LOG2E; pre[k] = run; }
        const float incl = wscan_add(run, lane);
        __syncthreads();
        if (lane == 63) wt[wave] = incl;
        __syncthreads();
        float off = incl - run;
        for (int w = 0; w < wave; ++w) off += wt[w];
        GAS f32x4* o = (GAS f32x4*)(C2 + (size_t)bh * SEQ + 8 * tid);
        o[0] = (f32x4){off + pre[0], off + pre[1], off + pre[2], off + pre[3]}; o[1] = (f32x4){off + pre[4], off + pre[5], off + pre[6], off + pre[7]};
        fox_rownorm2_blocks<64>(Kb, bh, (LAS float*)(lds + FX_CS), KMAX, tid);
    }
}
__device__ __forceinline__ void fox_qnorm_phase(LAS unsigned char* lds, const bf16* Qb, float* QMAX, const float* C2, const float* KMAX, int* T0, int vcu, int G) {
    for (int bh = vcu; bh < BATCH * FH; bh += G) {
        int tid = threadIdx.x; asm volatile("" : "+v"(tid));
        fox_rownorm2_blocks<256>(Qb, bh, (LAS float*)(lds + FX_CS), QMAX, tid);
        __threadfence_block(); __syncthreads();
        {
            const int lane = tid & 63, wave = __builtin_amdgcn_readfirstlane(tid >> 6);
            const GAS float* c2 = (const GAS float*)C2 + (size_t)bh * SEQ; const GAS float* km = (const GAS float*)KMAX + bh * 64;
            const float cend = c2[64 * lane + 63], kt = sqrtf(km[lane]) * 1.0001f;
#pragma unroll
            for (int k = 0; k < 2; ++k) {
                const int qb = 2 * wave + k, NT = 4 * (qb + 1);
                const float qu = sqrtf(__hip_atomic_load((const GAS float*)QMAX + bh * 16 + qb, __ATOMIC_RELAXED, __HIP_MEMORY_SCOPE_AGENT)) * 1.0001f;
                const float kband = fmaxf(fmaxf(sqrtf(km[NT - 4]), sqrtf(km[NT - 3])), fmaxf(sqrtf(km[NT - 2]), sqrtf(km[NT - 1]))) * 1.0001f;
                const bool keep = (lane >= NT - 4) || (c2[256 * qb] - cend >= -(qu * (kt + kband) + 48.f));
                int t0 = __builtin_ctzll(__ballot(keep)); t0 = (t0 > NT - 4 ? NT - 4 : t0) & ~1;
                if (lane == 0) T0[bh * 16 + qb] = t0;
            }
        }
    }
}
__device__ __forceinline__ void fox_phase(unsigned char* lds_g, LAS unsigned char* lds, const bf16* Qb, const bf16* Kb, const bf16* Vb, const bf16* Gb, bf16* Ob, const float* C2, const int* T0, gu32* qhead) {
    LAS unsigned* wq = (LAS unsigned*)(lds + FX_WT + 64);
    int cb = 0;
    if (threadIdx.x == 0) { const unsigned u0 = __hip_atomic_fetch_add(qhead, 1u, __ATOMIC_RELAXED, __HIP_MEMORY_SCOPE_AGENT); wq[0] = u0; wq[1] = (u0 < (unsigned)(BATCH * FH * 16)) ? (unsigned)((const GAS int*)T0)[(u0 & 255u) * 16u + 15u - (u0 >> 8)] : 0u; }
    __syncthreads();
    {
        int tid = threadIdx.x; asm volatile("" : "+v"(tid));
        const unsigned u = wq[0];
        if (u < (unsigned)(BATCH * FH * 16)) {
            const GAS f32x4* src = (const GAS f32x4*)(C2 + (size_t)(u & 255u) * SEQ);
            const f32x4 a = src[tid], c = src[tid + 512];
            LAS float* cs0 = (LAS float*)(lds + FX_CS);
            *(LAS f32x4*)(cs0 + 4 * tid) = a; *(LAS f32x4*)(cs0 + 4 * (tid + 512)) = c;
        }
    }
    __syncthreads();
#pragma unroll 1
    for (;;) {
        const unsigned u = wq[0];
        if (u >= (unsigned)(BATCH * FH * 16)) break;
        const int qb = 15 - (int)(u >> 8), bh = (int)(u & 255u);
        const size_t so = (size_t)(bh >> 5) * ((SLAB_BYTES - SH_ROW1K) / 2);
        const int t0 = __builtin_amdgcn_readfirstlane((int)wq[1]);
        LAS float* cs = (LAS float*)(lds + FX_CS + cb * (SEQ * 4));
        attn_body::attn_unit<40>(bh >> 4, bh & 15, qb, (const attn_body::bf16*)(Qb + so), (const attn_body::bf16*)Kb, (const attn_body::bf16*)Vb, (attn_body::bf16*)(Ob + so), (const attn_body::bf16*)(Gb + so), (attn_body::lds_cf32)cs, t0, (unsigned*)qhead, wq, T0, C2, (unsigned)(FX_CS + (cb ^ 1) * (SEQ * 4)), (char*)lds_g);
        cb ^= 1;
    }
    __syncthreads();
}

struct Args { Ins in; float* out; unsigned char* ws; };
struct KArgs { const GAS float* in[18]; GAS float* out; GAS unsigned char* ws; };
static_assert(sizeof(KArgs) == sizeof(Args), "kernarg view");
typedef const __attribute__((address_space(4))) KArgs* kargs_t;
__device__ __forceinline__ kargs_t kargs() { kargs_t p = (kargs_t)__builtin_amdgcn_kernarg_segment_ptr(); asm volatile("" : "+s"(p)); return p; }
#define PHASE_IDS() \
    int tid = threadIdx.x; asm volatile("" : "+v"(tid)); \
    const int lane = tid & 63, wave = __builtin_amdgcn_readfirstlane(tid >> 6); \
    extern __shared__ __attribute__((aligned(16))) unsigned char lds_raw[]; LAS unsigned char* lds = (LAS unsigned char*)lds_raw; (void)lds; \
    int G = gridDim.x, bx = __builtin_amdgcn_readfirstlane(*(volatile LAS int*)(lds + MISC_OFF + 40)); asm volatile("" : "+s"(G), "+s"(bx));   \
    const int vcu = (bx % 8) * (G / 8) + bx / 8, xg = bx % 8; \
    const int gw = vcu * NWAVES + wave, NGW = G * NWAVES, gtid = vcu * (NWAVES * 64) + tid, NT = G * NWAVES * 64; \
    (void)lane; (void)wave; (void)vcu; (void)xg; (void)gw; (void)NGW; (void)gtid; (void)NT; \
    const kargs_t ka = kargs(); unsigned char* ws = (unsigned char*)ka->ws; (void)ws;
constexpr size_t WS_STAMP = 512 * 1024;
#if defined(PROBE_A0) || defined(PROBE_K)
#define STAMP(k) do { if (blockIdx.x == 0 && threadIdx.x == 0) { __hip_atomic_store((GAS unsigned long long*)((unsigned char*)kargs()->ws + WS_STAMP) + (k), (unsigned long long)__builtin_amdgcn_s_memrealtime(), __ATOMIC_RELAXED, __HIP_MEMORY_SCOPE_AGENT); } } while (0)
#else
#define STAMP(k) do { } while (0)
#endif
#ifdef PROBE_SKEW
#define SKEW_ARR() do { if (threadIdx.x == 0) { unsigned bx_ = blockIdx.x; asm volatile("" : "+s"(bx_)); __hip_atomic_store((GAS unsigned long long*)((unsigned char*)kargs()->ws + WS_STAMP + 4096) + ((size_t)(curL * 16 + ((__COUNTER__ >> 1) & 15)) * 256 + bx_), (unsigned long long)__builtin_amdgcn_s_memrealtime(), __ATOMIC_RELAXED, __HIP_MEMORY_SCOPE_AGENT); } } while (0)
#define SKEW_DEP() do { if (threadIdx.x == 0) { unsigned bx_ = blockIdx.x; asm volatile("" : "+s"(bx_)); __hip_atomic_store((GAS unsigned long long*)((unsigned char*)kargs()->ws + WS_STAMP + 4096 + 80 * 256 * 8) + ((size_t)(curL * 16 + (((__COUNTER__ - 1) >> 1) & 15)) * 256 + bx_), (unsigned long long)__builtin_amdgcn_s_memrealtime(), __ATOMIC_RELAXED, __HIP_MEMORY_SCOPE_AGENT); } } while (0)
#else
#define SKEW_ARR() do { } while (0)
#define SKEW_DEP() do { } while (0)
#endif
#define GRID_BAR_ALL() do { SKEW_ARR(); { extern __shared__ __attribute__((aligned(16))) unsigned char lds_b_[]; XcdBarrier bar_; bar_.bar = (unsigned*)((unsigned char*)kargs()->ws + WS_CTL) + CW_BAR; bar_.x = xb_xcc_id(); \
    bar_.st = (volatile LAS unsigned*)((LAS unsigned char*)lds_b_ + MISC_OFF) + 8; xcd_barrier(bar_); } SKEW_DEP(); } while (0)
#define GRID_BAR() do { SKEW_ARR(); { extern __shared__ __attribute__((aligned(16))) unsigned char lds_b_[]; volatile LAS unsigned* st_ = (volatile LAS unsigned*)((LAS unsigned char*)lds_b_ + MISC_OFF) + 8; \
    unsigned* barw_ = (unsigned*)((unsigned char*)kargs()->ws + WS_CTL) + CW_BAR; \
    if (__builtin_amdgcn_readfirstlane(st_[3])) xcc_local_barrier(barw_, xb_xcc_id(), 32u); \
    else { XcdBarrier bar_; bar_.bar = barw_; bar_.x = xb_xcc_id(); bar_.st = st_; xcd_barrier(bar_); } } SKEW_DEP(); } while (0)

__global__ void __launch_bounds__(NWAVES * 64, 2) yoco_fwd(Args args_unused) {
#ifdef PROBE_SKEW
    int curL = 4;
#endif
    STAMP(100);
    {
        extern __shared__ __attribute__((aligned(16))) unsigned char lds_z_[]; LAS unsigned char* ldz = (LAS unsigned char*)lds_z_;
        for (int u = threadIdx.x; u < (LDS_BYTES - LDSCTL_OFF) / 4; u += NWAVES * 64) ((LAS unsigned*)(ldz + LDSCTL_OFF))[u] = 0u;
        __syncthreads();
        if (threadIdx.x == 0) {
            unsigned* barw = (unsigned*)((unsigned char*)kargs()->ws + WS_CTL) + CW_BAR; volatile LAS unsigned* st = (volatile LAS unsigned*)(ldz + MISC_OFF) + 8;
            st[4] = xb_add(&barw[XB_XCNT(xb_xcc_id())], 1u); st[2] = blockIdx.x;
        }
        __syncthreads();
    }
    {
        PHASE_IDS();
        Ins in;
#pragma unroll
        for (int i = 0; i < 18; ++i) in.p[i] = (const float*)ka->in[i];
        prologue_weights(in, ws, lds, gw, NGW, wave, lane);
        STAMP(102);
        norm_first(in.p[0], (bf16*)(ws + WS_XH), (float*)(ws + WS_RSTD), gw, NGW, lane);
        for (int i = gtid; i < (int)((4 * MiB) / 16); i += NT) ((GAS v4u*)(ws + WS_SUMS))[i] = (v4u){0u, 0u, 0u, 0u};
    }
    GRID_BAR();
    {
        extern __shared__ __attribute__((aligned(16))) unsigned char lds_m_[]; volatile LAS unsigned* st = (volatile LAS unsigned*)((LAS unsigned char*)lds_m_ + MISC_OFF) + 8;
        if (threadIdx.x == 0) {
            unsigned* barw = (unsigned*)((unsigned char*)kargs()->ws + WS_CTL) + CW_BAR; const unsigned x = xb_xcc_id();
            bool uni = (gridDim.x == 256u) && (x < 8u);
            for (unsigned j = 0; j < 8; ++j) uni = uni && (xb_ld(&barw[XB_XCNT(j)]) == 32u);
#if GROUP_LOCAL_SYNC
            if (uni) { st[2] = st[4] * 8u + x; st[3] = 1u; }
#else
            (void)uni;
#endif
        }
        __syncthreads();
    }
    STAMP(101);

#pragma unroll 1
    for (int L = 0; L < 4; ++L) {
        STAMP(L * 20 + 0);
#ifdef PROBE_SKEW
        curL = L;
#endif
        if (L < 2) {
            {
                PHASE_IDS();
                pg8::Gemm g{(const bf16*)(ws + WS_XH), (const bf16*)(ws + WS_WIN + L * SZ_WIN), M, MIN_NP, D}; pg8::StaticOrder S; S.init(M, MIN_NP, G, bx);
                pg8::EpiOut E{(bf16*)SLAB(SO_QKVO, SH_QKVO), MIN_LD, 0, 0, 1.f, MIN_LD / 256, (float*)(ws + WS_GATES), nullptr};
                pg8::gemm_phase<pg8::EpiOut, pg8::StaticOrder, true, true>(lds + RING_OFF, g, S, E);
            }
            GRID_BAR();
            STAMP(L * 20 + 1);
            {
                PHASE_IDS();
                mlstm_phase(lds, (const bf16*)SLAB(SO_QKVO, SH_QKVO), (const float*)(ws + WS_GATES), (const float*)ka->in[6] + L * 16, (const float*)ka->in[7] + L * D, (bf16*)SLAB(SO_HA, SH_ROW1K), vcu, G, tid, wave, lane);
            }
        } else {
            {
                PHASE_IDS();
                const int j = L - 2;
                pg8::Gemm g{(const bf16*)(ws + WS_XH), (const bf16*)(ws + WS_WQG + j * SZ_WQG), M, 2 * D, D}; pg8::StaticOrder S; S.init(M, 2 * D, G, bx);
                pg8::EpiOut E{(bf16*)SLAB(SO_FQ, SH_ROW1K), D, D, (size_t)(SO_FG - SO_FQ) / 2, attn_body::C2, -1, nullptr, nullptr, (int*)(ws + WS_T0), (const float*)(ws + WS_C2), (const float*)(ws + WS_KMAX), (LAS float*)(lds + XCH_OFF)};
                pg8::gemm_phase<pg8::EpiOut, pg8::StaticOrder, true, true>(lds + RING_OFF, g, S, E);
            }
            GRID_BAR_ALL();
            STAMP(L * 20 + 1);
            {
                PHASE_IDS();
                fox_phase(lds_raw, lds, (const bf16*)(ws + WS_S + SO_FQ), (const bf16*)(ws + WS_KB), (const bf16*)(ws + WS_VB), (const bf16*)(ws + WS_S + SO_FG), (bf16*)(ws + WS_S + SO_FQ), (const float*)(ws + WS_C2), (const int*)(ws + WS_T0), (gu32*)(ws + WS_CTL) + CW_QUEUE + 64 * (L - 2));
            }
        }
        if (L < 2) GRID_BAR(); else GRID_BAR_ALL();
        STAMP(L * 20 + 2);
        {
            PHASE_IDS();
            const bf16* Aout = (L < 2) ? (const bf16*)SLAB(SO_HA, SH_ROW1K) : (const bf16*)SLAB(SO_FQ, SH_ROW1K);
            const bf16* Wout = (L < 2) ? (const bf16*)(ws + WS_WMOUT + L * SZ_SQ) : (const bf16*)(ws + WS_WFOUT + (L - 2) * SZ_SQ);
            pg8::Gemm g{Aout, Wout, M, D, D}; pg8::StaticOrder S; S.init(M, D, G, bx);
            pg8::EpiNormRes E{(bf16*)(ws + WS_XH), (float*)(ws + WS_RSTD), (const float*)ka->in[2] + L * D, nullptr, false, (float*)(ws + WS_SUMS), (unsigned*)(ws + WS_CTL) + CW_NCNT, (unsigned*)(ws + WS_CTL) + CW_BAR + XB_TMO, 2 * L, lds + XCH_OFF};
            pg8::gemm_phase<pg8::EpiNormRes, pg8::StaticOrder, true, true>(lds + RING_OFF, g, S, E);
        }
        GRID_BAR();
        STAMP(L * 20 + 3);
        STAMP(L * 20 + 4);
        {
            PHASE_IDS();
            pg8::Gemm g{(const bf16*)(ws + WS_XH), (const bf16*)(ws + WS_WUP + L * SZ_WUP), M, DFF2, D}; pg8::StaticOrder S; S.init(M, DFF2, G, bx);
            pg8::EpiConv E{(bf16*)SLAB(SO_ACT, SH_ACT), (const float*)ka->in[15] + (size_t)L * 3 * DFF2, (const float*)ka->in[16] + (size_t)L * DFF2, (float*)SLAB(SO_HALO, SH_HALO), lds + XCH_OFF, DFF, (const float*)(ws + WS_RSTD)};
            pg8::gemm_phase<pg8::EpiConv, pg8::StaticOrder, true, true>(lds + RING_OFF, g, S, E);
        }
        GRID_BAR();
        STAMP(L * 20 + 5);
        {
            PHASE_IDS();
            ffn_fixup_phase((const float*)SLAB(SO_HALO, SH_HALO), (const float*)ka->in[15] + (size_t)L * 3 * DFF2, (const float*)ka->in[16] + (size_t)L * DFF2, (bf16*)SLAB(SO_ACT, SH_ACT), vcu, tid);
        }
        GRID_BAR();
        STAMP(L * 20 + 6);
        {
            PHASE_IDS();
            pg8::Gemm g{(const bf16*)SLAB(SO_ACT, SH_ACT), (const bf16*)(ws + WS_WDN + L * SZ_WDN), M, D, DFF}; pg8::StaticOrder S; S.init(M, D, G, bx);
            pg8::EpiNormRes E{(bf16*)(ws + WS_XH), (float*)(ws + WS_RSTD), (const float*)ka->in[4] + L * D, (float*)ka->out, L == 3, (float*)(ws + WS_SUMS), (unsigned*)(ws + WS_CTL) + CW_NCNT, (unsigned*)(ws + WS_CTL) + CW_BAR + XB_TMO, 2 * L + 1, lds + XCH_OFF};
            pg8::gemm_phase<pg8::EpiNormRes, pg8::StaticOrder, true, true>(lds + RING_OFF, g, S, E);
        }
        GRID_BAR();
        STAMP(L * 20 + 10);
        STAMP(L * 20 + 11);
        if (L == 1) {
            PHASE_IDS();
            pg8::Gemm g{(const bf16*)(ws + WS_XH), (const bf16*)(ws + WS_WKV), M, KV_NP, D}; pg8::StaticOrder S; S.init(M, KV_NP, G, bx);
            pg8::EpiOut E{(bf16*)(ws + WS_KB), D, D, (size_t)(WS_VB - WS_KB) / 2, 1.f, 8, (float*)(ws + WS_GATES), nullptr};
            pg8::gemm_phase<pg8::EpiOut, pg8::StaticOrder, true, true>(lds + RING_OFF, g, S, E);
        }
        if (L == 1) {
            GRID_BAR();
            PHASE_IDS();
            fox_cscan_phase(lds, (const float*)(ws + WS_GATES), (const float*)ka->in[11], (float*)(ws + WS_C2), (const bf16*)(ws + WS_KB), (float*)(ws + WS_KMAX), vcu, G);
        }
        STAMP(L * 20 + 12);
    }
#ifdef PROBE_K
    if (blockIdx.x == 0 && threadIdx.x == 0) {
        const GAS unsigned long long* ts = (const GAS unsigned long long*)((unsigned char*)kargs()->ws + WS_STAMP);
        unsigned long long tot = 0;
        for (int L = 0; L < 6; ++L) if ((PROBE_LMASK >> L) & 1) {
            tot += __hip_atomic_load(ts + 20 * L + PROBE_S1, __ATOMIC_RELAXED, __HIP_MEMORY_SCOPE_AGENT) - __hip_atomic_load(ts + 20 * L + PROBE_S0, __ATOMIC_RELAXED, __HIP_MEMORY_SCOPE_AGENT);
#ifdef PROBE_T0
            tot += __hip_atomic_load(ts + 20 * L + PROBE_T1, __ATOMIC_RELAXED, __HIP_MEMORY_SCOPE_AGENT) - __hip_atomic_load(ts + 20 * L + PROBE_T0, __ATOMIC_RELAXED, __HIP_MEMORY_SCOPE_AGENT);
#endif
        }
        const unsigned long long t0 = __builtin_amdgcn_s_memrealtime();
        while (__builtin_amdgcn_s_memrealtime() - t0 < (unsigned long long)PROBE_K * tot) __builtin_amdgcn_s_sleep(16);
    }
#endif
#ifdef PROBE_END
    {
        extern __shared__ __attribute__((aligned(16))) unsigned char lds_e_[]; volatile LAS unsigned* st = (volatile LAS unsigned*)((LAS unsigned char*)lds_e_ + MISC_OFF) + 8;
        GAS unsigned long long* en = (GAS unsigned long long*)((unsigned char*)kargs()->ws + WS_STAMP + 4096);
        if (threadIdx.x == 0) __hip_atomic_store(en + st[2], (unsigned long long)__builtin_amdgcn_s_memrealtime(), __ATOMIC_RELAXED, __HIP_MEMORY_SCOPE_AGENT);
        GRID_BAR_ALL();
        if (blockIdx.x == 0 && threadIdx.x < 64) {
            unsigned long long gmx = 0, gmn = ~0ull;
            for (int x = 0; x < 8; ++x) {
                unsigned long long v = __hip_atomic_load(en + x + 8 * (threadIdx.x & 31), __ATOMIC_RELAXED, __HIP_MEMORY_SCOPE_AGENT);
                for (int o = 32; o; o >>= 1) { const unsigned long long a = __shfl_xor(v, o); v = a > v ? a : v; }
                gmx = v > gmx ? v : gmx; gmn = v < gmn ? v : gmn;
            }
            if (threadIdx.x == 0) { const unsigned long long t0 = __builtin_amdgcn_s_memrealtime(); while (__builtin_amdgcn_s_memrealtime() - t0 < (unsigned long long)PROBE_END * (gmx - gmn)) __builtin_amdgcn_s_sleep(16); }
        }
    }
#endif
#ifdef PROBE_MODE
    { extern __shared__ __attribute__((aligned(16))) unsigned char lds_p_[]; volatile LAS unsigned* st = (volatile LAS unsigned*)((LAS unsigned char*)lds_p_ + MISC_OFF) + 8;
      if (blockIdx.x == 0 && threadIdx.x == 0 && st[3]) { const unsigned long long t0 = __builtin_amdgcn_s_memrealtime(); while (__builtin_amdgcn_s_memrealtime() - t0 < 200000ull) __builtin_amdgcn_s_sleep(16); } }
#endif
#ifdef PROBE_SKEW
    GRID_BAR();
    if (blockIdx.x == 0 && threadIdx.x < 64) {
        const GAS unsigned long long* ar = (const GAS unsigned long long*)((unsigned char*)kargs()->ws + WS_STAMP + 4096);
        unsigned long long tot = 0;
#if PROBE_SMODE == 2
        unsigned long long gx[8] = {0, 0, 0, 0, 0, 0, 0, 0};
        for (int s = 0; s < 80; ++s) if ((PROBE_SMASK >> (s & 15)) & 1u) {
            unsigned long long mxx[8], mall = 0;
#pragma unroll
            for (int x = 0; x < 8; ++x) {
                unsigned long long v = __hip_atomic_load(ar + (size_t)s * 256 + x + 8 * (threadIdx.x & 31), __ATOMIC_RELAXED, __HIP_MEMORY_SCOPE_AGENT);
                for (int o = 32; o; o >>= 1) { const unsigned long long a = __shfl_xor(v, o); v = a > v ? a : v; }
                mxx[x] = v; mall = v > mall ? v : mall;
            }
            if (mxx[0] != 0) {
#pragma unroll
                for (int x = 0; x < 8; ++x) gx[x] += mall - mxx[x];
            }
        }
        tot = gx[0];
#pragma unroll
        for (int x = 1; x < 8; ++x) tot = gx[x] < tot ? gx[x] : tot;
#endif
#if PROBE_SMODE == 3
        for (int s = 0; s < 80; ++s) if ((PROBE_SMASK >> (s & 15)) & 1u) {
            unsigned long long mx = 0, mn = ~0ull;
            for (int j = 0; j < 4; ++j) { const unsigned long long v = __hip_atomic_load(ar + (size_t)s * 256 + threadIdx.x * 4 + j, __ATOMIC_RELAXED, __HIP_MEMORY_SCOPE_AGENT); mx = v > mx ? v : mx;
                const unsigned long long w = __hip_atomic_load(ar + (size_t)(80 + s) * 256 + threadIdx.x * 4 + j, __ATOMIC_RELAXED, __HIP_MEMORY_SCOPE_AGENT); mn = w < mn ? w : mn; }
            for (int o = 32; o; o >>= 1) { const unsigned long long a = __shfl_xor(mx, o), b = __shfl_xor(mn, o); mx = a > mx ? a : mx; mn = b < mn ? b : mn; }
            if (mx != 0 && mn > mx) tot += mn - mx;
        }
#endif
        for (int s = 0; s < 80 && PROBE_SMODE < 2; ++s) if ((PROBE_SMASK >> (s & 15)) & 1u) {
            unsigned long long mx = 0, mn = ~0ull, sm = 0;
            for (int j = 0; j < 4; ++j) { const unsigned long long v = __hip_atomic_load(ar + (size_t)s * 256 + threadIdx.x * 4 + j, __ATOMIC_RELAXED, __HIP_MEMORY_SCOPE_AGENT); mx = v > mx ? v : mx; mn = v < mn ? v : mn; sm += v; }
            for (int o = 32; o; o >>= 1) { const unsigned long long a = __shfl_xor(mx, o), b = __shfl_xor(mn, o), c = __shfl_xor(sm, o); mx = a > mx ? a : mx; mn = b < mn ? b : mn; sm += c; }
            if (mn != 0) tot += (PROBE_SMODE == 0) ? (mx - mn) : (mx - sm / 256);
        }
        if (threadIdx.x == 0) {
            const unsigned long long t0 = __builtin_amdgcn_s_memrealtime();
            while (__builtin_amdgcn_s_memrealtime() - t0 < (unsigned long long)PROBE_SKEW * tot) __builtin_amdgcn_s_sleep(16);
        }
    }
#endif
#ifdef PROBE_A0
    GRID_BAR();
    {
        PHASE_IDS();
        const GAS unsigned long long* ts = (const GAS unsigned long long*)(ws + WS_STAMP);
        const float c = (float)(__hip_atomic_load(ts + PROBE_A1, __ATOMIC_RELAXED, __HIP_MEMORY_SCOPE_AGENT) - __hip_atomic_load(ts + PROBE_A0, __ATOMIC_RELAXED, __HIP_MEMORY_SCOPE_AGENT)) * 0.001f;
        const float d = (float)(__hip_atomic_load(ts + PROBE_B1, __ATOMIC_RELAXED, __HIP_MEMORY_SCOPE_AGENT) - __hip_atomic_load(ts + PROBE_B0, __ATOMIC_RELAXED, __HIP_MEMORY_SCOPE_AGENT)) * 0.01f;
        GAS float* o = (GAS float*)ka->out;
        for (size_t i = gtid; i < (size_t)M * D; i += NT) o[i] = (i == 0) ? d : c;
    }
#endif
}

extern "C" void kernel_launch(void* const* d_in, const int* in_sizes, int n_in, void* d_out, int out_size, void* d_ws, size_t ws_size, hipStream_t stream) {
    static int grid = 0;
    if (grid == 0) {
        if (n_in != 18 || in_sizes[0] != M * D || out_size != M * D || ws_size < WS_END) { fprintf(stderr, "kernel_launch: unexpected shapes (n_in %d, in0 %d, out %d, ws %zu); nothing launched\n", n_in, n_in > 0 ? in_sizes[0] : -1, out_size, ws_size); grid = -1; return; }
        if (hipFuncSetAttribute((const void*)yoco_fwd, hipFuncAttributeMaxDynamicSharedMemorySize, LDS_BYTES) != hipSuccess) { fprintf(stderr, "kernel_launch: hipFuncSetAttribute failed\n"); grid = -1; return; }
        int dev = 0, cus = 0, per_cu = 0;
        (void)hipGetDevice(&dev); (void)hipDeviceGetAttribute(&cus, hipDeviceAttributeMultiprocessorCount, dev);
        (void)hipOccupancyMaxActiveBlocksPerMultiprocessor(&per_cu, (const void*)yoco_fwd, NWAVES * 64, LDS_BYTES);
        (void)hipGetLastError();
        grid = (cus >= 256 && per_cu >= 1) ? 256 : (cus > 0 ? cus : 256);
    }
    if (grid < 0) return;
    (void)hipMemsetAsync((char*)d_ws + WS_CTL, 0, CTL_ZERO_BYTES, stream);
    Args a{};
    for (int i = 0; i < 18; ++i) a.in.p[i] = (const float*)d_in[i];
    a.out = (float*)d_out; a.ws = (unsigned char*)d_ws;
    hipLaunchKernelGGL(yoco_fwd, dim3(grid), dim3(NWAVES * 64), LDS_BYTES, stream, a);
}
```

```cpp
#include <hip/hip_runtime.h>
#include <hip/hip_bf16.h>
#include <cstdio>
#include <cstdint>
#include <cmath>

#include <hip/hip_runtime.h>
#include <cstdio>
#include <cstdint>
namespace pg8 {
#define PG8_LAS __attribute__((address_space(3)))
typedef unsigned short bf16_t;
typedef short bf16x8 __attribute__((ext_vector_type(8)));
typedef float f32x4 __attribute__((ext_vector_type(4)));
typedef unsigned u32x4 __attribute__((ext_vector_type(4)));
constexpr int BM = 256, BK = 64, HALF = 128, HTB = HALF * BK * 2  , STAGE_BYTES = 8 * HTB, NXCD = 8, WGM = 8;

__host__ __device__ __forceinline__ int lds_byte(int r, int c) { const int st = (r >> 4) * 2 + (c >> 5), rr = r & 15, cc = c & 31, ob = rr * 64 + cc * 2; return st * 1024 + (ob ^ (((ob >> 9) & 1) << 5)); }
__host__ __device__ __forceinline__ void stage_rc(int b, int& R, int& C) { const int st = b / 1024, sb = b % 1024, swz = sb ^ (((sb >> 9) & 1) << 5); R = (st >> 1) * 16 + swz / 64; C = (st & 1) * 32 + (swz % 64) / 2; }
__host__ __device__ __forceinline__ int perm32(int rho) { const int n = rho >> 4, i = rho & 15; return 8 * (i >> 2) + 4 * n + (i & 3); }

struct Unit { int pm, pn; };
struct Gemm { const bf16_t* A; const bf16_t* Bt; int M, N, K; };

struct StaticOrder {
    int nM, nN, nwg, G, c;
    __host__ __device__ void init(int M, int N, int G_, int c_) { nM = M / BM; nN = N / BM; nwg = nM * nN; G = G_; c = c_; }
    __host__ __device__ bool next(int i, Unit& u) const {
        const long L = (long)i * G + c; if (L >= nwg) return false;
        int wgid = (int)L; { const int q = nwg / NXCD, r = nwg % NXCD, xcd = wgid % NXCD, off = wgid / NXCD; wgid = (xcd < r ? xcd * (q + 1) : r * (q + 1) + (xcd - r) * q) + off; }
        const int nig = WGM * nN, gid = wgid / nig, fm = gid * WGM, gsz = (nM - fm) < WGM ? (nM - fm) : WGM;
        u.pm = fm + ((wgid % nig) % gsz); u.pn = (wgid % nig) / gsz; return true;
    }
    __device__ __forceinline__ void a_ready(const Unit&) const {}
    __device__ __forceinline__ void done(const Unit&) const {}
};

__device__ __forceinline__ unsigned cvt_pk_bf16(float lo, float hi) { unsigned r; asm volatile("v_cvt_pk_bf16_f32 %0, %1, %2" : "=v"(r) : "v"(lo), "v"(hi)); return r; }
typedef float f32x2 __attribute__((ext_vector_type(2)));
__device__ __forceinline__ f32x2 gelu_pk(f32x2 v) {
    const f32x2 av = __builtin_elementwise_abs(v), d = av * 0.2316418882f + 1.0f;
    f32x2 t; t.x = __builtin_amdgcn_rcpf(d.x); t.y = __builtin_amdgcn_rcpf(d.y);
    f32x2 q = t * 0.5307027145f + (-0.7265760135f); q = q * t + 0.7107068705f; q = q * t + (-0.142248368f); q = q * t + 0.127414796f; q = q * t;
    const f32x2 s = (v * v) * (-0.72134752044f);
    f32x2 e; e.x = __builtin_amdgcn_exp2f(s.x); e.y = __builtin_amdgcn_exp2f(s.y);
    const f32x2 m = v * (q * e), r = v - m;
    f32x2 o; o.x = v.x < 0.f ? m.x : r.x; o.y = v.y < 0.f ? m.y : r.y; return o;
}

template <int ACT  > struct EpiBf16 {
    static constexpr bool PERM = true, AFTER_DRAIN = false; static_assert(ACT == 0 || ACT == 1, "EpiBf16: ACT is 0 (none) or 1 (gelu_pk)");
    bf16_t* O; int ldc; const float* bias; int split_cols; size_t split_stride; float scale0;
    __device__ __forceinline__ void operator()(const f32x4 (&acc)[2][2][4][2], const Unit& u, int wr, int wc, int fr, int fq) const {
        const int row0 = u.pm * BM + wr * 64 + fr; int colt = u.pn * BM; bf16_t* base = O;
        float sc = 1.f; if (split_cols) { const int t = colt / split_cols; base += (size_t)t * split_stride; colt -= t * split_cols; if (t == 0) sc = scale0; }
        const int col0 = colt + wc * 32 + 8 * fq, bcol0 = u.pn * BM + wc * 32 + 8 * fq;
        f32x4 bv[2][2];
#pragma unroll
        for (int bj = 0; bj < 2; ++bj)
#pragma unroll
            for (int n = 0; n < 2; ++n) bv[bj][n] = bias ? *(const f32x4*)(bias + bcol0 + bj * HALF + 4 * n) : (f32x4){0.f, 0.f, 0.f, 0.f};
#pragma unroll
        for (int ai = 0; ai < 2; ++ai)
#pragma unroll
            for (int m = 0; m < 4; ++m) { bf16_t* rowp = base + (size_t)(row0 + ai * HALF + m * 16) * ldc + col0;
#pragma unroll
                for (int bj = 0; bj < 2; ++bj) { f32x4 v0 = acc[ai][bj][m][0] + bv[bj][0], v1 = acc[ai][bj][m][1] + bv[bj][1];
                    if (ACT == 1) { f32x2 a = gelu_pk((f32x2){v0[0], v0[1]}), b = gelu_pk((f32x2){v0[2], v0[3]}), c = gelu_pk((f32x2){v1[0], v1[1]}), d = gelu_pk((f32x2){v1[2], v1[3]});
                        v0 = (f32x4){a.x, a.y, b.x, b.y}; v1 = (f32x4){c.x, c.y, d.x, d.y}; }
                    v0 = v0 * sc; v1 = v1 * sc; u32x4 w; w.x = cvt_pk_bf16(v0[0], v0[1]); w.y = cvt_pk_bf16(v0[2], v0[3]); w.z = cvt_pk_bf16(v1[0], v1[1]); w.w = cvt_pk_bf16(v1[2], v1[3]);
                    *(u32x4*)(rowp + bj * HALF) = w; } }
    }
};

struct PanelStats {
    unsigned* xbuf;
    unsigned* cnt;
    unsigned* tmo;
    int ntn; float eps;
    unsigned code;
    __device__ __forceinline__ bool run(const f32x4 (&v)[2][2][4][2], const Unit& u, int wr, int wc, int fr, int fq, PG8_LAS unsigned char* lds, int wid, int lane) const {
        typedef float f32x2v __attribute__((ext_vector_type(2)));
        PG8_LAS f32x2v* P = (PG8_LAS f32x2v*)lds;
        PG8_LAS f32x2v* S = (PG8_LAS f32x2v*)(lds + 8192);
        PG8_LAS unsigned* flag = (PG8_LAS unsigned*)(lds + 8192 + 2048);
#pragma unroll
        for (int ai = 0; ai < 2; ++ai)
#pragma unroll
            for (int m = 0; m < 4; ++m) {
                float s = 0.f;
#pragma unroll
                for (int bj = 0; bj < 2; ++bj)
#pragma unroll
                    for (int n = 0; n < 2; ++n) { const f32x4 x = v[ai][bj][m][n]; s += (x[0] + x[1]) + (x[2] + x[3]); }
                s += __shfl_xor(s, 16); s += __shfl_xor(s, 32);
                const float mw = s * (1.0f / 64.0f); float q = 0.f;
#pragma unroll
                for (int bj = 0; bj < 2; ++bj)
#pragma unroll
                    for (int n = 0; n < 2; ++n) { const f32x4 d = v[ai][bj][m][n] - mw; q += (d[0] * d[0] + d[1] * d[1]) + (d[2] * d[2] + d[3] * d[3]); }
                q += __shfl_xor(q, 16); q += __shfl_xor(q, 32);
                if (fq == 0) P[(ai * HALF + wr * 64 + m * 16 + fr) * 4 + wc] = (f32x2v){mw, q};
            }
        asm volatile("s_waitcnt lgkmcnt(0)" ::: "memory"); __builtin_amdgcn_s_barrier(); asm volatile("" ::: "memory");
#if defined(BROKEN_EXCHANGE_NO_WAIT)
#warning BROKEN CONTROL BUILD: the row-statistics exchange does not wait; results are wrong by design
        if (blockIdx.x >= 64) { const long long t0_ = clock64(); while (clock64() - t0_ < 60000) __builtin_amdgcn_s_sleep(8); }
#endif
        const int row = wid * 32 + (lane & 31);
        if (lane < 32) {
            const f32x2v a = P[row * 4 + 0], b = P[row * 4 + 1], c = P[row * 4 + 2], d = P[row * 4 + 3];
            const float mt = (a.x + b.x + c.x + d.x) * 0.25f;
            const float da = a.x - mt, db = b.x - mt, dc = c.x - mt, dd = d.x - mt;
            const float m2 = (a.y + b.y) + (c.y + d.y) + 64.0f * ((da * da + db * db) + (dc * dc + dd * dd));
            unsigned long long* slot = (unsigned long long*)xbuf + ((size_t)(u.pm * BM + row) * 4 + u.pn);
            __hip_atomic_store(slot, ((unsigned long long)__float_as_uint(m2) << 32) | __float_as_uint(mt), __ATOMIC_RELAXED, __HIP_MEMORY_SCOPE_AGENT);
        }
        asm volatile("s_waitcnt vmcnt(0)" ::: "memory");
        if (lane == 0) __hip_atomic_fetch_add(cnt + 64 * u.pm, 1u, __ATOMIC_RELAXED, __HIP_MEMORY_SCOPE_AGENT);
        if (wid == 0) {
            bool dead = false; const unsigned long long t0 = __builtin_amdgcn_s_memrealtime(); const unsigned want = 8u * (unsigned)ntn;
            for (;;) {
#if defined(BROKEN_EXCHANGE_NO_WAIT)
                break;
#endif
                if ((unsigned)__builtin_amdgcn_readfirstlane(__hip_atomic_load(cnt + 64 * u.pm, __ATOMIC_RELAXED, __HIP_MEMORY_SCOPE_AGENT)) >= want) break;
                if (__builtin_amdgcn_s_memrealtime() - t0 > 2000000ull) {
                    if (lane == 0) { unsigned expect = 0u; __hip_atomic_compare_exchange_strong(tmo + 1, &expect, code | (unsigned)(u.pm & 0xff), __ATOMIC_RELAXED, __ATOMIC_RELAXED, __HIP_MEMORY_SCOPE_AGENT);
                                     __hip_atomic_store(tmo, 1u, __ATOMIC_RELAXED, __HIP_MEMORY_SCOPE_AGENT); }
                    dead = true; break; }
                __builtin_amdgcn_s_sleep(2);
            }
            __builtin_amdgcn_fence(__ATOMIC_ACQUIRE, "agent");
            if (lane == 0) flag[0] = dead ? 1u : 0u;
        }
        asm volatile("s_waitcnt vmcnt(0) lgkmcnt(0)" ::: "memory"); __builtin_amdgcn_s_barrier(); asm volatile("" ::: "memory");
        const bool bad = flag[0] != 0u;
        if (lane < 32) {
            const unsigned long long* slot = (const unsigned long long*)xbuf + (size_t)(u.pm * BM + row) * 4; float mt[4], m2[4]; float ms = 0.f;
#pragma unroll
            for (int t = 0; t < 4; ++t) { if (t < ntn) { const unsigned long long w = __hip_atomic_load(slot + t, __ATOMIC_RELAXED, __HIP_MEMORY_SCOPE_AGENT); mt[t] = __uint_as_float((unsigned)w); m2[t] = __uint_as_float((unsigned)(w >> 32)); } else { mt[t] = 0.f; m2[t] = 0.f; } ms += mt[t]; }
            const float mean = ms / (float)ntn; float q = 0.f;
#pragma unroll
            for (int t = 0; t < 4; ++t) if (t < ntn) { const float dm = mt[t] - mean; q += m2[t] + 256.0f * dm * dm; }
            S[row] = (f32x2v){mean, 1.0f / sqrtf(q / (256.0f * (float)ntn) + eps)};
        }
        asm volatile("s_waitcnt lgkmcnt(0)" ::: "memory"); __builtin_amdgcn_s_barrier(); asm volatile("" ::: "memory");
        return bad;
    }
};
struct EpiLnRes {
    static constexpr bool PERM = false, AFTER_DRAIN = true;
    const float* base; float* out; int ldc; const float* bias; PanelStats st; unsigned poison;
    __device__ __forceinline__ void fused(f32x4 (&acc)[2][2][4][2], const Unit& u, int wr, int wc, int fr, int fq, PG8_LAS unsigned char* lds, int wid, int lane) const {
        typedef float f32x2v __attribute__((ext_vector_type(2)));
        const PG8_LAS f32x2v* S = (const PG8_LAS f32x2v*)(lds + 8192);
        const int col0 = u.pn * BM + wc * 32 + 4 * fq;
#pragma unroll
        for (int bj = 0; bj < 2; ++bj)
#pragma unroll
            for (int n = 0; n < 2; ++n) { const f32x4 bv = bias ? *(const f32x4*)(bias + col0 + bj * HALF + n * 16) : (f32x4){0.f, 0.f, 0.f, 0.f};
#pragma unroll
                for (int ai = 0; ai < 2; ++ai)
#pragma unroll
                    for (int m = 0; m < 4; ++m) acc[ai][bj][m][n] += bv; }
        f32x4 pre[4][2][2];
#pragma unroll
        for (int m = 0; m < 4; ++m) { const size_t off = (size_t)(u.pm * BM + wr * 64 + m * 16 + fr) * ldc + col0;
#pragma unroll
            for (int bj = 0; bj < 2; ++bj)
#pragma unroll
                for (int n = 0; n < 2; ++n) pre[m][bj][n] = *(const f32x4*)(base + off + bj * HALF + n * 16); }
        const bool bad = st.run(acc, u, wr, wc, fr, fq, lds, wid, lane) || poison != 0u;
        const float qnan = __builtin_nanf("");
#pragma unroll
        for (int ai = 0; ai < 2; ++ai)
#pragma unroll
            for (int m = 0; m < 4; ++m) { const int r = ai * HALF + wr * 64 + m * 16 + fr; const f32x2v sr = S[r]; const size_t off = (size_t)(u.pm * BM + r) * ldc + col0;
#pragma unroll
                for (int bj = 0; bj < 2; ++bj)
#pragma unroll
                    for (int n = 0; n < 2; ++n) { const f32x4 bs = ai == 0 ? pre[m][bj][n] : *(const f32x4*)(base + off + bj * HALF + n * 16); f32x4 o = bs + (acc[ai][bj][m][n] - sr.x) * sr.y;
                        if (bad) o = (f32x4){qnan, qnan, qnan, qnan}; *(f32x4*)(out + off + bj * HALF + n * 16) = o; }
                if (m & 1) asm volatile("" ::: "memory"); }
    }
};
struct EpiLnResLn {
    static constexpr bool PERM = false, AFTER_DRAIN = true;
    const float* base; float* out; bf16_t* xn; int ldc; const float* bias; PanelStats st1, st2; unsigned poison;
    __device__ __forceinline__ void fused(f32x4 (&acc)[2][2][4][2], const Unit& u, int wr, int wc, int fr, int fq, PG8_LAS unsigned char* lds, int wid, int lane) const {
        typedef float f32x2v __attribute__((ext_vector_type(2))); typedef unsigned u32x2v __attribute__((ext_vector_type(2)));
        const PG8_LAS f32x2v* S = (const PG8_LAS f32x2v*)(lds + 8192);
        const int col0 = u.pn * BM + wc * 32 + 4 * fq;
#pragma unroll
        for (int bj = 0; bj < 2; ++bj)
#pragma unroll
            for (int n = 0; n < 2; ++n) { const f32x4 bv = bias ? *(const f32x4*)(bias + col0 + bj * HALF + n * 16) : (f32x4){0.f, 0.f, 0.f, 0.f};
#pragma unroll
                for (int ai = 0; ai < 2; ++ai)
#pragma unroll
                    for (int m = 0; m < 4; ++m) acc[ai][bj][m][n] += bv; }
        bool bad = st1.run(acc, u, wr, wc, fr, fq, lds, wid, lane) || poison != 0u;
        const float qnan = __builtin_nanf("");
#pragma unroll
        for (int ai = 0; ai < 2; ++ai)
#pragma unroll
            for (int m = 0; m < 4; ++m) { const int r = ai * HALF + wr * 64 + m * 16 + fr; const f32x2v sr = S[r]; const size_t off = (size_t)(u.pm * BM + r) * ldc + col0;
#pragma unroll
                for (int bj = 0; bj < 2; ++bj)
#pragma unroll
                    for (int n = 0; n < 2; ++n) { const f32x4 bs = *(const f32x4*)(base + off + bj * HALF + n * 16); acc[ai][bj][m][n] = bs + (acc[ai][bj][m][n] - sr.x) * sr.y; }
                asm volatile("" : "+v"(acc[ai][0][m][0]), "+v"(acc[ai][0][m][1]), "+v"(acc[ai][1][m][0]), "+v"(acc[ai][1][m][1]));
                if (m & 1) asm volatile("" ::: "memory"); }
        const bool bad1 = bad;
        bad = st2.run(acc, u, wr, wc, fr, fq, lds, wid, lane) || bad;
#pragma unroll
        for (int ai = 0; ai < 2; ++ai)
#pragma unroll
            for (int m = 0; m < 4; ++m) { const int r = ai * HALF + wr * 64 + m * 16 + fr; const f32x2v sr = S[r]; const size_t off = (size_t)(u.pm * BM + r) * ldc + col0;
#pragma unroll
                for (int bj = 0; bj < 2; ++bj)
#pragma unroll
                    for (int n = 0; n < 2; ++n) { const f32x4 x1 = acc[ai][bj][m][n]; *(f32x4*)(out + off + bj * HALF + n * 16) = bad1 ? (f32x4){qnan, qnan, qnan, qnan} : x1;
                        const f32x4 o = (x1 - sr.x) * sr.y; u32x2v w; w.x = cvt_pk_bf16(o[0], o[1]); w.y = cvt_pk_bf16(o[2], o[3]);
                        if (bad) { w.x = 0x7fc07fc0u; w.y = 0x7fc07fc0u; } *(u32x2v*)(xn + off + bj * HALF + n * 16) = w; }
                asm volatile("" ::: "memory"); }
    }
};

template <class E, class = void> struct aperm_of { static constexpr bool value = false; };
template <class E> struct aperm_of<E, decltype((void)E::APERM)> { static constexpr bool value = E::APERM; };
template <class Epi, class Sched, bool ALIGN_EPI = false, bool SP2 = false>
__device__ __forceinline__ void gemm_phase(PG8_LAS unsigned char* lds, const Gemm g, const Sched& S, const Epi& E) {
    int tid = threadIdx.x; asm volatile("" : "+v"(tid)); const int wid = __builtin_amdgcn_readfirstlane(tid >> 6), lane = tid & 63, wr = wid >> 2, wc = wid & 3, fr = lane & 15, fq = lane >> 4;
    const int K = g.K, nt = K / BK;
    unsigned voffA[2], voffB[2];
#pragma unroll
    for (int i = 0; i < 2; ++i) { int R, C; stage_rc(tid * 16 + i * 8192, R, C); const int Rb = Epi::PERM ? ((R & ~31) + perm32(R & 31)) : R;
        const int Ra = aperm_of<Epi>::value ? ((R & ~63) + 4 * (R & 15) + ((R >> 4) & 3)) : R;
        voffA[i] = (unsigned)(Ra * K + C) * 2u; voffB[i] = (unsigned)(Rb * K + C) * 2u; }
    const size_t kstep = (size_t)(BK * 2);
    const size_t hstep = (size_t)HALF * K * 2;
    const size_t tstep = 2 * hstep;
    const unsigned ldsw = (unsigned)wid * 1024u;
    const int aoff = lds_byte(wr * 64 + fr, fq * 8), boff = lds_byte(wc * 32 + fr, fq * 8);
#define PG8_SA(b, h) (((b) * 2 + (h)) * HTB)
#define PG8_SB(b, h) ((4 + (b) * 2 + (h)) * HTB)
#define PG8_STAGE(bufoff, gbase, voff) do { _Pragma("unroll") for (int _i = 0; _i < 2; ++_i) \
        __builtin_amdgcn_global_load_lds((const unsigned*)((const char*)(gbase) + (voff)[_i]), (PG8_LAS unsigned*)(lds + (bufoff) + ldsw + _i * 8192), 16, 0, 0); } while (0)
#define PG8_LDA(dst, b, h) do { _Pragma("unroll") for (int m = 0; m < 4; ++m) _Pragma("unroll") for (int k = 0; k < 2; ++k) dst[m][k] = *(const PG8_LAS bf16x8*)(lds + PG8_SA(b, h) + aoff + m * 2048 + k * 1024); } while (0)
#define PG8_LDB(dst, b, h) do { _Pragma("unroll") for (int n = 0; n < 2; ++n) _Pragma("unroll") for (int k = 0; k < 2; ++k) dst[n][k] = *(const PG8_LAS bf16x8*)(lds + PG8_SB(b, h) + boff + n * 2048 + k * 1024); } while (0)
#define PG8_MMA(ai, bj, At, Bt) do { __builtin_amdgcn_s_setprio(1); _Pragma("unroll") for (int m = 0; m < 4; ++m) _Pragma("unroll") for (int n = 0; n < 2; ++n) _Pragma("unroll") for (int k = 0; k < 2; ++k) \
        acc[ai][bj][m][n] = __builtin_amdgcn_mfma_f32_16x16x32_bf16(Bt[n][k], At[m][k], acc[ai][bj][m][n], 0, 0, 0); __builtin_amdgcn_s_setprio(0); } while (0)
#define PG8_WAIT_V(n) asm volatile("s_waitcnt vmcnt(" #n ")" ::: "memory")
#define PG8_WAIT_L(n) asm volatile("s_waitcnt lgkmcnt(" #n ")" ::: "memory")
#define PG8_BAR __builtin_amdgcn_s_barrier()
#define PG8_SCHED __builtin_amdgcn_sched_barrier(0)
    Unit cur, nxt; int ui = 0;
    if (!S.next(0, cur)) return;
    f32x4 acc[2][2][4][2];
#pragma unroll
    for (int a = 0; a < 2; ++a)
#pragma unroll
        for (int b = 0; b < 2; ++b)
#pragma unroll
            for (int m = 0; m < 4; ++m)
#pragma unroll
                for (int n = 0; n < 2; ++n) acc[a][b][m][n] = (f32x4){0.f, 0.f, 0.f, 0.f};
    bf16x8 At[4][2], B0[2][2], B1[2][2];
    const char* cA = (const char*)g.A + (size_t)cur.pm * tstep; const char* cB = (const char*)g.Bt + (size_t)cur.pn * tstep;
    S.a_ready(cur);
    if constexpr (SP2) {
        PG8_STAGE(PG8_SB(0, 0), cB, voffB); PG8_STAGE(PG8_SB(0, 1), cB + hstep, voffB); PG8_STAGE(PG8_SA(0, 0), cA, voffA); PG8_STAGE(PG8_SA(0, 1), cA + hstep, voffA);
        if (wr == 1) PG8_BAR;
        PG8_WAIT_V(2); PG8_BAR;
        PG8_STAGE(PG8_SB(1, 0), cB + kstep, voffB); PG8_STAGE(PG8_SA(1, 0), cA + kstep, voffA); PG8_STAGE(PG8_SB(1, 1), cB + hstep + kstep, voffB);
        PG8_WAIT_V(6); PG8_BAR;
    } else {
        PG8_STAGE(PG8_SB(0, 0), cB, voffB); PG8_STAGE(PG8_SA(0, 0), cA, voffA); PG8_STAGE(PG8_SB(0, 1), cB + hstep, voffB); PG8_STAGE(PG8_SA(0, 1), cA + hstep, voffA);
        if (wr == 1) PG8_BAR;
        PG8_WAIT_V(4); PG8_BAR;
        PG8_STAGE(PG8_SB(1, 0), cB + kstep, voffB); PG8_STAGE(PG8_SA(1, 0), cA + kstep, voffA); PG8_STAGE(PG8_SB(1, 1), cB + hstep + kstep, voffB);
        PG8_WAIT_V(6); PG8_BAR;
    }
    for (;;) {
        const bool has_next = S.next(ui + 1, nxt);
        const char* nA = has_next ? (const char*)g.A + (size_t)nxt.pm * tstep : cA; const char* nB = has_next ? (const char*)g.Bt + (size_t)nxt.pn * tstep : cB;
        for (int t = 0; t < nt; t += 2) {
            const bool last = (t == nt - 2);
            const char* a1 = cA + (size_t)(t + 1) * kstep;
            const char* a2 = last ? nA : cA + (size_t)(t + 2) * kstep; const char* b2 = last ? nB : cB + (size_t)(t + 2) * kstep;
            const char* a3 = a2 + kstep; const char* b3 = b2 + kstep;
            if (last && has_next) S.a_ready(nxt);
            if constexpr (SP2) {
            PG8_LDB(B0, 0, 0); PG8_LDB(B1, 0, 1); PG8_SCHED; PG8_LDA(At, 0, 0); PG8_STAGE(PG8_SA(1, 1), a1 + hstep, voffA);
            PG8_WAIT_V(8); PG8_WAIT_L(0); PG8_BAR; PG8_MMA(0, 0, At, B0); PG8_MMA(0, 1, At, B1); PG8_BAR; PG8_SCHED;
            PG8_LDA(At, 0, 1); PG8_STAGE(PG8_SB(0, 0), b2, voffB); PG8_STAGE(PG8_SB(0, 1), b2 + hstep, voffB); PG8_STAGE(PG8_SA(0, 0), a2, voffA);
            PG8_WAIT_V(8); PG8_WAIT_L(0); PG8_BAR; PG8_MMA(1, 0, At, B0); PG8_MMA(1, 1, At, B1); PG8_BAR; PG8_SCHED;
            PG8_LDB(B0, 1, 0); PG8_LDB(B1, 1, 1); PG8_SCHED; PG8_LDA(At, 1, 0); PG8_STAGE(PG8_SA(0, 1), a2 + hstep, voffA);
            PG8_WAIT_V(8); PG8_WAIT_L(0); PG8_BAR; PG8_MMA(0, 0, At, B0); PG8_MMA(0, 1, At, B1); PG8_BAR; PG8_SCHED;
            PG8_LDA(At, 1, 1); PG8_STAGE(PG8_SB(1, 0), b3, voffB); PG8_STAGE(PG8_SB(1, 1), b3 + hstep, voffB); PG8_STAGE(PG8_SA(1, 0), a3, voffA);
            PG8_WAIT_V(8); PG8_WAIT_L(0); PG8_BAR; PG8_MMA(1, 0, At, B0); PG8_MMA(1, 1, At, B1); PG8_BAR; PG8_SCHED;
            } else {
            PG8_LDB(B0, 0, 0); PG8_SCHED; PG8_LDA(At, 0, 0); PG8_STAGE(PG8_SA(1, 1), a1 + hstep, voffA);
            PG8_WAIT_L(8); PG8_BAR; PG8_WAIT_L(0); PG8_MMA(0, 0, At, B0); PG8_BAR; PG8_SCHED;
            PG8_LDB(B1, 0, 1); PG8_STAGE(PG8_SB(0, 0), b2, voffB);
            PG8_BAR; PG8_WAIT_L(0); PG8_MMA(0, 1, At, B1); PG8_BAR;
            PG8_LDA(At, 0, 1); PG8_STAGE(PG8_SA(0, 0), a2, voffA);
            PG8_BAR; PG8_WAIT_L(0); PG8_MMA(1, 0, At, B0); PG8_BAR; PG8_SCHED;
            PG8_STAGE(PG8_SB(0, 1), b2 + hstep, voffB);
            PG8_WAIT_V(6); PG8_BAR; PG8_MMA(1, 1, At, B1); PG8_BAR;
            PG8_LDB(B0, 1, 0); PG8_SCHED; PG8_LDA(At, 1, 0); PG8_STAGE(PG8_SA(0, 1), a2 + hstep, voffA);
            PG8_WAIT_L(8); PG8_BAR; PG8_WAIT_L(0); PG8_MMA(0, 0, At, B0); PG8_BAR; PG8_SCHED;
            PG8_LDB(B1, 1, 1); PG8_STAGE(PG8_SB(1, 0), b3, voffB);
            PG8_BAR; PG8_WAIT_L(0); PG8_MMA(0, 1, At, B1); PG8_BAR;
            PG8_LDA(At, 1, 1); PG8_STAGE(PG8_SA(1, 0), a3, voffA);
            PG8_BAR; PG8_WAIT_L(0); PG8_MMA(1, 0, At, B0); PG8_BAR; PG8_SCHED;
            PG8_STAGE(PG8_SB(1, 1), b3 + hstep, voffB);
            PG8_WAIT_V(6); PG8_BAR; PG8_MMA(1, 1, At, B1); PG8_BAR;
            }
        }
        if constexpr (ALIGN_EPI) { if (wr == 0) PG8_BAR; }
        if constexpr (!Epi::AFTER_DRAIN) { E(acc, cur, wr, wc, fr, fq); S.done(cur); }
        if (!has_next) break;
#pragma unroll
        for (int a = 0; a < 2; ++a)
#pragma unroll
            for (int b = 0; b < 2; ++b)
#pragma unroll
                for (int m = 0; m < 4; ++m)
#pragma unroll
                    for (int n = 0; n < 2; ++n) acc[a][b][m][n] = (f32x4){0.f, 0.f, 0.f, 0.f};
        cur = nxt; cA = nA; cB = nB; ++ui;
        if constexpr (ALIGN_EPI) { if (wr == 1) PG8_BAR; }
    }
    PG8_WAIT_V(0);
    if constexpr (!ALIGN_EPI) { if (wr == 0) PG8_BAR; }
    PG8_BAR;
    if constexpr (Epi::AFTER_DRAIN) { E.fused(acc, cur, wr, wc, fr, fq, lds, wid, lane); S.done(cur); }
#undef PG8_SA
#undef PG8_SB
#undef PG8_STAGE
#undef PG8_LDA
#undef PG8_LDB
#undef PG8_MMA
#undef PG8_WAIT_V
#undef PG8_WAIT_L
#undef PG8_BAR
#undef PG8_SCHED
}
}

#ifndef PG8_SP2
#define PG8_SP2 true
#endif
#ifndef PG8_ALIGN
#define PG8_ALIGN true
#endif
#include <hip/hip_bf16.h>
#include <cmath>
namespace attn_body {
using bf16=__hip_bfloat16;
using bf16x8=__attribute__((ext_vector_type(8)))short;
using s16x4=__attribute__((ext_vector_type(4)))short;
using f32x16=__attribute__((ext_vector_type(16)))float;
using u32x4=__attribute__((ext_vector_type(4)))unsigned;
constexpr int BATCH=16,NHEAD=16,SEQ=4096,D=64,DM=NHEAD*D;
constexpr int NW=8,QBLK=32,QB=QBLK*NW,KVBLK=64,NQB=SEQ/QB;
constexpr int ATTN_PITCH=DM, ATTN_UNIT_ROWS=QB;
__device__ __forceinline__ int crow(int r,int hi){return (r&3)+8*(r>>2)+4*hi;}
#define SBAR() __builtin_amdgcn_sched_barrier(0)
__device__ __forceinline__ void cmask(f32x16&p0,f32x16&p1,int jb,int qrel,int hi){
  const float NEG=-INFINITY; int kb=64*jb+4*hi;
  #pragma unroll
  for(int r=0;r<16;++r){int kv=kb+(r&3)+8*(r>>2); if(kv>qrel)p0[r]=NEG; if(kv+32>qrel)p1[r]=NEG;}
}

constexpr int NSLOT=3, SLOTB=8192;
constexpr int LDS_K=0, LDS_V=NSLOT*SLOTB, LDS_WS=2*NSLOT*SLOTB, LDS_OST=LDS_WS+NW*64*4, LDS_BYTES=LDS_OST+NW*4096;
constexpr float C2=0.125f*1.4426950408889634f;
__device__ __forceinline__ void glds16(const void*gsrc,unsigned lds_dst){unsigned keep;
  asm volatile("s_mov_b32 %0, m0\n\ts_mov_b32 m0, %2\n\ts_nop 0\n\tglobal_load_lds_dwordx4 %1, off\n\ts_mov_b32 m0, %0":"=&s"(keep):"v"(gsrc),"s"(lds_dst):"memory");}
__device__ __forceinline__ void glds16s(const void*sbase,unsigned voff,unsigned lds_dst){unsigned keep;
  asm volatile("s_mov_b32 %0, m0\n\ts_mov_b32 m0, %3\n\ts_nop 0\n\tglobal_load_lds_dwordx4 %1, %2\n\ts_mov_b32 m0, %0":"=&s"(keep):"v"(voff),"s"(sbase),"s"(lds_dst):"memory");}
__device__ __forceinline__ float max3f(float a,float b,float c){float r;asm("v_max3_f32 %0, %1, %2, %3":"=v"(r):"v"(a),"v"(b),"v"(c));return r;}
__device__ __forceinline__ float max2f(float a,float b){float r;asm("v_max_f32_e32 %0, %1, %2":"=v"(r):"v"(a),"v"(b));return r;}
__device__ __forceinline__ float fadd_s(float a,float b){float r;asm("v_add_f32_e32 %0, %1, %2":"=v"(r):"v"(a),"v"(b));return r;}
__device__ __forceinline__ float fmul_s(float a,float b){float r;asm("v_mul_f32_e32 %0, %1, %2":"=v"(r):"v"(a),"v"(b));return r;}
__device__ __forceinline__ float fsub_s(float a,float b){float r;asm("v_sub_f32_e32 %0, %1, %2":"=v"(r):"v"(a),"v"(b));return r;}
typedef float f32x2_t __attribute__((ext_vector_type(2))); typedef __bf16 bf16x2_t __attribute__((ext_vector_type(2)));
__device__ __forceinline__ unsigned cvtpk_s(float lo,float hi){f32x2_t v={lo,hi};bf16x2_t b=__builtin_convertvector(v,bf16x2_t);return __builtin_bit_cast(unsigned,b);}
#define WAIT_BAR(N) asm volatile("s_waitcnt vmcnt(" #N ") lgkmcnt(0)\n\ts_barrier":::"memory")

__device__ __forceinline__ void qkt(f32x16&p0,f32x16&p1,const char*Kslot,const bf16x8*qr,const f32x16&negm,int r32,int hi){
  const char*kb=Kslot+hi*1024+r32*16;
  #pragma unroll
  for(int d0=0;d0<4;++d0){
    const bf16x8 b0=*reinterpret_cast<const bf16x8*>(kb+d0*2048);
    const bf16x8 b1=*reinterpret_cast<const bf16x8*>(kb+d0*2048+512);
    if(d0==0){p0=__builtin_amdgcn_mfma_f32_32x32x16_bf16(b0,qr[0],negm,0,0,0);p1=__builtin_amdgcn_mfma_f32_32x32x16_bf16(b1,qr[0],negm,0,0,0);}
    else{p0=__builtin_amdgcn_mfma_f32_32x32x16_bf16(b0,qr[d0],p0,0,0,0);p1=__builtin_amdgcn_mfma_f32_32x32x16_bf16(b1,qr[d0],p1,0,0,0);}}
}
typedef __attribute__((address_space(3))) const char* lds_cptr;
typedef short v4i16_t __attribute__((ext_vector_type(4)));
__device__ __forceinline__ void kload8(bf16x8*kf,lds_cptr kp){
  kf[0]=*(const __attribute__((address_space(3))) bf16x8*)(kp);      kf[1]=*(const __attribute__((address_space(3))) bf16x8*)(kp+512);
  kf[2]=*(const __attribute__((address_space(3))) bf16x8*)(kp+2048); kf[3]=*(const __attribute__((address_space(3))) bf16x8*)(kp+2560);
  kf[4]=*(const __attribute__((address_space(3))) bf16x8*)(kp+4096); kf[5]=*(const __attribute__((address_space(3))) bf16x8*)(kp+4608);
  kf[6]=*(const __attribute__((address_space(3))) bf16x8*)(kp+6144); kf[7]=*(const __attribute__((address_space(3))) bf16x8*)(kp+6656);
}
__device__ __forceinline__ void kload2(bf16x8*kf,lds_cptr kp,int j){ kf[2*j]=*(const __attribute__((address_space(3))) bf16x8*)(kp+j*2048); kf[2*j+1]=*(const __attribute__((address_space(3))) bf16x8*)(kp+j*2048+512); }
__device__ __forceinline__ s16x4 vtr(lds_cptr p){ return __builtin_bit_cast(s16x4,__builtin_amdgcn_ds_read_tr16_b64_v4i16((__attribute__((address_space(3))) v4i16_t*)p)); }
__device__ __forceinline__ float rowmax(const f32x16&p0,const f32x16&p1){
  float a=max3f(p0[0],p0[1],p1[0]),b=max3f(p0[2],p0[3],p1[1]);a=max3f(a,p1[2],p1[3]);
  #pragma unroll
  for(int r=4;r<16;r+=4){a=max3f(a,p0[r],p0[r+1]);b=max3f(b,p0[r+2],p0[r+3]);a=max3f(a,p1[r],p1[r+1]);b=max3f(b,p1[r+2],p1[r+3]);}
  const float m=max2f(a,b);
  auto rr=__builtin_amdgcn_permlane32_swap(__float_as_uint(m),__float_as_uint(m),false,false);
  return max2f(__uint_as_float(rr[0]),__uint_as_float(rr[1]));
}
__device__ __forceinline__ void pv(f32x16*o,int vb,bf16x8 pa0,bf16x8 pa1,bf16x8 pa2,bf16x8 pa3){
  #pragma unroll
  for(int d0=0;d0<2;++d0){s16x4 lo[4],hi[4];
    #pragma unroll
    for(int ks=0;ks<4;++ks){
      asm volatile("ds_read_b64_tr_b16 %0,%1 offset:%c2":"=&v"(lo[ks]):"v"(vb),"i"(d0*4096+ks*1024):"memory");
      asm volatile("ds_read_b64_tr_b16 %0,%1 offset:%c2":"=&v"(hi[ks]):"v"(vb),"i"(d0*4096+ks*1024+512):"memory");}
    asm volatile("s_waitcnt lgkmcnt(0)":::"memory");SBAR();
    #define PK(k) (bf16x8){lo[k][0],lo[k][1],lo[k][2],lo[k][3],hi[k][0],hi[k][1],hi[k][2],hi[k][3]}
    o[d0]=__builtin_amdgcn_mfma_f32_32x32x16_bf16(pa0,PK(0),o[d0],0,0,0);
    o[d0]=__builtin_amdgcn_mfma_f32_32x32x16_bf16(pa1,PK(1),o[d0],0,0,0);
    o[d0]=__builtin_amdgcn_mfma_f32_32x32x16_bf16(pa2,PK(2),o[d0],0,0,0);
    o[d0]=__builtin_amdgcn_mfma_f32_32x32x16_bf16(pa3,PK(3),o[d0],0,0,0);
    #undef PK
  }
}

#ifndef ATTN_STORE16
#define ATTN_STORE16(p,v) (*(u32x4*)(p)=(v))
#endif
typedef const __attribute__((address_space(3))) float* lds_cf32;
typedef float f32x4_t __attribute__((ext_vector_type(4)));
template<int THRL> __device__ __forceinline__ void attn_unit(int b,int h,int qb,const bf16*Q,const bf16*__restrict__ K,const bf16*__restrict__ V,bf16*O,const bf16*__restrict__ G,lds_cf32 cs_abs,int t0,unsigned*qhead,__attribute__((address_space(3))) unsigned*wq,const int*T0tab,const float*C2tab,unsigned csn_off,char*shm){
  const lds_cf32 cs=cs_abs+64*t0;
  int tid=threadIdx.x; asm volatile("":"+v"(tid));   const int lane=tid&63,r32=lane&31,hi=lane>>5; const int wid=__builtin_amdgcn_readfirstlane(tid>>6);
  const long rowbase=(long)b*SEQ; const int q0=qb*QB;
  const bf16*Qw=Q+(rowbase+q0+wid*QBLK)*DM+h*D;
  const bf16*Kh=K+(rowbase+(long)t0*KVBLK)*DM+h*D,*Vh=V+(rowbase+(long)t0*KVBLK)*DM+h*D;
  const unsigned lds0=(unsigned)(uintptr_t)shm;
  float*wsf=(float*)(shm+LDS_WS)+wid*64;
  const unsigned kvoff=(unsigned)((lane*DM+wid*8)*2);
  const unsigned vvoff=(unsigned)(((16*(wid&3)+(lane>>2))*DM+(wid>>2)*32+(lane&3)*8)*2);
  const unsigned kdst=lds0+LDS_K+wid*1024, vdst=lds0+LDS_V+wid*1024;
  #define DMA_K(t,slot) glds16s(Kh+(long)(t)*KVBLK*DM,kvoff,(unsigned)__builtin_amdgcn_readfirstlane(kdst+(slot)))
  #define DMA_V(t,slot) glds16s(Vh+(long)(t)*KVBLK*DM,vvoff,(unsigned)__builtin_amdgcn_readfirstlane(vdst+(slot)))
  const int vb0=(int)(lds0+LDS_V)+((lane>>4)&1)*32+(lane&3)*8+(4*hi+((lane&15)>>2))*64;
  const char*Kbase=shm+LDS_K; bf16x8 kf[8];
  const lds_cptr shm3=(lds_cptr)shm; const lds_cptr kp0=shm3+LDS_K+hi*1024+r32*16; const lds_cptr vp0=shm3+LDS_V+((lane>>4)&1)*32+(lane&3)*8+(4*hi+((lane&15)>>2))*64;
  const int NT=(q0+QB)/KVBLK-t0;
  DMA_K(0,0);DMA_V(0,0);DMA_K(1,SLOTB);
  bf16x8 qr[4];
  #pragma unroll
  for(int d0=0;d0<4;++d0)qr[d0]=*reinterpret_cast<const bf16x8*>(&Qw[(long)r32*DM+d0*16+hi*8]);
  const int qrel=wid*QBLK+r32;
  #define ct2 (cs_abs[q0+qrel])
  float mhat=0.f,l_reg=0.f;f32x16 o[2];o[0]=f32x16{};o[1]=f32x16{};f32x16 negm;
  #define KBIAS(P0,P1,t) do{ const __attribute__((address_space(3))) f32x4_t* cb_=(const __attribute__((address_space(3))) f32x4_t*)(cs+64*(t)); \
    _Pragma("unroll") for(int g_=0;g_<4;++g_){ const f32x4_t a_=cb_[2*g_+hi], b_=cb_[8+2*g_+hi]; \
      P0[4*g_+0]-=a_[0];P0[4*g_+1]-=a_[1];P0[4*g_+2]-=a_[2];P0[4*g_+3]-=a_[3]; P1[4*g_+0]-=b_[0];P1[4*g_+1]-=b_[1];P1[4*g_+2]-=b_[2];P1[4*g_+3]-=b_[3]; } }while(0)
  #define CMASK(P0,P1,t) do{int jb_=(t)-(NT-4); if(jb_>=0)cmask(P0,P1,jb_,qrel,hi);}while(0)
  bool resc=false;
  #define START(P0,P1) do{ const float rm=rowmax(P0,P1); resc=false; \
    { const float dl=rm; mhat=fadd_s(mhat,dl); \
      _Pragma("unroll") for(int r=0;r<16;++r){P0[r]=fsub_s(P0[r],dl);P1[r]=fsub_s(P1[r],dl);} \
      _Pragma("unroll") for(int r=0;r<16;++r)negm[r]=ct2-mhat; asm volatile("":"+v"(negm)); } \
    _Pragma("unroll") for(int r=0;r<16;++r)P0[r]=__builtin_amdgcn_exp2f(P0[r]); }while(0)
  #define RESC() do{ if(resc){ asm volatile("s_waitcnt lgkmcnt(0)":::"memory"); \
      asm volatile("s_nop 15\n\ts_nop 7":"+v"(o[0]),"+v"(o[1])); \
      _Pragma("unroll") for(int d_=0;d_<2;++d_) _Pragma("unroll") for(int r=0;r<16;++r)o[d_][r]=fmul_s(o[d_][r],wsf[crow(r,hi)]); } }while(0)
  f32x16 pA0,pA1,pB0,pB1;
  int sl_prev=0,sl_cur=0,sl_next=SLOTB;
  #define ROT() do{sl_prev=sl_cur;sl_cur=sl_next;sl_next=(sl_next==(NSLOT-1)*SLOTB)?0:sl_next+SLOTB;}while(0)
  DMA_K(2,2*SLOTB);
  unsigned nres_=0u; if(tid==0)nres_=__hip_atomic_fetch_add(qhead,1u,__ATOMIC_RELAXED,__HIP_MEMORY_SCOPE_AGENT);
  WAIT_BAR(3);
  _Pragma("unroll") for(int r=0;r<16;++r)negm[r]=ct2; asm volatile("":"+v"(negm));
  qkt(pA0,pA1,Kbase,qr,negm,r32,hi);asm volatile("s_nop 15\n\ts_nop 7":"+v"(pA0),"+v"(pA1));KBIAS(pA0,pA1,0);CMASK(pA0,pA1,0);
  START(pA0,pA1);
  _Pragma("unroll") for(int r=0;r<16;++r)pA1[r]=__builtin_amdgcn_exp2f(pA1[r]);
  if(tid==0)wq[2]=nres_;
  WAIT_BAR(0);
  DMA_K(3,0);DMA_V(1,SLOTB);
  ROT();
  kload8(kf,kp0+sl_cur);
  WAIT_BAR(2);
  s16x4 vlo[8],vhi[8]; u32x4 pw0,pw1,pw2,pw3;
  f32x4_t kbA0,kbA1,kbA2,kbA3,kbB0,kbB1,kbB2,kbB3;
  #define KBPTR(t) ((const __attribute__((address_space(3))) f32x4_t*)(cs+64*(t))+hi)
  #define KBLD_A(t) do{ kbA0=KBPTR(t)[0]; kbA1=KBPTR(t)[2]; kbA2=KBPTR(t)[4]; kbA3=KBPTR(t)[6]; SBAR(); }while(0)
  #define KBLD_B(t) do{ kbB0=KBPTR(t)[8]; kbB1=KBPTR(t)[10]; kbB2=KBPTR(t)[12]; kbB3=KBPTR(t)[14]; SBAR(); }while(0)
  #define KBS4(P,B,K) P[B]=fsub_s(P[B],K[0]);P[B+1]=fsub_s(P[B+1],K[1]);P[B+2]=fsub_s(P[B+2],K[2]);P[B+3]=fsub_s(P[B+3],K[3])
  #define KBSUB(C0,C1) do{ asm volatile("s_nop 15\n\ts_nop 7":"+v"(C0),"+v"(C1));   KBS4(C0,0,kbA0);KBS4(C0,4,kbA1);KBS4(C0,8,kbA2);KBS4(C0,12,kbA3);KBS4(C1,0,kbB0);KBS4(C1,4,kbB1);KBS4(C1,8,kbB2);KBS4(C1,12,kbB3); }while(0)
  #define PKW(P,B) cvtpk_s(P[B],P[B+1])
  #define PAF(k) __builtin_bit_cast(bf16x8,pw##k)
  #define VFR(i) (bf16x8){vlo[i][0],vlo[i][1],vlo[i][2],vlo[i][3],vhi[i][0],vhi[i][1],vhi[i][2],vhi[i][3]}
  #define PIN(x) asm volatile("":"+v"(x))
  #define MX3(a,b,c) __builtin_fmaxf(__builtin_fmaxf((a),(b)),(c))
  #define GAPA(MF,A0,A1,A2,A3,W0,W1,PW) do{ MF; sacc+=A0; sacc+=A1; sacc+=A2; sacc+=A3; PIN(sacc); W0; W1; PIN(PW); SBAR(); }while(0)
  #define EX(v) __builtin_amdgcn_exp2f(v)
  #define GAPB(MF,X,B) do{ MF; X[B]=EX(X[B]); X[B+1]=EX(X[B+1]); X[B+2]=EX(X[B+2]); X[B+3]=EX(X[B+3]); PIN(X); SBAR(); }while(0)
  #define VRD(i) do{ vlo[i]=vtr(vp_+(((i)>>2)*4096+((i)&3)*1024)); vhi[i]=vtr(vp_+(((i)>>2)*4096+((i)&3)*1024+512)); }while(0)
  #define KRD(G,j) do{ if(G){ kload2(kf,kp0+sl_next,j); SBAR(); } }while(0)
  #define STEP(C0,C1,P0,P1,t,GK,GV,GL) do{ SBAR(); \
    const lds_cptr vp_=vp0+sl_prev; \
    VRD(0); SBAR(); float sacc=(P0[0]+P0[1]); \
    GAPA(C0=__builtin_amdgcn_mfma_f32_32x32x16_bf16(kf[0],qr[0],negm,0,0,0), P0[2],P0[3],P0[4],P0[5],     pw0[0]=PKW(P0,0), pw0[1]=PKW(P0,2), pw0); \
    VRD(4); SBAR(); GAPA(C1=__builtin_amdgcn_mfma_f32_32x32x16_bf16(kf[1],qr[0],negm,0,0,0), P0[6],P0[7],P0[8],P0[9],     pw0[2]=PKW(P0,4), pw0[3]=PKW(P0,6), pw0); \
    VRD(1); SBAR(); GAPA(C0=__builtin_amdgcn_mfma_f32_32x32x16_bf16(kf[2],qr[1],C0,0,0,0),   P0[10],P0[11],P0[12],P0[13], pw1[0]=PKW(P0,8), pw1[1]=PKW(P0,10), pw1); \
    VRD(5); SBAR(); GAPA(C1=__builtin_amdgcn_mfma_f32_32x32x16_bf16(kf[3],qr[1],C1,0,0,0),   P0[14],P0[15],P1[0],P1[1],   pw1[2]=PKW(P0,12),pw1[3]=PKW(P0,14), pw1); \
    KBLD_A(t); \
    VRD(2); SBAR(); GAPA(C0=__builtin_amdgcn_mfma_f32_32x32x16_bf16(kf[4],qr[2],C0,0,0,0),   P1[2],P1[3],P1[4],P1[5],     pw2[0]=PKW(P1,0), pw2[1]=PKW(P1,2), pw2); \
    VRD(6); SBAR(); GAPA(C1=__builtin_amdgcn_mfma_f32_32x32x16_bf16(kf[5],qr[2],C1,0,0,0),   P1[6],P1[7],P1[8],P1[9],     pw2[2]=PKW(P1,4), pw2[3]=PKW(P1,6), pw2); \
    VRD(3); SBAR(); GAPA(C0=__builtin_amdgcn_mfma_f32_32x32x16_bf16(kf[6],qr[3],C0,0,0,0),   P1[10],P1[11],P1[12],P1[13], pw3[0]=PKW(P1,8), pw3[1]=PKW(P1,10), pw3); \
    VRD(7); SBAR(); GAPA(C1=__builtin_amdgcn_mfma_f32_32x32x16_bf16(kf[7],qr[3],C1,0,0,0),   P1[14],P1[15],0.f,0.f,       pw3[2]=PKW(P1,12),pw3[3]=PKW(P1,14), pw3); \
    KBLD_B(t); \
    l_reg+=sacc; \
    if(GK){DMA_K((t)+3,sl_cur);} if(GV){DMA_V((t)+1,sl_next);} \
    KBSUB(C0,C1); CMASK(C0,C1,t); \
    { float a=MX3(C0[0],C0[1],C1[0]),b=MX3(C0[2],C0[3],C1[1]); a=MX3(a,C1[2],C1[3]); \
      _Pragma("unroll") for(int r=4;r<16;r+=4){a=MX3(a,C0[r],C0[r+1]);b=MX3(b,C0[r+2],C0[r+3]);a=MX3(a,C1[r],C1[r+1]);b=MX3(b,C1[r+2],C1[r+3]);} \
      float rm=__builtin_fmaxf(a,b); { auto rr=__builtin_amdgcn_permlane32_swap(__float_as_uint(rm),__float_as_uint(rm),false,false); rm=__builtin_fmaxf(__uint_as_float(rr[0]),__uint_as_float(rr[1])); } \
      resc=false; \
      if(__builtin_expect(__any(rm>(float)THRL),0)){ const float dl=__builtin_fmaxf(rm,0.f); mhat+=dl; \
        _Pragma("unroll") for(int r=0;r<16;++r){C0[r]-=dl;C1[r]-=dl;} \
        _Pragma("unroll") for(int r=0;r<16;++r)negm[r]=ct2-mhat; asm volatile("":"+v"(negm)); \
        const float f=__builtin_amdgcn_exp2f(-dl); l_reg*=f; if(hi==0)wsf[r32]=f; resc=true; } } \
    SBAR(); \
    GAPB(o[0]=__builtin_amdgcn_mfma_f32_32x32x16_bf16(PAF(0),VFR(0),o[0],0,0,0), C0,0); \
    GAPB(o[1]=__builtin_amdgcn_mfma_f32_32x32x16_bf16(PAF(0),VFR(4),o[1],0,0,0), C0,4); \
    KRD(GL,0); GAPB(o[0]=__builtin_amdgcn_mfma_f32_32x32x16_bf16(PAF(1),VFR(1),o[0],0,0,0), C0,8); \
    KRD(GL,1); GAPB(o[1]=__builtin_amdgcn_mfma_f32_32x32x16_bf16(PAF(1),VFR(5),o[1],0,0,0), C0,12); \
    KRD(GL,2); GAPB(o[0]=__builtin_amdgcn_mfma_f32_32x32x16_bf16(PAF(2),VFR(2),o[0],0,0,0), C1,0); \
    KRD(GL,3); GAPB(o[1]=__builtin_amdgcn_mfma_f32_32x32x16_bf16(PAF(2),VFR(6),o[1],0,0,0), C1,4); \
    GAPB(o[0]=__builtin_amdgcn_mfma_f32_32x32x16_bf16(PAF(3),VFR(3),o[0],0,0,0), C1,8); \
    GAPB(o[1]=__builtin_amdgcn_mfma_f32_32x32x16_bf16(PAF(3),VFR(7),o[1],0,0,0), C1,12); \
    }while(0)
  int t=1;
  #undef CMASK
  #define CMASK(P0,P1,t) do{}while(0)
  for(;t+5<NT;t+=2){
    STEP(pB0,pB1,pA0,pA1,t,true,true,true);     WAIT_BAR(2); RESC(); ROT();
    STEP(pA0,pA1,pB0,pB1,t+1,true,true,true);   WAIT_BAR(2); RESC(); ROT();
  }
  #undef CMASK
  #define CMASK(P0,P1,t) do{int jb_=(t)-(NT-4); if(jb_>=0)cmask(P0,P1,jb_,qrel,hi);}while(0)
  #define ENDW(tt) do{ if((tt)+3<NT){WAIT_BAR(2);} else if((tt)+2<NT){WAIT_BAR(1);} else {WAIT_BAR(0);} }while(0)
  for(;t+1<NT;t+=2){
    STEP(pB0,pB1,pA0,pA1,t,(t+3<NT),(t+1<NT),(t+1<NT));       ENDW(t);   RESC(); ROT();
    STEP(pA0,pA1,pB0,pB1,t+1,(t+4<NT),(t+2<NT),(t+2<NT));     ENDW(t+1); RESC(); ROT();
  }
  STEP(pB0,pB1,pA0,pA1,NT-1,false,false,false); RESC();
  { float sacc=pB0[0]+pB0[1]; _Pragma("unroll") for(int r=2;r<16;++r)sacc+=pB0[r]; _Pragma("unroll") for(int r=0;r<16;++r)sacc+=pB1[r]; l_reg+=sacc;
    pw0=(u32x4){PKW(pB0,0),PKW(pB0,2),PKW(pB0,4),PKW(pB0,6)};pw1=(u32x4){PKW(pB0,8),PKW(pB0,10),PKW(pB0,12),PKW(pB0,14)};pw2=(u32x4){PKW(pB1,0),PKW(pB1,2),PKW(pB1,4),PKW(pB1,6)};pw3=(u32x4){PKW(pB1,8),PKW(pB1,10),PKW(pB1,12),PKW(pB1,14)};
    SBAR(); pv(o,vb0+sl_cur,PAF(0),PAF(1),PAF(2),PAF(3)); }
  #undef KBPTR
  #undef KBLD_A
  #undef KBLD_B
  #undef KBS4
  #undef KBSUB
  #undef PKW
  #undef PAF
  #undef VFR
  #undef PIN
  #undef MX3
  #undef GAPA
  #undef GAPB
  #undef EX
  #undef VRD
  #undef KRD
  #undef STEP
  #undef ENDW
  {auto rr=__builtin_amdgcn_permlane32_swap(__float_as_uint(l_reg),__float_as_uint(l_reg),false,false);l_reg=__uint_as_float(rr[0])+__uint_as_float(rr[1]);}
  int lane_e=lane; asm volatile("":"+v"(lane_e)); const int r32e=lane_e&31,hie=lane_e>>5;
  const unsigned nxt_=(unsigned)__builtin_amdgcn_readfirstlane((int)wq[2]); int t0n_=0; if(tid==0){ if(nxt_<4096u)t0n_=((const __attribute__((address_space(1))) int*)T0tab)[(nxt_&255u)*16u+15u-(nxt_>>8)];}
  u32x4 gpre[4]; { const bf16*Gp=G+(rowbase+q0+wid*QBLK)*DM+h*D;
    #pragma unroll
    for(int i=0;i<4;++i)gpre[i]=*(const u32x4*)(Gp+(long)(i*8+(lane_e>>3))*DM+(lane_e&7)*8); }
  if(hie==0)wsf[32+r32e]=l_reg;asm volatile("s_waitcnt lgkmcnt(0)":::"memory");
  float rli[16];
  #pragma unroll
  for(int r=0;r<16;++r)rli[r]=__builtin_amdgcn_rcpf(wsf[32+crow(r,hie)]);
  bf16*Ow=O+(rowbase+q0+wid*QBLK)*DM+h*D;
  { bf16*stg=(bf16*)(shm+LDS_OST)+wid*2048;
    #pragma unroll
    for(int r=0;r<16;++r){const int orow=crow(r,hie);
      #pragma unroll
      for(int d0=0;d0<2;++d0)stg[orow*64+d0*32+r32e]=__float2bfloat16(o[d0][r]*rli[r]);}
    asm volatile("s_waitcnt lgkmcnt(0)":::"memory");
    const bf16*Gw=G+(rowbase+q0+wid*QBLK)*DM+h*D;
    #pragma unroll
    for(int i=0;i<4;++i){const int row=i*8+(lane_e>>3),ch=lane_e&7; const u32x4 v=*(const u32x4*)(stg+row*64+ch*8); const u32x4 gv=gpre[i]; u32x4 w;
      #pragma unroll
      for(int e=0;e<4;++e){ const float o0=__uint_as_float(v[e]<<16),o1=__uint_as_float(v[e]&0xffff0000u),g0=__uint_as_float(gv[e]<<16),g1=__uint_as_float(gv[e]&0xffff0000u);
        const float s0=__builtin_amdgcn_rcpf(1.f+__builtin_amdgcn_exp2f(-1.4426950408889634f*g0)),s1=__builtin_amdgcn_rcpf(1.f+__builtin_amdgcn_exp2f(-1.4426950408889634f*g1)); w[e]=cvtpk_s(o0*s0,o1*s1); }
      ATTN_STORE16(Ow+(long)row*DM+ch*8,w);} }
  if(nxt_<4096u){ const char*c2n_=(const char*)(C2tab+(size_t)(nxt_&255u)*4096u); const unsigned cd_=(unsigned)__builtin_amdgcn_readfirstlane((int)(lds0+csn_off+(unsigned)wid*2048u));
    glds16s(c2n_,(unsigned)(wid*2048+lane_e*16),cd_); glds16s(c2n_,(unsigned)(wid*2048+1024+lane_e*16),cd_+1024u); }
  if(tid==0){wq[0]=nxt_;wq[1]=(unsigned)t0n_;}
  asm volatile("s_waitcnt lgkmcnt(0)\n\ts_barrier":::"memory");
  #undef KBIAS
  #undef ct2
  #undef DMA_K
  #undef DMA_V
  #undef CMASK
  #undef START
  #undef RESC
  #undef ROT
}
constexpr int ATTN_LDS_BYTES=LDS_BYTES;
struct AttnTensors { const bf16* Q; const bf16* K; const bf16* V; bf16* O; const bf16* G; };
struct AttnUnit { int bh; int qb; };
#undef SBAR
#undef WAIT_BAR
}
#define GAS __attribute__((address_space(1)))
#define LAS __attribute__((address_space(3)))
typedef unsigned short bf16;
typedef unsigned v4u __attribute__((ext_vector_type(4)));
typedef float f32x4 __attribute__((ext_vector_type(4)));
typedef short bf16x8 __attribute__((ext_vector_type(8)));
typedef GAS unsigned gu32;
typedef GAS unsigned long long gu64;
#define RLX_AGENT __ATOMIC_RELAXED, __HIP_MEMORY_SCOPE_AGENT
#define LDS_WAIT() asm volatile("s_waitcnt lgkmcnt(0)" ::: "memory")
#define VM_WAIT() asm volatile("s_waitcnt vmcnt(0)" ::: "memory")
__device__ __forceinline__ unsigned long long rt() { return __builtin_amdgcn_s_memrealtime(); }
__device__ __forceinline__ unsigned f2bf(float f) { unsigned u = __builtin_bit_cast(unsigned, f); return (u + 0x7fffu + ((u >> 16) & 1u)) >> 16; }
__device__ __forceinline__ unsigned pk2(float lo, float hi) { return f2bf(lo) | (f2bf(hi) << 16); }

#define XB_TMO      128
#define XB_XCNT(j)  (256  + 64 * (j))
#define XB_XSUB(j)  (1280 + 64 * (j))
#define XB_XGEN(j)  (2304 + 64 * (j))
#define XB_TOP      3328
#define XB_TOPGEN   3392
#define XCD_BAR_WORDS 3456
#define XB_SPIN_CAP (1u << 18)

__device__ __forceinline__ unsigned xb_ld(unsigned* p)              { return __hip_atomic_load(p, __ATOMIC_RELAXED, __HIP_MEMORY_SCOPE_AGENT); }
__device__ __forceinline__ unsigned xb_add(unsigned* p, unsigned v) { return __hip_atomic_fetch_add(p, v, __ATOMIC_RELAXED, __HIP_MEMORY_SCOPE_AGENT); }
__device__ __forceinline__ unsigned xb_xcc_id() { return (unsigned)__builtin_amdgcn_s_getreg((3 << 11) | 20) & 0xFu; }
#define XB_SPIN(cond, bar) do { unsigned _sp = 0; while (cond) { __builtin_amdgcn_s_sleep(1); \
    if ((++_sp & 255u) == 0u) { if (xb_ld(&(bar)[XB_TMO])) break; if (_sp > XB_SPIN_CAP) { atomicAdd(&(bar)[XB_TMO], 1u); break; } } } } while (0)

struct XcdBarrier {
    unsigned* bar; unsigned x;
    volatile LAS unsigned* st;
};

__device__ __forceinline__ XcdBarrier xcd_barrier_post(unsigned* bar, volatile LAS unsigned* st) {
    XcdBarrier b; b.bar = bar; b.x = xb_xcc_id(); b.st = st;
    if (threadIdx.x == 0) (void)xb_add(&bar[XB_XCNT(b.x)], 1u);
    return b;
}
__device__ __forceinline__ void xcd_barrier_complete(unsigned* bar, unsigned x, unsigned& nloc, unsigned& nx) {
    const unsigned G = gridDim.x * gridDim.y * gridDim.z;
    unsigned sum, cnt, mine, sp = 0u;
    for (;;) {
        sum = 0u; cnt = 0u; mine = 0u;
#pragma unroll
        for (unsigned j = 0; j < 16; ++j) { const unsigned c = xb_ld(&bar[XB_XCNT(j)]); sum += c; cnt += (c > 0u) ? 1u : 0u; mine = (j == x) ? c : mine; }
        if (sum == G) break;
        __builtin_amdgcn_s_sleep(1);
        if ((++sp & 255u) == 0u) { if (xb_ld(&bar[XB_TMO])) break; if (sp > XB_SPIN_CAP) { atomicAdd(&bar[XB_TMO], 1u); break; } }
    }
    nloc = mine > 0u ? mine : 1u; nx = cnt > 0u ? cnt : 1u;
}

#define XB_LSUB(j)  (3520 + 64 * (j))
#define XB_LGEN(j)  (4096 + 64 * (j))
__device__ __forceinline__ void xcc_local_barrier(unsigned* bar, unsigned x, unsigned nloc) {
    asm volatile("s_waitcnt vmcnt(0)" ::: "memory");
    __syncthreads();
    if (threadIdx.x == 0) {
        __builtin_amdgcn_s_waitcnt(0);
        const unsigned old = xb_add(&bar[XB_LSUB(x)], 1u);
        const unsigned gen = old / nloc;
        if (old + 1u == (gen + 1u) * nloc) xb_add(&bar[XB_LGEN(x)], 1u);
        else XB_SPIN(xb_ld(&bar[XB_LGEN(x)]) == gen, bar);
        __builtin_amdgcn_fence(__ATOMIC_ACQUIRE, "agent");
        asm volatile("s_waitcnt vmcnt(0)" ::: "memory");
    }
    __syncthreads();
}

__device__ __forceinline__ void xcd_barrier(const XcdBarrier& b) {
    asm volatile("s_waitcnt vmcnt(0)" ::: "memory");
    __syncthreads();
    if (threadIdx.x == 0) {
        unsigned* bar = b.bar;
        __builtin_amdgcn_s_waitcnt(0);
        unsigned nloc = b.st[0], nx = b.st[1];
        if (nloc == 0u) { xcd_barrier_complete(bar, b.x, nloc, nx); b.st[0] = nloc; b.st[1] = nx; }
        const unsigned old = xb_add(&bar[XB_XSUB(b.x)], 1u);
        const unsigned gen = old / nloc;
        if (old + 1u == (gen + 1u) * nloc) {
            __builtin_amdgcn_fence(__ATOMIC_RELEASE, "agent");
            asm volatile("s_waitcnt vmcnt(0)" ::: "memory");
            const unsigned og = xb_add(&bar[XB_TOP], 1u);
            const unsigned tg = og / nx;
            if (og + 1u == (tg + 1u) * nx) xb_add(&bar[XB_TOPGEN], 1u);
            else XB_SPIN(xb_ld(&bar[XB_TOPGEN]) == tg, bar);
            __builtin_amdgcn_fence(__ATOMIC_ACQUIRE, "agent");
            xb_add(&bar[XB_XGEN(b.x)], 1u);
            asm volatile("s_waitcnt vmcnt(0)" ::: "memory");
        } else {
            XB_SPIN(xb_ld(&bar[XB_XGEN(b.x)]) == gen, bar);
            __builtin_amdgcn_fence(__ATOMIC_ACQUIRE, "agent");
            asm volatile("s_waitcnt vmcnt(0)" ::: "memory");
        }
    }
    __syncthreads();
}

#ifndef GROUP_LOCAL_SYNC
#define GROUP_LOCAL_SYNC 1
#endif
constexpr int NWAVES = 8;
constexpr int BATCH = 16, SEQ = 4096, D = 1024, M = BATCH * SEQ;
constexpr int MH = 8, DK = 64, DV = 128, LCH = 64, NCH = SEQ / LCH;
constexpr int MIN_N = 3088, MIN_NP = 3328, MIN_LD = 3072;
constexpr int FH = 16;
constexpr int DFF = 2816, DFF2 = 5632;
constexpr int KV_N = 2064, KV_NP = 2304;
constexpr int MHALF = M / 2;
constexpr float EPS = 1e-6f;
constexpr float LOG2E = 1.4426950408889634f;

constexpr size_t MiB = 1u << 20;
constexpr size_t WS_CTL = 0, CTL_ZERO_BYTES = 1 * MiB;
constexpr size_t WS_GATES = 2 * MiB;
constexpr size_t WS_RSTD = 6 * MiB;
constexpr size_t WS_KMAX = 6 * MiB + 512 * 1024, WS_QMAX = WS_KMAX + 65536;
constexpr size_t WS_T0 = WS_QMAX + 32768;
constexpr size_t WS_W = 8 * MiB;
constexpr size_t SZ_WIN = (size_t)MIN_NP * D * 2, SZ_SQ = (size_t)D * D * 2, SZ_WKV = (size_t)KV_NP * D * 2, SZ_WQG = (size_t)2 * D * D * 2, SZ_WUP = (size_t)DFF2 * D * 2, SZ_WDN = (size_t)D * DFF * 2;
constexpr size_t WS_WIN = WS_W, WS_WMOUT = WS_WIN + 2 * SZ_WIN, WS_WKV = WS_WMOUT + 2 * SZ_SQ, WS_WQG = WS_WKV + SZ_WKV, WS_WFOUT = WS_WQG + 2 * SZ_WQG,
                 WS_WUP = WS_WFOUT + 2 * SZ_SQ, WS_WDN = WS_WUP + 4 * SZ_WUP, WS_WEND = WS_WDN + 4 * SZ_WDN;
constexpr size_t WS_C2 = 108 * MiB;
constexpr size_t WS_XH = 112 * MiB;
constexpr size_t WS_KB = 240 * MiB, WS_VB = 368 * MiB;
constexpr size_t WS_S = 496 * MiB;
constexpr size_t SLAB_BYTES = 64 * MiB;
constexpr size_t SO_QKVO = 0, SO_HA = 48 * MiB;
constexpr size_t SO_FQ = 0, SO_FG = 16 * MiB;
constexpr size_t SO_YM_A = 0, SO_YM_B = 32 * MiB, SO_YF = 48 * MiB;
constexpr size_t SO_ACT = 0, SO_HALO = 44 * MiB;
constexpr size_t SH_ROW1K = (size_t)8192 * D * 2, SH_QKVO = (size_t)8192 * MIN_LD * 2, SH_ACT = (size_t)8192 * DFF * 2, SH_HALO = (size_t)32 * 4 * DFF2 * 4;
static_assert(SH_QKVO <= SO_HA && SH_ACT <= SO_HALO && SO_HALO + SH_HALO <= SO_YF && SO_YF + SH_ROW1K <= SLAB_BYTES && SO_FG + SH_ROW1K <= SO_YM_B, "slab map");
#define SLAB(off, share) (ws + WS_S + (size_t)(off) + (size_t)xg * (SLAB_BYTES - (size_t)(share)))
constexpr size_t WS_SUMS = 1008 * MiB;
constexpr size_t WS_END = 1024 * MiB;
static_assert(WS_WEND <= WS_C2 && WS_S + 8 * SLAB_BYTES <= WS_END, "d_ws map");
constexpr int CW_TMO = 0, CW_BAR = 4096, CW_NCNT = 32768, CW_QUEUE = 65536;

constexpr int RING_OFF = 0, RING_BYTES = 131072;
constexpr int LDSCTL_OFF = RING_BYTES, MISC_OFF = LDSCTL_OFF + 320;
constexpr int LDS_BYTES = 147456;
constexpr int XCH_OFF = RING_BYTES + 1024;
static_assert(XCH_OFF + 8192 + 512 <= LDS_BYTES, "lds map");

__device__ __forceinline__ float wave_sum(float v) {
#pragma unroll
    for (int o = 1; o < 64; o <<= 1) v += __shfl_xor(v, o);
    return v;
}
__device__ __forceinline__ float bf_lo(unsigned w) { return __uint_as_float(w << 16); }
__device__ __forceinline__ float bf_hi(unsigned w) { return __uint_as_float(w & 0xffff0000u); }
__device__ __forceinline__ unsigned cvtpk(float lo, float hi) { typedef float f2 __attribute__((ext_vector_type(2))); typedef __bf16 b2 __attribute__((ext_vector_type(2))); f2 v = {lo, hi}; b2 b = __builtin_convertvector(v, b2); return __builtin_bit_cast(unsigned, b); }
#define BAR_LDS() do { asm volatile("s_waitcnt lgkmcnt(0)" ::: "memory"); __builtin_amdgcn_s_barrier(); asm volatile("" ::: "memory"); } while (0)

namespace pg8 {
struct EpiOut {
    static constexpr bool PERM = true, AFTER_DRAIN = false;
    bf16_t* O; int ldc; int split_cols; size_t split_stride; float scale0; int gate_tile; float* Gt; const float* rs;
    int* T0 = nullptr; const float* C2v = nullptr; const float* KMX = nullptr; PG8_LAS float* P = nullptr;
    __device__ __forceinline__ void operator()(const f32x4 (&acc)[2][2][4][2], const Unit& u, int wr, int wc, int fr, int fq) const {
        const int row0 = u.pm * BM + wr * 64 + fr;
        float rsc[2][4];
#pragma unroll
        for (int ai = 0; ai < 2; ++ai)
#pragma unroll
            for (int m = 0; m < 4; ++m) rsc[ai][m] = rs ? rs[row0 + ai * HALF + m * 16] : 1.f;
        if (u.pn == gate_tile) {
            if (wc == 0 && fq < 2) {
#pragma unroll
                for (int ai = 0; ai < 2; ++ai)
#pragma unroll
                    for (int m = 0; m < 4; ++m) { GAS float* gp = (GAS float*)Gt + (size_t)(row0 + ai * HALF + m * 16) * 16 + 8 * fq; *(GAS f32x4*)gp = acc[ai][0][m][0] * rsc[ai][m]; *(GAS f32x4*)(gp + 4) = acc[ai][0][m][1] * rsc[ai][m]; }
            }
            return;
        }
        int colt = u.pn * BM; bf16_t* base = O; float sc = 1.f; bool qtile = false;
        if (split_cols) { const int t = colt / split_cols; base += (size_t)t * split_stride; colt -= t * split_cols; if (t == 0) { sc = scale0; qtile = (T0 != nullptr); } }
        const int col0 = colt + wc * 32 + 8 * fq;
        const int px16 = ((fq ^ 1) * 16 + fr) * 4, px32 = ((fq ^ 2) * 16 + fr) * 4;
        float qv[2][4][2];
#pragma unroll
        for (int ai = 0; ai < 2; ++ai)
#pragma unroll
            for (int m = 0; m < 4; ++m) { bf16_t* rowp = base + (size_t)(row0 + ai * HALF + m * 16) * ldc + col0;
#pragma unroll
                for (int bj = 0; bj < 2; ++bj) { const float sr = sc * rsc[ai][m]; const f32x4 v0 = acc[ai][bj][m][0] * sr, v1 = acc[ai][bj][m][1] * sr;
                    u32x4 w; w.x = cvt_pk_bf16(v0[0], v0[1]); w.y = cvt_pk_bf16(v0[2], v0[3]); w.z = cvt_pk_bf16(v1[0], v1[1]); w.w = cvt_pk_bf16(v1[2], v1[3]);
                    *(u32x4*)(rowp + bj * HALF) = w;
                    if (qtile) {
                        float q = (bf_lo(w.x) * bf_lo(w.x) + bf_hi(w.x) * bf_hi(w.x)) + (bf_lo(w.y) * bf_lo(w.y) + bf_hi(w.y) * bf_hi(w.y)) + (bf_lo(w.z) * bf_lo(w.z) + bf_hi(w.z) * bf_hi(w.z)) + (bf_lo(w.w) * bf_lo(w.w) + bf_hi(w.w) * bf_hi(w.w));
                        qv[ai][m][bj] = q; } } }
        if (qtile) {
            {
                float t_[2][4][2];
#pragma unroll
                for (int ai = 0; ai < 2; ++ai)
#pragma unroll
                    for (int m = 0; m < 4; ++m)
#pragma unroll
                        for (int bj = 0; bj < 2; ++bj) t_[ai][m][bj] = __builtin_bit_cast(float, __builtin_amdgcn_ds_bpermute(px16, __builtin_bit_cast(int, qv[ai][m][bj])));
#pragma unroll
                for (int ai = 0; ai < 2; ++ai)
#pragma unroll
                    for (int m = 0; m < 4; ++m)
#pragma unroll
                        for (int bj = 0; bj < 2; ++bj) qv[ai][m][bj] += t_[ai][m][bj];
#pragma unroll
                for (int ai = 0; ai < 2; ++ai)
#pragma unroll
                    for (int m = 0; m < 4; ++m)
#pragma unroll
                        for (int bj = 0; bj < 2; ++bj) t_[ai][m][bj] = __builtin_bit_cast(float, __builtin_amdgcn_ds_bpermute(px32, __builtin_bit_cast(int, qv[ai][m][bj])));
                if (fq == 0) {
#pragma unroll
                    for (int ai = 0; ai < 2; ++ai)
#pragma unroll
                        for (int m = 0; m < 4; ++m)
#pragma unroll
                            for (int bj = 0; bj < 2; ++bj) P[(bj * 4 + wc) * 256 + ai * HALF + wr * 64 + m * 16 + fr] = qv[ai][m][bj] + t_[ai][m][bj];
                }
            }
            asm volatile("s_waitcnt lgkmcnt(0)" ::: "memory"); __builtin_amdgcn_s_barrier(); asm volatile("" ::: "memory");
            const int hd = wr * 4 + wc;
            if (hd < 4) {
                const int lane = fq * 16 + fr; const PG8_LAS float* p0 = P + ((hd >> 1) * 4 + 2 * (hd & 1)) * 256;
                float mx = 0.f;
#pragma unroll
                for (int k = 0; k < 4; ++k) mx = fmaxf(mx, p0[lane + 64 * k] + p0[256 + lane + 64 * k]);
#pragma unroll
                for (int o = 1; o < 64; o <<= 1) mx = fmaxf(mx, __builtin_bit_cast(float, __builtin_amdgcn_ds_bpermute((lane ^ o) * 4, __builtin_bit_cast(int, mx))));
                const int bh = (u.pm >> 4) * 16 + (colt >> 6) + hd, qb = u.pm & 15, NT = 4 * (qb + 1);
                const __attribute__((address_space(1))) float* c2 = (const __attribute__((address_space(1))) float*)C2v + (size_t)bh * 4096; const __attribute__((address_space(1))) float* km = (const __attribute__((address_space(1))) float*)KMX + bh * 64;
                const float cend = c2[64 * lane + 63], kt = sqrtf(km[lane]) * 1.0001f, qu = sqrtf(mx) * 1.0001f;
                const float kband = fmaxf(fmaxf(sqrtf(km[NT - 4]), sqrtf(km[NT - 3])), fmaxf(sqrtf(km[NT - 2]), sqrtf(km[NT - 1]))) * 1.0001f;
                const bool keep = (lane >= NT - 4) || (c2[256 * qb] - cend >= -(qu * (kt + kband) + 48.f));
                int t0 = __builtin_ctzll(__ballot(keep)); t0 = (t0 > NT - 4 ? NT - 4 : t0) & ~1;
                if (lane == 0) ((__attribute__((address_space(1))) int*)T0)[bh * 16 + qb] = t0;
            }
            asm volatile("s_waitcnt lgkmcnt(0)" ::: "memory"); __builtin_amdgcn_s_barrier(); asm volatile("" ::: "memory");
        }
    }
};

static_assert(WGM * 4 == 32, "EpiNormRes: the four column tiles of a token tile must be dealt to four workgroups of the SAME round (StaticOrder, N = 1024, 32 workgroups per group): WGM = 8");

#ifdef PROBE_K
#define NR_TS(k) do { if (blockIdx.x == 0 && tid == 0) { const unsigned long long tn_ = __builtin_amdgcn_s_memrealtime(); __hip_atomic_fetch_add((__attribute__((address_space(1))) unsigned long long*)(tmo - XB_TMO - CW_BAR + (512 * 1024 / 4) + 2 * (120 + (k))), tn_ - tl_, __ATOMIC_RELAXED, __HIP_MEMORY_SCOPE_AGENT); tl_ = tn_; } } while (0)
#else
#define NR_TS(k) do { } while (0)
#endif
struct EpiNormRes {
    static constexpr bool PERM = true, AFTER_DRAIN = false;
    bf16_t* XH; float* RSTD; const float* wpost; float* xout; bool last; float* SUMS; unsigned* CNT; unsigned* tmo; int kidx; PG8_LAS unsigned char* tl;
    __device__ __forceinline__ void exchange(int e, int pm, int pn, int tid, PG8_LAS float* T, PG8_LAS float* R) const {
        typedef __attribute__((address_space(1))) float gfloat; typedef __attribute__((address_space(1))) unsigned gunsigned; typedef __attribute__((address_space(1))) unsigned long long gu64t;
        asm volatile("s_waitcnt lgkmcnt(0)" ::: "memory"); __builtin_amdgcn_s_barrier(); asm volatile("" ::: "memory");
        if (tid < 256) {
            gu64t* slot = (gu64t*)SUMS + ((size_t)(e * 256 + pm) * 4) * 256;
            const unsigned tag = (unsigned)(2 * kidx + e + 1);
            const float own = (T[tid] + T[256 + tid]) + (T[512 + tid] + T[768 + tid]);
            __hip_atomic_store(slot + pn * 256 + tid, ((unsigned long long)tag << 32) | (unsigned long long)__builtin_bit_cast(unsigned, own), __ATOMIC_RELAXED, __HIP_MEMORY_SCOPE_AGENT);
            float rs_old = 1.f, wg = 0.f;
            if (e == 0) { rs_old = ((const gfloat*)RSTD)[pm * 256 + tid]; wg = ((const gfloat*)wpost)[pn * 256 + tid]; }
#ifdef PROBE_K
            const unsigned long long tq0_ = __builtin_amdgcn_s_memrealtime();
#endif
            unsigned long long w[4]; unsigned sp = 0;
            for (;;) {
#pragma unroll
                for (int q = 0; q < 4; ++q) w[q] = __hip_atomic_load(slot + q * 256 + tid, __ATOMIC_RELAXED, __HIP_MEMORY_SCOPE_AGENT);
                if ((unsigned)(w[0] >> 32) == tag && (unsigned)(w[1] >> 32) == tag && (unsigned)(w[2] >> 32) == tag && (unsigned)(w[3] >> 32) == tag) break;
                __builtin_amdgcn_s_sleep(1);
                if ((++sp & 255u) == 0u) { if (__hip_atomic_load((gunsigned*)tmo, __ATOMIC_RELAXED, __HIP_MEMORY_SCOPE_AGENT)) break; if (sp > (1u << 18)) { __hip_atomic_fetch_add((gunsigned*)tmo, 1u, __ATOMIC_RELAXED, __HIP_MEMORY_SCOPE_AGENT); break; } }
            }
#ifdef PROBE_K
            if (blockIdx.x == 0 && tid == 0) __hip_atomic_fetch_add((__attribute__((address_space(1))) unsigned long long*)(tmo - XB_TMO - CW_BAR + (512 * 1024 / 4) + 2 * (113 + 2 * e)), __builtin_amdgcn_s_memrealtime() - tq0_, __ATOMIC_RELAXED, __HIP_MEMORY_SCOPE_AGENT);
#endif
            float s = 0.f;
#pragma unroll
            for (int q = 0; q < 4; ++q) s += (q == pn) ? own : __builtin_bit_cast(float, (unsigned)w[q]);
            const float r = __builtin_amdgcn_rsqf(s * (1.f / 1024.f) + 1e-6f);
            R[tid] = r;
            if (e == 0) { R[256 + tid] = 1.0f / rs_old; R[512 + tid] = wg; }
            if (e == 1 && pn == 0) ((gfloat*)RSTD)[pm * 256 + tid] = r;
        }
        asm volatile("s_waitcnt lgkmcnt(0)" ::: "memory"); __builtin_amdgcn_s_barrier(); asm volatile("" ::: "memory");
    }
    __device__ __forceinline__ void operator()(f32x4 (&acc)[2][2][4][2], const Unit& u, int wr, int wc, int fr_in, int fq_in) const {
        typedef __attribute__((address_space(1))) float gfloat;
        int fr = fr_in, fq = fq_in; asm volatile("" : "+v"(fr), "+v"(fq));
        const int tid = (wr * 4 + wc) * 64 + fq * 16 + fr;
#ifdef PROBE_K
        const unsigned long long tp0_ = __builtin_amdgcn_s_memrealtime(); unsigned long long tl_ = tp0_;
#endif
        const int px16 = ((fq ^ 1) * 16 + fr) * 4, px32 = ((fq ^ 2) * 16 + fr) * 4;
#define NR_XSUM8(q) do { float t_[2][4]; \
        _Pragma("unroll") for (int a_ = 0; a_ < 2; ++a_) _Pragma("unroll") for (int m_ = 0; m_ < 4; ++m_) t_[a_][m_] = __builtin_bit_cast(float, __builtin_amdgcn_ds_bpermute(px16, __builtin_bit_cast(int, q[a_][m_]))); \
        _Pragma("unroll") for (int a_ = 0; a_ < 2; ++a_) _Pragma("unroll") for (int m_ = 0; m_ < 4; ++m_) q[a_][m_] += t_[a_][m_]; \
        _Pragma("unroll") for (int a_ = 0; a_ < 2; ++a_) _Pragma("unroll") for (int m_ = 0; m_ < 4; ++m_) t_[a_][m_] = __builtin_bit_cast(float, __builtin_amdgcn_ds_bpermute(px32, __builtin_bit_cast(int, q[a_][m_]))); \
        _Pragma("unroll") for (int a_ = 0; a_ < 2; ++a_) _Pragma("unroll") for (int m_ = 0; m_ < 4; ++m_) q[a_][m_] += t_[a_][m_]; } while (0)
        PG8_LAS float* T = (PG8_LAS float*)tl; PG8_LAS float* R = T + 1024;
        const int rl0 = wr * 64 + fr;
        u32x4 xh[2][4][2];
        const unsigned voff = (unsigned)((rl0 * 1024 + wc * 32 + 8 * fq) * 2);
        const char* xu = (const char*)(XH + (size_t)u.pm * BM * 1024 + u.pn * BM);
        {
#pragma unroll
            for (int ai = 0; ai < 2; ++ai)
#pragma unroll
                for (int m = 0; m < 4; ++m) {
#pragma unroll
                    for (int bj = 0; bj < 2; ++bj) xh[ai][m][bj] = *(const __attribute__((address_space(1))) u32x4*)(xu + ((ai * HALF + m * 16) * 1024 + bj * HALF) * 2 + voff);
                }
        }
        __builtin_amdgcn_sched_barrier(0);
        float ps[2][4];
#pragma unroll
        for (int ai = 0; ai < 2; ++ai)
#pragma unroll
            for (int m = 0; m < 4; ++m) {
                float p = 0.f;
#pragma unroll
                for (int bj = 0; bj < 2; ++bj)
#pragma unroll
                    for (int n = 0; n < 2; ++n) { const f32x4 a = acc[ai][bj][m][n]; p += (a[0] * a[0] + a[1] * a[1]) + (a[2] * a[2] + a[3] * a[3]); }
                ps[ai][m] = p;
            }
        NR_XSUM8(ps);
        if (fq == 0) {
#pragma unroll
            for (int ai = 0; ai < 2; ++ai)
#pragma unroll
                for (int m = 0; m < 4; ++m) T[wc * 256 + ai * HALF + m * 16 + rl0] = ps[ai][m];
        }
        NR_TS(0);
        exchange(0, u.pm, u.pn, tid, T, R);
        NR_TS(1);
#pragma unroll
        for (int ai = 0; ai < 2; ++ai)
#pragma unroll
            for (int m = 0; m < 4; ++m) {
                const float ry = R[ai * HALF + m * 16 + rl0], rinv = R[256 + ai * HALF + m * 16 + rl0];
                float p = 0.f;
#pragma unroll
                for (int bj = 0; bj < 2; ++bj) {
                    const u32x4 w = xh[ai][m][bj];
                    const f32x4 x0 = (f32x4){bf_lo(w.x), bf_hi(w.x), bf_lo(w.y), bf_hi(w.y)} * rinv, x1 = (f32x4){bf_lo(w.z), bf_hi(w.z), bf_lo(w.w), bf_hi(w.w)} * rinv;
                    const f32x4 wp0 = *(const PG8_LAS f32x4*)(R + 512 + bj * HALF + wc * 32 + 8 * fq), wp1 = *(const PG8_LAS f32x4*)(R + 512 + bj * HALF + wc * 32 + 8 * fq + 4);
                    const f32x4 a0 = x0 + (acc[ai][bj][m][0] * ry) * wp0, a1 = x1 + (acc[ai][bj][m][1] * ry) * wp1;
                    acc[ai][bj][m][0] = a0; acc[ai][bj][m][1] = a1;
                    p += ((a0[0] * a0[0] + a0[1] * a0[1]) + (a0[2] * a0[2] + a0[3] * a0[3])) + ((a1[0] * a1[0] + a1[1] * a1[1]) + (a1[2] * a1[2] + a1[3] * a1[3]));
                }
                ps[ai][m] = p;
            }
        if (!last) {
            NR_XSUM8(ps);
            if (fq == 0) {
#pragma unroll
                for (int ai = 0; ai < 2; ++ai)
#pragma unroll
                    for (int m = 0; m < 4; ++m) T[wc * 256 + ai * HALF + m * 16 + rl0] = ps[ai][m];
            }
        }
        if (last) {
            char* ou = (char*)(xout + (size_t)u.pm * BM * 1024 + u.pn * BM); unsigned vo2 = voff * 2u; asm volatile("" : "+v"(vo2));
#pragma unroll
            for (int ai = 0; ai < 2; ++ai)
#pragma unroll
                for (int m = 0; m < 4; ++m)
#pragma unroll
                    for (int bj = 0; bj < 2; ++bj)
#pragma unroll
                        for (int n = 0; n < 2; ++n) __builtin_nontemporal_store(acc[ai][bj][m][n], (__attribute__((address_space(1))) f32x4*)(ou + ((ai * HALF + m * 16) * 1024 + bj * HALF + 4 * n) * 4 + vo2));
            return;
        }
        NR_TS(2);
        exchange(1, u.pm, u.pn, tid, T, R);
        NR_TS(3);
        {
            unsigned vo1 = voff; asm volatile("" : "+v"(vo1));
#pragma unroll
            for (int ai = 0; ai < 2; ++ai)
#pragma unroll
                for (int m = 0; m < 4; ++m) {
                    const float rx = R[ai * HALF + m * 16 + rl0];
#pragma unroll
                    for (int bj = 0; bj < 2; ++bj) { const f32x4 v0 = acc[ai][bj][m][0] * rx, v1 = acc[ai][bj][m][1] * rx;
                        u32x4 w; w.x = cvt_pk_bf16(v0[0], v0[1]); w.y = cvt_pk_bf16(v0[2], v0[3]); w.z = cvt_pk_bf16(v1[0], v1[1]); w.w = cvt_pk_bf16(v1[2], v1[3]);
                        *(__attribute__((address_space(1))) u32x4*)((char*)xu + ((ai * HALF + m * 16) * 1024 + bj * HALF) * 2 + vo1) = w; }
                }
        }
#ifdef PROBE_K
        if (blockIdx.x == 0 && tid == 0) __hip_atomic_fetch_add((__attribute__((address_space(1))) unsigned long long*)(tmo - XB_TMO - CW_BAR + (512 * 1024 / 4) + 2 * 111), __builtin_amdgcn_s_memrealtime() - tp0_, __ATOMIC_RELAXED, __HIP_MEMORY_SCOPE_AGENT);
#endif
#undef NR_XSUM8
    }
};

template <int N> __device__ __forceinline__ float dpp_ror(float v) { return __builtin_bit_cast(float, __builtin_amdgcn_mov_dpp(__builtin_bit_cast(int, v), 0x120 + N, 0xf, 0xf, false)); }
__device__ __forceinline__ float dpp_ror1(float v) { return dpp_ror<1>(v); }
__device__ __forceinline__ float dpp_ror2(float v) { return dpp_ror<2>(v); }
__device__ __forceinline__ float fmac_shr1(float acc, float src, float w) { asm("v_fmac_f32_dpp %0, %1, %2 row_shr:1 row_mask:0xf bank_mask:0xf bound_ctrl:1" : "+v"(acc) : "v"(src), "v"(w)); return acc; }
__device__ __forceinline__ float fmac_shr2(float acc, float src, float w) { asm("v_fmac_f32_dpp %0, %1, %2 row_shr:2 row_mask:0xf bank_mask:0xf bound_ctrl:1" : "+v"(acc) : "v"(src), "v"(w)); return acc; }
__device__ __forceinline__ float fmac_shl15(float acc, float src, float w) { asm("v_fmac_f32_dpp %0, %1, %2 row_shl:15 row_mask:0xf bank_mask:0xf bound_ctrl:1" : "+v"(acc) : "v"(src), "v"(w)); return acc; }
__device__ __forceinline__ float fmac_shl14(float acc, float src, float w) { asm("v_fmac_f32_dpp %0, %1, %2 row_shl:14 row_mask:0xf bank_mask:0xf bound_ctrl:1" : "+v"(acc) : "v"(src), "v"(w)); return acc; }
template <int N> __device__ __forceinline__ float dpp_shr_old(float old, float v) { return __builtin_bit_cast(float, __builtin_amdgcn_update_dpp(__builtin_bit_cast(int, old), __builtin_bit_cast(int, v), 0x110 + N, 0xf, 0xf, false)); }
struct EpiConv {
    static constexpr bool PERM = true, AFTER_DRAIN = false, APERM = true;
    bf16_t* ACT; const float* cw; const float* cb; float* HALO; PG8_LAS unsigned char* xch; int dff; const float* rs;
    __device__ __forceinline__ void operator()(const f32x4 (&acc)[2][2][4][2], const Unit& u, int wr, int wc, int fr_in, int fq_in) const {
        typedef PG8_LAS f32x4 las4;
        int fr = fr_in, fq = fq_in; asm volatile("" : "+v"(fr), "+v"(fq));
        (void)rs;
        if (fr == 15) {
#pragma unroll
            for (int ai = 0; ai < 2; ++ai)
#pragma unroll
                for (int bj = 0; bj < 2; ++bj)
#pragma unroll
                    for (int mm = 0; mm < 2; ++mm)
#pragma unroll
                        for (int n = 0; n < 2; ++n) *(las4*)(xch + (((((wc * 4 + 2 * ai + wr) * 2 + mm) * 2 + bj) * 32) + 8 * fq + 4 * n) * 4) = acc[ai][bj][2 + mm][n];
        }
        {
            const int colu = u.pn * BM + wc * 32 + 8 * fq;
            if (wr == 0 && fr == 0) {
#pragma unroll
                for (int mm = 0; mm < 2; ++mm)
#pragma unroll
                    for (int bj = 0; bj < 2; ++bj)
#pragma unroll
                        for (int n = 0; n < 2; ++n) *(__attribute__((address_space(1))) f32x4*)(HALO + ((size_t)u.pm * 4 + mm) * (2 * dff) + colu + bj * HALF + 4 * n) = acc[0][bj][mm][n];
            }
            if (wr == 1 && fr == 15) {
#pragma unroll
                for (int mm = 0; mm < 2; ++mm)
#pragma unroll
                    for (int bj = 0; bj < 2; ++bj)
#pragma unroll
                        for (int n = 0; n < 2; ++n) *(__attribute__((address_space(1))) f32x4*)(HALO + ((size_t)u.pm * 4 + 2 + mm) * (2 * dff) + colu + bj * HALF + 4 * n) = acc[1][bj][2 + mm][n];
            }
        }
        asm volatile("s_waitcnt lgkmcnt(0)" ::: "memory"); __builtin_amdgcn_s_barrier(); asm volatile("" ::: "memory");
        const int ca = u.pn * HALF + wc * 32 + 8 * fq;
        unsigned pk0[2][4][2];
#pragma unroll
        for (int n = 0; n < 2; ++n) {
            const f32x4 wg0 = *(const f32x4*)(cw + ca + 4 * n), wg1 = *(const f32x4*)(cw + 2 * dff + ca + 4 * n), wg2 = *(const f32x4*)(cw + 4 * dff + ca + 4 * n), bg = *(const f32x4*)(cb + ca + 4 * n);
            const f32x4 wv0 = *(const f32x4*)(cw + dff + ca + 4 * n), wv1 = *(const f32x4*)(cw + 3 * dff + ca + 4 * n), wv2 = *(const f32x4*)(cw + 5 * dff + ca + 4 * n), bv = *(const f32x4*)(cb + dff + ca + 4 * n);
#pragma unroll
            for (int ai = 0; ai < 2; ++ai) {
                const int g = 2 * ai + wr;
                const PG8_LAS unsigned char* hb = xch + (g > 0 ? ((wc * 4 + (g - 1)) * 2) * 2 * 32 * 4 : 8192) + (8 * fq + 4 * n) * 4;
                const int hrow = g > 0 ? 2 * 32 * 4 : 0;
                f32x4 s2g = *(const las4*)(hb), s2v = *(const las4*)(hb + 32 * 4), s3g = *(const las4*)(hb + hrow), s3v = *(const las4*)(hb + hrow + 32 * 4);
#pragma unroll
                for (int j = 0; j < 4; ++j) {
                    s3g[j] = dpp_shr_old<1>(s3g[j], acc[ai][0][3][n][j]); s2g[j] = dpp_shr_old<1>(s2g[j], acc[ai][0][2][n][j]);
                    s3v[j] = dpp_shr_old<1>(s3v[j], acc[ai][1][3][n][j]); s2v[j] = dpp_shr_old<1>(s2v[j], acc[ai][1][2][n][j]);
                }
#pragma unroll
                for (int m = 0; m < 4; ++m) {
                    const f32x4 cg = acc[ai][0][m][n], cv = acc[ai][1][m][n];
                    const f32x4 g1 = (m == 0) ? s3g : acc[ai][0][m == 0 ? 0 : m - 1][n], v1 = (m == 0) ? s3v : acc[ai][1][m == 0 ? 0 : m - 1][n];
                    const f32x4 g2 = (m == 0) ? s2g : (m == 1) ? s3g : acc[ai][0][m < 2 ? 0 : m - 2][n], v2 = (m == 0) ? s2v : (m == 1) ? s3v : acc[ai][1][m < 2 ? 0 : m - 2][n];
                    const f32x4 yg = wg2 * cg + bg + wg1 * g1 + wg0 * g2, yv = wv2 * cv + bv + wv1 * v1 + wv0 * v2;
                    const f32x4 ea = yg * ((yg * yg) * (-2.302208198f * 0.044715f) + (-2.302208198f));
                    f32x4 e;
#pragma unroll
                    for (int j = 0; j < 4; ++j) e[j] = __builtin_amdgcn_exp2f(ea[j]);
                    const f32x4 d = e + 1.0f;
                    f32x4 r;
#pragma unroll
                    for (int j = 0; j < 4; ++j) r[j] = __builtin_amdgcn_rcpf(d[j]);
                    const f32x4 o = (yg * r) * yv;
                    const unsigned w0 = cvt_pk_bf16(o[0], o[1]), w1 = cvt_pk_bf16(o[2], o[3]);
                    if (n == 0) { pk0[ai][m][0] = w0; pk0[ai][m][1] = w1; }
                    else { u32x4 w; w.x = pk0[ai][m][0]; w.y = pk0[ai][m][1]; w.z = w0; w.w = w1;
                        *(__attribute__((address_space(1))) u32x4*)(ACT + (size_t)(u.pm * BM + ai * HALF + wr * 64 + 4 * fr + m) * dff + ca) = w; }
                }
            }
        }
    }
};
}

__device__ __forceinline__ void wt_item(const float* W, int Ns, const float* gain, bf16* WT, int Kd, int dst_row0, int k0, int n0, LAS float* scr, int lane) {
    const int nn = lane & 31; const bool inb = (n0 + nn) < Ns; const int ncl = inb ? n0 + nn : Ns - 1;
    const GAS float* src = (const GAS float*)W + (size_t)(k0 + (lane >> 5)) * Ns + ncl;
    float v[32];
#pragma unroll
    for (int i = 0; i < 32; ++i) v[i] = src[(size_t)(2 * i) * Ns];
    const int c = lane & 7;
    f32x4 g0 = (f32x4){1.f, 1.f, 1.f, 1.f}, g1 = g0;
    if (gain) { g0 = *(const GAS f32x4*)(gain + k0 + 8 * c); g1 = *(const GAS f32x4*)(gain + k0 + 8 * c + 4); }
#pragma unroll
    for (int i = 0; i < 32; ++i) scr[(2 * i + (lane >> 5)) * 33 + nn] = inb ? v[i] : 0.f;
    LDS_WAIT(); asm volatile("" ::: "memory");
#pragma unroll
    for (int j = 0; j < 4; ++j) { const int n = (lane >> 3) + 8 * j; const LAS float* s = scr + (8 * c) * 33 + n;
        v4u o; o.x = cvtpk(s[0 * 33] * g0[0], s[1 * 33] * g0[1]); o.y = cvtpk(s[2 * 33] * g0[2], s[3 * 33] * g0[3]); o.z = cvtpk(s[4 * 33] * g1[0], s[5 * 33] * g1[1]); o.w = cvtpk(s[6 * 33] * g1[2], s[7 * 33] * g1[3]);
        *(GAS v4u*)(WT + (size_t)(dst_row0 + n) * Kd + k0 + 8 * c) = o; }
    LDS_WAIT(); asm volatile("" ::: "memory");
}
struct Ins { const float* p[18]; };
__device__ __forceinline__ void prologue_weights(const Ins& in, unsigned char* ws, LAS unsigned char* lds, int gw, int NGW, int wave, int lane) {
    LAS float* scr = (LAS float*)(lds + RING_OFF + wave * 16384);
    constexpr int I_IN = 16 * (MIN_NP / 32), I_SQ = 16 * 32, I_KV = 16 * (KV_NP / 32), I_QG = 16 * 64, I_UP = 16 * (DFF2 / 32), I_DN = (DFF / 64) * 32;
    constexpr int E0 = 2 * I_IN, E1 = E0 + 2 * I_SQ, E2 = E1 + I_KV, E3 = E2 + 2 * I_QG, E4 = E3 + 2 * I_SQ, E5 = E4 + 4 * I_UP, E6 = E5 + 4 * I_DN;
    for (int it = gw; it < E6; it += NGW) {
        const float* W; const float* gain = nullptr; bf16* WT; int Ns, Kd = D, nblk, r, kind = 0;
        if (it < E0)      { r = it;      const int L = r / I_IN; r -= L * I_IN; W = in.p[5] + (size_t)L * D * MIN_N; gain = in.p[1] + L * D; WT = (bf16*)(ws + WS_WIN + L * SZ_WIN); Ns = MIN_N; nblk = MIN_NP / 32; }
        else if (it < E1) { r = it - E0; const int L = r / I_SQ; r -= L * I_SQ; W = in.p[8] + (size_t)L * D * D; WT = (bf16*)(ws + WS_WMOUT + L * SZ_SQ); Ns = D; nblk = 32; }
        else if (it < E2) { r = it - E1; W = in.p[10]; gain = in.p[9]; WT = (bf16*)(ws + WS_WKV); Ns = KV_N; nblk = KV_NP / 32; }
        else if (it < E3) { r = it - E2; const int L = r / I_QG; r -= L * I_QG; W = in.p[12] + (size_t)L * D * 2 * D; gain = in.p[1] + (2 + L) * D; WT = (bf16*)(ws + WS_WQG + L * SZ_WQG); Ns = 2 * D; nblk = 64; }
        else if (it < E4) { r = it - E3; const int L = r / I_SQ; r -= L * I_SQ; W = in.p[13] + (size_t)L * D * D; WT = (bf16*)(ws + WS_WFOUT + L * SZ_SQ); Ns = D; nblk = 32; }
        else if (it < E5) { r = it - E4; const int L = r / I_UP; r -= L * I_UP; W = in.p[14] + (size_t)L * D * DFF2; gain = in.p[3] + L * D; WT = (bf16*)(ws + WS_WUP + L * SZ_WUP); Ns = DFF2; nblk = DFF2 / 32; kind = 1; }
        else              { r = it - E5; const int L = r / I_DN; r -= L * I_DN; W = in.p[17] + (size_t)L * DFF * D; WT = (bf16*)(ws + WS_WDN + L * SZ_WDN); Ns = D; nblk = 32; Kd = DFF; }
        const int kb = r / nblk, nb = r - kb * nblk, n0 = 32 * nb;
        int drow = n0;
        if (kind == 1) drow = (n0 < DFF) ? 256 * (n0 >> 7) + (n0 & 127) : 256 * ((n0 - DFF) >> 7) + 128 + ((n0 - DFF) & 127);
        wt_item(W, Ns, gain, WT, Kd, drow, 64 * kb, n0, scr, lane);
    }
}

__device__ __forceinline__ void norm_first(const float* x, bf16* XH, float* RSTD, int gw, int NGW, int lane) {
    for (int m = gw; m < M; m += NGW) {
        const GAS f32x4* xr = (const GAS f32x4*)(x + (size_t)m * D) + lane;
        f32x4 v[4]; float s = 0.f;
#pragma unroll
        for (int j = 0; j < 4; ++j) { v[j] = __builtin_nontemporal_load(xr + 64 * j); s += (v[j].x * v[j].x + v[j].y * v[j].y) + (v[j].z * v[j].z + v[j].w * v[j].w); }
        const float r = __builtin_amdgcn_rsqf(wave_sum(s) * (1.f / D) + EPS);
        GAS unsigned long long* o8 = (GAS unsigned long long*)(XH + (size_t)m * D) + lane;
#pragma unroll
        for (int j = 0; j < 4; ++j) o8[64 * j] = (unsigned long long)cvtpk(v[j].x * r, v[j].y * r) | ((unsigned long long)cvtpk(v[j].z * r, v[j].w * r) << 32);
        if (lane == 0) RSTD[m] = r;
    }
}
__device__ __forceinline__ void norm_res(bf16* XH, const bf16* Y, const float* wpost, float* RSTD, float* xout, bool last, int vcu, int wave, int lane) {
    f32x4 wp[4];
#pragma unroll
    for (int j = 0; j < 4; ++j) wp[j] = ((const GAS f32x4*)wpost)[lane + 64 * j];
    for (int m = 256 * vcu + wave; m < 256 * vcu + 256; m += NWAVES) {
        GAS unsigned long long* xr = (GAS unsigned long long*)(XH + (size_t)m * D) + lane;
        const GAS unsigned long long* yr = (const GAS unsigned long long*)(Y + (size_t)m * D) + lane;
        const float rinv = 1.0f / ((const GAS float*)RSTD)[m];
        f32x4 xv[4], yv[4]; float sy = 0.f;
#pragma unroll
        for (int j = 0; j < 4; ++j) { const unsigned long long a = xr[64 * j], w = yr[64 * j]; const unsigned alo = (unsigned)a, ahi = (unsigned)(a >> 32), lo = (unsigned)w, hi = (unsigned)(w >> 32);
            xv[j] = (f32x4){bf_lo(alo), bf_hi(alo), bf_lo(ahi), bf_hi(ahi)} * rinv;
            yv[j] = (f32x4){bf_lo(lo), bf_hi(lo), bf_lo(hi), bf_hi(hi)}; sy += (yv[j].x * yv[j].x + yv[j].y * yv[j].y) + (yv[j].z * yv[j].z + yv[j].w * yv[j].w); }
        const float ry = __builtin_amdgcn_rsqf(wave_sum(sy) * (1.f / D) + EPS); float sx = 0.f;
#pragma unroll
        for (int j = 0; j < 4; ++j) { xv[j] = xv[j] + (yv[j] * ry) * wp[j]; sx += (xv[j].x * xv[j].x + xv[j].y * xv[j].y) + (xv[j].z * xv[j].z + xv[j].w * xv[j].w); }
        if (last) {
            GAS f32x4* xo = (GAS f32x4*)(xout + (size_t)m * D) + lane;
#pragma unroll
            for (int j = 0; j < 4; ++j) xo[64 * j] = xv[j];
        } else {
            const float rx = __builtin_amdgcn_rsqf(wave_sum(sx) * (1.f / D) + EPS);
#pragma unroll
            for (int j = 0; j < 4; ++j) xr[64 * j] = (unsigned long long)cvtpk(xv[j].x * rx, xv[j].y * rx) | ((unsigned long long)cvtpk(xv[j].z * rx, xv[j].w * rx) << 32);
            if (lane == 0) RSTD[m] = rx;
        }
    }
}

__device__ __forceinline__ float gelu_tanh(float x) {
    const float z = x + 0.044715f * x * x * x;
    return x * __builtin_amdgcn_rcpf(1.f + __builtin_amdgcn_exp2f(-2.0f * 0.7978845608028654f * LOG2E * z));
}
__device__ __forceinline__ void conv_phase(const bf16* U, const float* cw, const float* cb, bf16* ACT, int gtid, int NT) {
    constexpr int RG = 16, NRG = MHALF / RG, NCG = DFF / 8;
    for (int task = gtid; task < NRG * NCG; task += NT) {
        const int rg = task / NCG, cg = task - rg * NCG, r0 = rg * RG, c0 = cg * 8;
        const int ucol = 256 * (c0 >> 7) + (c0 & 127);
        float wg[3][8], wv[3][8], bg[8], bv[8];
#pragma unroll
        for (int j = 0; j < 3; ++j)
#pragma unroll
            for (int e = 0; e < 8; ++e) { wg[j][e] = cw[j * DFF2 + c0 + e]; wv[j][e] = cw[j * DFF2 + DFF + c0 + e]; }
#pragma unroll
        for (int e = 0; e < 8; ++e) { bg[e] = cb[c0 + e]; bv[e] = cb[DFF + c0 + e]; }
        float g2[8], g1[8], v2[8], v1[8];
        const bool has_prev = (r0 % SEQ) != 0;
        if (has_prev) {
            const v4u a = *(const GAS v4u*)(U + (size_t)(r0 - 2) * DFF2 + ucol), b = *(const GAS v4u*)(U + (size_t)(r0 - 2) * DFF2 + ucol + 128);
            const v4u c = *(const GAS v4u*)(U + (size_t)(r0 - 1) * DFF2 + ucol), d = *(const GAS v4u*)(U + (size_t)(r0 - 1) * DFF2 + ucol + 128);
#pragma unroll
            for (int e = 0; e < 4; ++e) { g2[2 * e] = bf_lo(a[e]); g2[2 * e + 1] = bf_hi(a[e]); v2[2 * e] = bf_lo(b[e]); v2[2 * e + 1] = bf_hi(b[e]);
                                          g1[2 * e] = bf_lo(c[e]); g1[2 * e + 1] = bf_hi(c[e]); v1[2 * e] = bf_lo(d[e]); v1[2 * e + 1] = bf_hi(d[e]); }
        } else {
#pragma unroll
            for (int e = 0; e < 8; ++e) { g2[e] = 0.f; g1[e] = 0.f; v2[e] = 0.f; v1[e] = 0.f; }
        }
#pragma unroll 4
        for (int i = 0; i < RG; ++i) {
            const v4u a = *(const GAS v4u*)(U + (size_t)(r0 + i) * DFF2 + ucol), b = *(const GAS v4u*)(U + (size_t)(r0 + i) * DFF2 + ucol + 128);
            float g0[8], v0[8]; v4u o;
#pragma unroll
            for (int e = 0; e < 4; ++e) { g0[2 * e] = bf_lo(a[e]); g0[2 * e + 1] = bf_hi(a[e]); v0[2 * e] = bf_lo(b[e]); v0[2 * e + 1] = bf_hi(b[e]); }
            float r[8];
#pragma unroll
            for (int e = 0; e < 8; ++e) { const float yg = bg[e] + wg[0][e] * g2[e] + wg[1][e] * g1[e] + wg[2][e] * g0[e]; const float yv = bv[e] + wv[0][e] * v2[e] + wv[1][e] * v1[e] + wv[2][e] * v0[e];
                r[e] = gelu_tanh(yg) * yv; g2[e] = g1[e]; g1[e] = g0[e]; v2[e] = v1[e]; v1[e] = v0[e]; }
            o.x = cvtpk(r[0], r[1]); o.y = cvtpk(r[2], r[3]); o.z = cvtpk(r[4], r[5]); o.w = cvtpk(r[6], r[7]);
            *(GAS v4u*)(ACT + (size_t)(r0 + i) * DFF + c0) = o;
        }
    }
}

__device__ __forceinline__ void ffn_fixup_phase(const float* HALO, const float* cw, const float* cb, bf16* ACT, int vcu, int tid) {
    constexpr int NCG = DFF / 4;
    const int pm = vcu;
    if ((pm & 15) == 0) return;
    for (int cg = tid; cg < NCG; cg += NWAVES * 64) {
        const int c0 = cg * 4;
        const int ucol = 256 * (c0 >> 7) + (c0 & 127);
        const GAS float* Hp = (const GAS float*)HALO + (size_t)(pm - 1) * 4 * DFF2; const GAS float* Hc = (const GAS float*)HALO + (size_t)pm * 4 * DFF2;
        f32x4 a254[2], a255[2], c0v[2], c1v[2], w0[2], w1[2], w2[2], bb[2];
#pragma unroll
        for (int half = 0; half < 2; ++half) {
            const int uc = ucol + 128 * half, pc = c0 + DFF * half;
            a254[half] = *(const GAS f32x4*)(Hp + 2 * DFF2 + uc); a255[half] = *(const GAS f32x4*)(Hp + 3 * DFF2 + uc); c0v[half] = *(const GAS f32x4*)(Hc + uc); c1v[half] = *(const GAS f32x4*)(Hc + DFF2 + uc);
            w0[half] = *(const GAS f32x4*)(cw + pc); w1[half] = *(const GAS f32x4*)(cw + DFF2 + pc); w2[half] = *(const GAS f32x4*)(cw + 2 * DFF2 + pc); bb[half] = *(const GAS f32x4*)(cb + pc);
        }
        typedef unsigned u32x2 __attribute__((ext_vector_type(2)));
#pragma unroll
        for (int row = 0; row < 2; ++row) {
            const f32x4 yg = (row == 0) ? bb[0] + w0[0] * a254[0] + w1[0] * a255[0] + w2[0] * c0v[0] : bb[0] + w0[0] * a255[0] + w1[0] * c0v[0] + w2[0] * c1v[0];
            const f32x4 yv = (row == 0) ? bb[1] + w0[1] * a254[1] + w1[1] * a255[1] + w2[1] * c0v[1] : bb[1] + w0[1] * a255[1] + w1[1] * c0v[1] + w2[1] * c1v[1];
            f32x4 o; o[0] = gelu_tanh(yg[0]); o[1] = gelu_tanh(yg[1]); o[2] = gelu_tanh(yg[2]); o[3] = gelu_tanh(yg[3]); o = o * yv;
            u32x2 w; w.x = cvtpk(o[0], o[1]); w.y = cvtpk(o[2], o[3]);
            *(GAS u32x2*)(ACT + (size_t)(pm * 256 + row) * DFF + c0) = w;
        }
    }
}

typedef short s16x4 __attribute__((ext_vector_type(4)));
typedef LAS s16x4 las_s16x4; typedef LAS bf16x8 las_bf16x8; typedef LAS f32x4 las_f32x4;
__device__ __forceinline__ s16x4 tr16(const LAS bf16* p) { typedef short v4i16_t __attribute__((ext_vector_type(4))); return __builtin_bit_cast(s16x4, __builtin_amdgcn_ds_read_tr16_b64_v4i16((LAS v4i16_t*)p)); }
__device__ __forceinline__ float wscan_add(float v, int lane) {
#pragma unroll
    for (int o = 1; o < 64; o <<= 1) { const float t = __shfl_up(v, o); if (lane >= o) v += t; }
    return v;
}
__device__ __forceinline__ float wscan_max(float v, int lane) {
#pragma unroll
    for (int o = 1; o < 64; o <<= 1) { const float t = __shfl_up(v, o); if (lane >= o) v = fmaxf(v, t); }
    return v;
}
constexpr int ML_A2 = 0, ML_M2 = 16384, ML_MT2 = 32768, ML_CH = 49152, ML_RS = 50176, ML_HSQ = 50688, ML_PS = 51712, ML_BUF = 56320;
constexpr int ML_QP = 72, ML_KP = 72, ML_VP = 136, ML_PP = 72;
constexpr int ML_QS = 0, ML_KS = 32 * ML_QP * 2, ML_VS = ML_KS + 64 * ML_KP * 2, ML_BUFB = ML_VS + 64 * ML_VP * 2;
static_assert(ML_BUF + 2 * ML_BUFB <= RING_BYTES && ML_BUFB % 16 == 0 && ML_KS % 16 == 0 && ML_VS % 16 == 0, "mlstm lds map");

__device__ __forceinline__ void mlstm_phase(LAS unsigned char* lds, const bf16* QKVO, const float* GT, const float* bgate, const float* whn, bf16* HA, int vcu, int G, int tid, int wave, int lane) {
    LAS float* A2 = (LAS float*)(lds + ML_A2); LAS float* M2 = (LAS float*)(lds + ML_M2); LAS float* MT2 = (LAS float*)(lds + ML_MT2);
    LAS float* blast = (LAS float*)(lds + ML_CH); LAS float* amaxc = blast + 64; LAS float* m2c = blast + 128; LAS float* Mlc = blast + 192;
    LAS float* RS = (LAS float*)(lds + ML_RS); LAS float* HSQ = (LAS float*)(lds + ML_HSQ);
    LAS bf16* Ps = (LAS bf16*)(lds + ML_PS);
    const int fr = lane & 15, fq = lane >> 4, q4 = fr >> 2, p4 = fr & 3;
    const int tt_s = wave >> 2, st_s = wave & 3, e0 = 16 * wave;
    for (int unit = vcu; unit < BATCH * MH * 2; unit += G) {
        const int bh = unit >> 1, rh = unit & 1, b = bh >> 3, h = bh & 7;
        {
            const float bi = bgate[h], bfg = bgate[MH + h];
            int lane_s = lane; asm volatile("" : "+v"(lane_s));
            float ivr[NCH / NWAVES], fvr[NCH / NWAVES];
#pragma unroll
            for (int k = 0; k < NCH / NWAVES; ++k) { const size_t row = (size_t)b * SEQ + (wave + k * NWAVES) * LCH + lane; ivr[k] = GT[row * 16 + h]; fvr[k] = GT[row * 16 + MH + h]; }
#pragma unroll
            for (int k = 0; k < NCH / NWAVES; ++k) {
                const int c = wave + k * NWAVES;
                const float iv = ivr[k] + bi, fv = fvr[k] + bfg;
                const float lf = fminf(fv, 0.f) - log1pf(expf(-fabsf(fv)));
                const float b2 = wscan_add(lf * LOG2E, lane_s);
                const float a2 = iv * LOG2E - b2;
                const float lam = wscan_max(a2, lane_s);
                A2[c * LCH + lane] = a2; M2[c * LCH + lane] = lam; MT2[c * LCH + lane] = b2;
                if (lane == 63) { blast[c] = b2; amaxc[c] = lam; }
            }
            __syncthreads();
            if (tid == 0) { float m2 = 0.f; for (int c = 0; c < NCH; ++c) { m2c[c] = m2; const float Ml = fmaxf(m2, amaxc[c]); Mlc[c] = Ml; m2 = blast[c] + Ml; } }
            __syncthreads();
            for (int t = tid; t < SEQ; t += NWAVES * 64) { const float Mv = fmaxf(m2c[t >> 6], M2[t]); M2[t] = Mv; MT2[t] = MT2[t] + Mv; }
            __syncthreads();
        }
        const bf16* Qg = QKVO + (size_t)b * SEQ * MIN_LD + h * DK;
        const bf16* Kg = Qg + 512;
        const bf16* Vg = QKVO + (size_t)b * SEQ * MIN_LD + 1024 + h * DV;
        const bf16* Og = Vg + 1024;
        const float whn_l = whn[h * DV + e0 + fr];
        f32x4 Cst[4], Nst[4];
#pragma unroll
        for (int i = 0; i < 4; ++i) { Cst[i] = (f32x4){0.f, 0.f, 0.f, 0.f}; Nst[i] = (f32x4){0.f, 0.f, 0.f, 0.f}; }
        v4u kreg, vreg0, vreg1, qreg = (v4u){0u, 0u, 0u, 0u};
#define ML_LOAD(c) do { const size_t r_ = (size_t)(c) * LCH; \
            kreg = *(const GAS v4u*)(Kg + (r_ + (tid >> 3)) * MIN_LD + (tid & 7) * 8); \
            vreg0 = *(const GAS v4u*)(Vg + (r_ + (tid >> 4)) * MIN_LD + (tid & 15) * 8); \
            vreg1 = *(const GAS v4u*)(Vg + (r_ + 32 + (tid >> 4)) * MIN_LD + (tid & 15) * 8); \
            if (tid < 256) qreg = *(const GAS v4u*)(Qg + (r_ + 32 * rh + (tid >> 3)) * MIN_LD + (tid & 7) * 8); } while (0)
#define ML_STORE(bufp) do { \
            *(LAS v4u*)((bufp) + ML_KS + ((tid >> 3) * ML_KP + (tid & 7) * 8) * 2) = kreg; \
            *(LAS v4u*)((bufp) + ML_VS + ((tid >> 4) * ML_VP + (tid & 15) * 8) * 2) = vreg0; \
            *(LAS v4u*)((bufp) + ML_VS + ((32 + (tid >> 4)) * ML_VP + (tid & 15) * 8) * 2) = vreg1; \
            if (tid < 256) *(LAS v4u*)((bufp) + ML_QS + ((tid >> 3) * ML_QP + (tid & 7) * 8) * 2) = qreg; } while (0)
        ML_LOAD(0);
        ML_STORE(lds + ML_BUF);
        BAR_LDS();
#pragma unroll 1
        for (int c = 0; c < NCH; ++c) {
            LAS unsigned char* buf = lds + ML_BUF + (c & 1) * ML_BUFB;
            LAS unsigned char* nbuf = lds + ML_BUF + ((c & 1) ^ 1) * ML_BUFB;
            const LAS bf16* Qs = (const LAS bf16*)(buf + ML_QS); const LAS bf16* Ks = (const LAS bf16*)(buf + ML_KS); const LAS bf16* Vs = (const LAS bf16*)(buf + ML_VS);
            if (c + 1 < NCH) ML_LOAD(c + 1);
            unsigned short og[2][4];
#pragma unroll
            for (int tt = 0; tt < 2; ++tt)
#pragma unroll
                for (int j = 0; j < 4; ++j) og[tt][j] = *(const GAS unsigned short*)(Og + ((size_t)c * LCH + 32 * rh + 16 * tt + 4 * fq + j) * MIN_LD + e0 + fr);
            const int cb = c * LCH;
            {
                const LAS bf16* Kt = Ks + (16 * st_s + fr) * ML_KP + 8 * fq;
                const LAS bf16* Qt = Qs + (16 * tt_s + fr) * ML_QP + 8 * fq;
                f32x4 sacc = (f32x4){0.f, 0.f, 0.f, 0.f};
#pragma unroll
                for (int g = 0; g < 2; ++g) { const bf16x8 ka = *(const las_bf16x8*)(Kt + 32 * g), qb = *(const las_bf16x8*)(Qt + 32 * g); sacc = __builtin_amdgcn_mfma_f32_16x16x32_bf16(ka, qb, sacc, 0, 0, 0); }
                const int t_loc = 16 * tt_s + fr, t_pos = 32 * rh + t_loc;
                const float Mt = M2[cb + t_pos];
                const f32x4 av = *(const las_f32x4*)(A2 + cb + 16 * st_s + 4 * fq);
                float p[4];
#pragma unroll
                for (int j = 0; j < 4; ++j) { const int s_pos = 16 * st_s + 4 * fq + j; const float w = __builtin_amdgcn_exp2f(av[j] - Mt - 3.0f); p[j] = (s_pos <= t_pos) ? sacc[j] * w : 0.f; }
                typedef unsigned u32x2 __attribute__((ext_vector_type(2)));
                u32x2 pk; pk.x = cvtpk(p[0], p[1]); pk.y = cvtpk(p[2], p[3]);
                *(LAS u32x2*)(Ps + t_loc * ML_PP + 16 * st_s + 4 * fq) = pk;
            }
            BAR_LDS();
            bf16x8 vf[2];
            {
                const LAS bf16* Vt = Vs + (8 * fq + q4) * ML_VP + e0 + 4 * p4;
#pragma unroll
                for (int g = 0; g < 2; ++g) { const s16x4 lo = tr16(Vt + 32 * g * ML_VP), hi = tr16(Vt + (32 * g + 4) * ML_VP); vf[g] = (bf16x8){lo[0], lo[1], lo[2], lo[3], hi[0], hi[1], hi[2], hi[3]}; }
            }
            float hval[2][4];
            bf16x8 cbf[2], nbf[2];
                const bf16x8 ones = (bf16x8){0x3f80, 0x3f80, 0x3f80, 0x3f80, 0x3f80, 0x3f80, 0x3f80, 0x3f80};
#pragma unroll
                for (int g = 0; g < 2; ++g) {
                    typedef unsigned u32x4v __attribute__((ext_vector_type(4)));
                    u32x4v a, n;
                    a.x = cvtpk(Cst[2 * g][0], Cst[2 * g][1]); a.y = cvtpk(Cst[2 * g][2], Cst[2 * g][3]); a.z = cvtpk(Cst[2 * g + 1][0], Cst[2 * g + 1][1]); a.w = cvtpk(Cst[2 * g + 1][2], Cst[2 * g + 1][3]);
                    n.x = cvtpk(Nst[2 * g][0], Nst[2 * g][1]); n.y = cvtpk(Nst[2 * g][2], Nst[2 * g][3]); n.z = cvtpk(Nst[2 * g + 1][0], Nst[2 * g + 1][1]); n.w = cvtpk(Nst[2 * g + 1][2], Nst[2 * g + 1][3]);
                    cbf[g] = __builtin_bit_cast(bf16x8, a); nbf[g] = __builtin_bit_cast(bf16x8, n);
                }
            auto SB = [&]() __attribute__((always_inline)) {
                f32x4 hi_acc[2], he_acc[2], qn_acc[2], rs_acc[2];
#pragma unroll
                for (int tt = 0; tt < 2; ++tt) {
                    hi_acc[tt] = (f32x4){0.f, 0.f, 0.f, 0.f}; he_acc[tt] = (f32x4){0.f, 0.f, 0.f, 0.f}; qn_acc[tt] = (f32x4){0.f, 0.f, 0.f, 0.f}; rs_acc[tt] = (f32x4){0.f, 0.f, 0.f, 0.f};
#pragma unroll
                    for (int g = 0; g < 2; ++g) {
                        const bf16x8 pf = *(const las_bf16x8*)(Ps + (16 * tt + fr) * ML_PP + 32 * g + 8 * fq);
                        hi_acc[tt] = __builtin_amdgcn_mfma_f32_16x16x32_bf16(pf, vf[g], hi_acc[tt], 0, 0, 0);
                        rs_acc[tt] = __builtin_amdgcn_mfma_f32_16x16x32_bf16(pf, ones, rs_acc[tt], 0, 0, 0);
                        const s16x4 qlo = *(const las_s16x4*)(Qs + (16 * tt + fr) * ML_QP + 32 * g + 4 * fq), qhi = *(const las_s16x4*)(Qs + (16 * tt + fr) * ML_QP + 32 * g + 16 + 4 * fq);
                        const bf16x8 qp = (bf16x8){qlo[0], qlo[1], qlo[2], qlo[3], qhi[0], qhi[1], qhi[2], qhi[3]};
                        he_acc[tt] = __builtin_amdgcn_mfma_f32_16x16x32_bf16(qp, cbf[g], he_acc[tt], 0, 0, 0);
                        qn_acc[tt] = __builtin_amdgcn_mfma_f32_16x16x32_bf16(qp, nbf[g], qn_acc[tt], 0, 0, 0);
                    }
                }
                const float m2cc = m2c[c];
                float qs[2][4];
#pragma unroll
                for (int tt = 0; tt < 2; ++tt) {
                    const int tl0 = 16 * tt + 4 * fq;
                    const f32x4 Mv = *(const las_f32x4*)(M2 + cb + 32 * rh + tl0), MTv = *(const las_f32x4*)(MT2 + cb + 32 * rh + tl0);
#pragma unroll
                    for (int j = 0; j < 4; ++j) {
                        const float w = __builtin_amdgcn_exp2f(m2cc - Mv[j] - 3.0f);
                        const float num = hi_acc[tt][j] + w * he_acc[tt][j];
                        const float den = rs_acc[tt][j] + w * qn_acc[tt][j];
                        const float dd = fmaxf(fabsf(den), __builtin_amdgcn_exp2f(-MTv[j]));
                        const float hv = num * __builtin_amdgcn_rcpf(dd);
                        hval[tt][j] = hv;
                        float q = hv * hv;
                        q += pg8::dpp_ror<8>(q); q += pg8::dpp_ror<4>(q); q += pg8::dpp_ror<2>(q); q += pg8::dpp_ror<1>(q);
                        qs[tt][j] = q;
                    }
                }
                if (fr == 0) {
#pragma unroll
                    for (int tt = 0; tt < 2; ++tt) *(las_f32x4*)(HSQ + wave * 32 + 16 * tt + 4 * fq) = (f32x4){qs[tt][0], qs[tt][1], qs[tt][2], qs[tt][3]};
                }
            };
            auto SD = [&]() __attribute__((always_inline)) {
                const float Ml = Mlc[c], decay = __builtin_amdgcn_exp2f(m2c[c] - Ml);
                bf16x8 vfs[2], wkf[2];
#pragma unroll
                for (int g = 0; g < 2; ++g) {
                    const f32x4 a0 = *(const las_f32x4*)(A2 + cb + 32 * g + 8 * fq), a1 = *(const las_f32x4*)(A2 + cb + 32 * g + 8 * fq + 4);
                    float wk[8];
#pragma unroll
                    for (int j = 0; j < 4; ++j) { wk[j] = __builtin_amdgcn_exp2f(a0[j] - Ml); wk[4 + j] = __builtin_amdgcn_exp2f(a1[j] - Ml); }
                    typedef unsigned u32x4v __attribute__((ext_vector_type(4)));
                    const u32x4v vr = __builtin_bit_cast(u32x4v, vf[g]); u32x4v vs, ws_;
#pragma unroll
                    for (int e = 0; e < 4; ++e) { vs[e] = cvtpk(bf_lo(vr[e]) * wk[2 * e], bf_hi(vr[e]) * wk[2 * e + 1]); ws_[e] = cvtpk(wk[2 * e], wk[2 * e + 1]); }
                    vfs[g] = __builtin_bit_cast(bf16x8, vs); wkf[g] = __builtin_bit_cast(bf16x8, ws_);
                }
                const LAS bf16* Kt2 = Ks + (8 * fq + q4) * ML_KP + 4 * p4;
#pragma unroll
                for (int dt = 0; dt < 4; ++dt) {
                    Cst[dt] = Cst[dt] * decay; Nst[dt] = Nst[dt] * decay;
#pragma unroll
                    for (int g = 0; g < 2; ++g) {
                        const s16x4 lo = tr16(Kt2 + 32 * g * ML_KP + 16 * dt), hi = tr16(Kt2 + (32 * g + 4) * ML_KP + 16 * dt);
                        const bf16x8 kf = (bf16x8){lo[0], lo[1], lo[2], lo[3], hi[0], hi[1], hi[2], hi[3]};
                        Cst[dt] = __builtin_amdgcn_mfma_f32_16x16x32_bf16(kf, vfs[g], Cst[dt], 0, 0, 0);
                        Nst[dt] = __builtin_amdgcn_mfma_f32_16x16x32_bf16(kf, wkf[g], Nst[dt], 0, 0, 0);
                    }
                }
            };
            if (wave < 4) { SB(); __builtin_amdgcn_sched_barrier(0); SD(); } else { SD(); __builtin_amdgcn_sched_barrier(0); SB(); }
            if (c + 1 < NCH) ML_STORE(nbuf);
            BAR_LDS();
#pragma unroll
            for (int tt = 0; tt < 2; ++tt) {
                const int tl0 = 16 * tt + 4 * fq;
                f32x4 sp[NWAVES];
#pragma unroll
                for (int w = 0; w < NWAVES; ++w) sp[w] = *(const las_f32x4*)(HSQ + w * 32 + tl0);
                const f32x4 ss = ((sp[0] + sp[1]) + (sp[2] + sp[3])) + ((sp[4] + sp[5]) + (sp[6] + sp[7]));
#pragma unroll
                for (int j = 0; j < 4; ++j) {
                    const float r = __builtin_amdgcn_rsqf(ss[j] * (1.f / DV) + EPS);
                    const float ogf = __uint_as_float((unsigned)og[tt][j] << 16);
                    const float sg = __builtin_amdgcn_rcpf(1.f + __builtin_amdgcn_exp2f(-LOG2E * ogf));
                    const float ov = hval[tt][j] * r * whn_l * sg;
                    const size_t row = (size_t)b * SEQ + cb + 32 * rh + tl0 + j;
                    *(GAS unsigned short*)(HA + row * D + h * DV + e0 + fr) = (unsigned short)(cvtpk(ov, 0.f) & 0xffffu);
                }
            }
        }
#undef ML_LOAD
#undef ML_STORE
        __syncthreads();
    }
}

constexpr int FX_CS = 86016, FX_WT = FX_CS + 2 * SEQ * 4;
static_assert(attn_body::ATTN_LDS_BYTES <= FX_CS && FX_WT + 128 <= RING_BYTES, "fox lds map");
template <int BLK> __device__ __forceinline__ void fox_rownorm2_blocks(const bf16* T, int bh, LAS float* rown, float* out, int tid) {
    const int b = bh >> 4, h = bh & 15, sub = tid & 7, r0 = tid >> 3;
    const GAS v4u* src = (const GAS v4u*)(T + ((size_t)b * SEQ + r0) * D + h * 64 + sub * 8);
    __syncthreads();
#pragma unroll 1
    for (int it = 0; it < 64; it += 8) {
        v4u v[8];
#pragma unroll
        for (int k = 0; k < 8; ++k) v[k] = src[(size_t)(it + k) * 64 * (D / 8)];
#pragma unroll
        for (int k = 0; k < 8; ++k) {
            float q = 0.f;
#pragma unroll
            for (int e = 0; e < 4; ++e) { const float lo = bf_lo(v[k][e]), hi = bf_hi(v[k][e]); q += lo * lo + hi * hi; }
            q += __shfl_xor(q, 1); q += __shfl_xor(q, 2); q += __shfl_xor(q, 4);
            if (sub == 0) rown[(it + k) * 64 + r0] = q;
        }
    }
    __syncthreads();
    {
        const f32x4 a = *(const LAS f32x4*)(rown + 8 * tid), c = *(const LAS f32x4*)(rown + 8 * tid + 4);
        float mx = fmaxf(fmaxf(fmaxf(a[0], a[1]), fmaxf(a[2], a[3])), fmaxf(fmaxf(c[0], c[1]), fmaxf(c[2], c[3])));
#pragma unroll
        for (int o = 1; o < BLK / 8; o <<= 1) mx = fmaxf(mx, __shfl_xor(mx, o));
        if ((tid & (BLK / 8 - 1)) == 0) out[bh * (SEQ / BLK) + tid / (BLK / 8)] = mx;
    }
}
__device__ __forceinline__ void fox_cscan_phase(LAS unsigned char* lds, const float* FG, const float* kvbf, float* C2, const bf16* Kb, float* KMAX, int vcu, int G) {
    LAS float* wt = (LAS float*)(lds + FX_WT);
    for (int bh = vcu; bh < BATCH * FH; bh += G) {
        const int b = bh >> 4, h = bh & 15;
        int tid = threadIdx.x; asm volatile("" : "+v"(tid)); const int lane = tid & 63, wave = __builtin_amdgcn_readfirstlane(tid >> 6);
        const float bb = kvbf[h]; float pre[8]; float run = 0.f;
#pragma unroll
        for (int k = 0; k < 8; ++k) { const float fv = FG[((size_t)b * SEQ + 8 * tid + k) * 16 + h] + bb; const float lf = fminf(fv, 0.f) - log1pf(expf(-fabsf(fv))); run += lf * LOG2E; pre[k] = run; }
        const float incl = wscan_add(run, lane);
        __syncthreads();
        if (lane == 63) wt[wave] = incl;
        __syncthreads();
        float off = incl - run;
        for (int w = 0; w < wave; ++w) off += wt[w];
        GAS f32x4* o = (GAS f32x4*)(C2 + (size_t)bh * SEQ + 8 * tid);
        o[0] = (f32x4){off + pre[0], off + pre[1], off + pre[2], off + pre[3]}; o[1] = (f32x4){off + pre[4], off + pre[5], off + pre[6], off + pre[7]};
        fox_rownorm2_blocks<64>(Kb, bh, (LAS float*)(lds + FX_CS), KMAX, tid);
    }
}
__device__ __forceinline__ void fox_qnorm_phase(LAS unsigned char* lds, const bf16* Qb, float* QMAX, const float* C2, const float* KMAX, int* T0, int vcu, int G) {
    for (int bh = vcu; bh < BATCH * FH; bh += G) {
        int tid = threadIdx.x; asm volatile("" : "+v"(tid));
        fox_rownorm2_blocks<256>(Qb, bh, (LAS float*)(lds + FX_CS), QMAX, tid);
        __threadfence_block(); __syncthreads();
        {
            const int lane = tid & 63, wave = __builtin_amdgcn_readfirstlane(tid >> 6);
            const GAS float* c2 = (const GAS float*)C2 + (size_t)bh * SEQ; const GAS float* km = (const GAS float*)KMAX + bh * 64;
            const float cend = c2[64 * lane + 63], kt = sqrtf(km[lane]) * 1.0001f;
#pragma unroll
            for (int k = 0; k < 2; ++k) {
                const int qb = 2 * wave + k, NT = 4 * (qb + 1);
                const float qu = sqrtf(__hip_atomic_load((const GAS float*)QMAX + bh * 16 + qb, __ATOMIC_RELAXED, __HIP_MEMORY_SCOPE_AGENT)) * 1.0001f;
                const float kband = fmaxf(fmaxf(sqrtf(km[NT - 4]), sqrtf(km[NT - 3])), fmaxf(sqrtf(km[NT - 2]), sqrtf(km[NT - 1]))) * 1.0001f;
                const bool keep = (lane >= NT - 4) || (c2[256 * qb] - cend >= -(qu * (kt + kband) + 48.f));
                int t0 = __builtin_ctzll(__ballot(keep)); t0 = (t0 > NT - 4 ? NT - 4 : t0) & ~1;
                if (lane == 0) T0[bh * 16 + qb] = t0;
            }
        }
    }
}
__device__ __forceinline__ void fox_phase(unsigned char* lds_g, LAS unsigned char* lds, const bf16* Qb, const bf16* Kb, const bf16* Vb, const bf16* Gb, bf16* Ob, const float* C2, const int* T0, gu32* qhead) {
    LAS unsigned* wq = (LAS unsigned*)(lds + FX_WT + 64);
    int cb = 0;
    if (threadIdx.x == 0) { const unsigned u0 = __hip_atomic_fetch_add(qhead, 1u, __ATOMIC_RELAXED, __HIP_MEMORY_SCOPE_AGENT); wq[0] = u0; wq[1] = (u0 < (unsigned)(BATCH * FH * 16)) ? (unsigned)((const GAS int*)T0)[(u0 & 255u) * 16u + 15u - (u0 >> 8)] : 0u; }
    __syncthreads();
    {
        int tid = threadIdx.x; asm volatile("" : "+v"(tid));
        const unsigned u = wq[0];
        if (u < (unsigned)(BATCH * FH * 16)) {
            const GAS f32x4* src = (const GAS f32x4*)(C2 + (size_t)(u & 255u) * SEQ);
            const f32x4 a = src[tid], c = src[tid + 512];
            LAS float* cs0 = (LAS float*)(lds + FX_CS);
            *(LAS f32x4*)(cs0 + 4 * tid) = a; *(LAS f32x4*)(cs0 + 4 * (tid + 512)) = c;
        }
    }
    __syncthreads();
#pragma unroll 1
    for (;;) {
        const unsigned u = wq[0];
        if (u >= (unsigned)(BATCH * FH * 16)) break;
        const int qb = 15 - (int)(u >> 8), bh = (int)(u & 255u);
        const size_t so = (size_t)(bh >> 5) * ((SLAB_BYTES - SH_ROW1K) / 2);
        const int t0 = __builtin_amdgcn_readfirstlane((int)wq[1]);
        LAS float* cs = (LAS float*)(lds + FX_CS + cb * (SEQ * 4));
        attn_body::attn_unit<40>(bh >> 4, bh & 15, qb, (const attn_body::bf16*)(Qb + so), (const attn_body::bf16*)Kb, (const attn_body::bf16*)Vb, (attn_body::bf16*)(Ob + so), (const attn_body::bf16*)(Gb + so), (attn_body::lds_cf32)cs, t0, (unsigned*)qhead, wq, T0, C2, (unsigned)(FX_CS + (cb ^ 1) * (SEQ * 4)), (char*)lds_g);
        cb ^= 1;
    }
    __syncthreads();
}

struct Args { Ins in; float* out; unsigned char* ws; };
struct KArgs { const GAS float* in[18]; GAS float* out; GAS unsigned char* ws; };
static_assert(sizeof(KArgs) == sizeof(Args), "kernarg view");
typedef const __attribute__((address_space(4))) KArgs* kargs_t;
__device__ __forceinline__ kargs_t kargs() { kargs_t p = (kargs_t)__builtin_amdgcn_kernarg_segment_ptr(); asm volatile("" : "+s"(p)); return p; }
#define PHASE_IDS() \
    int tid = threadIdx.x; asm volatile("" : "+v"(tid)); \
    const int lane = tid & 63, wave = __builtin_amdgcn_readfirstlane(tid >> 6); \
    extern __shared__ __attribute__((aligned(16))) unsigned char lds_raw[]; LAS unsigned char* lds = (LAS unsigned char*)lds_raw; (void)lds; \
    int G = gridDim.x, bx = __builtin_amdgcn_readfirstlane(*(volatile LAS int*)(lds + MISC_OFF + 40)); asm volatile("" : "+s"(G), "+s"(bx));   \
    const int vcu = (bx % 8) * (G / 8) + bx / 8, xg = bx % 8; \
    const int gw = vcu * NWAVES + wave, NGW = G * NWAVES, gtid = vcu * (NWAVES * 64) + tid, NT = G * NWAVES * 64; \
    (void)lane; (void)wave; (void)vcu; (void)xg; (void)gw; (void)NGW; (void)gtid; (void)NT; \
    const kargs_t ka = kargs(); unsigned char* ws = (unsigned char*)ka->ws; (void)ws;
constexpr size_t WS_STAMP = 512 * 1024;
#if defined(PROBE_A0) || defined(PROBE_K)
#define STAMP(k) do { if (blockIdx.x == 0 && threadIdx.x == 0) { __hip_atomic_store((GAS unsigned long long*)((unsigned char*)kargs()->ws + WS_STAMP) + (k), (unsigned long long)__builtin_amdgcn_s_memrealtime(), __ATOMIC_RELAXED, __HIP_MEMORY_SCOPE_AGENT); } } while (0)
#else
#define STAMP(k) do { } while (0)
#endif
#ifdef PROBE_SKEW
#define SKEW_ARR() do { if (threadIdx.x == 0) { unsigned bx_ = blockIdx.x; asm volatile("" : "+s"(bx_)); __hip_atomic_store((GAS unsigned long long*)((unsigned char*)kargs()->ws + WS_STAMP + 4096) + ((size_t)(curL * 16 + ((__COUNTER__ >> 1) & 15)) * 256 + bx_), (unsigned long long)__builtin_amdgcn_s_memrealtime(), __ATOMIC_RELAXED, __HIP_MEMORY_SCOPE_AGENT); } } while (0)
#define SKEW_DEP() do { if (threadIdx.x == 0) { unsigned bx_ = blockIdx.x; asm volatile("" : "+s"(bx_)); __hip_atomic_store((GAS unsigned long long*)((unsigned char*)kargs()->ws + WS_STAMP + 4096 + 80 * 256 * 8) + ((size_t)(curL * 16 + (((__COUNTER__ - 1) >> 1) & 15)) * 256 + bx_), (unsigned long long)__builtin_amdgcn_s_memrealtime(), __ATOMIC_RELAXED, __HIP_MEMORY_SCOPE_AGENT); } } while (0)
#else
#define SKEW_ARR() do { } while (0)
#define SKEW_DEP() do { } while (0)
#endif
#define GRID_BAR_ALL() do { SKEW_ARR(); { extern __shared__ __attribute__((aligned(16))) unsigned char lds_b_[]; XcdBarrier bar_; bar_.bar = (unsigned*)((unsigned char*)kargs()->ws + WS_CTL) + CW_BAR; bar_.x = xb_xcc_id(); \
    bar_.st = (volatile LAS unsigned*)((LAS unsigned char*)lds_b_ + MISC_OFF) + 8; xcd_barrier(bar_); } SKEW_DEP(); } while (0)
#define GRID_BAR() do { SKEW_ARR(); { extern __shared__ __attribute__((aligned(16))) unsigned char lds_b_[]; volatile LAS unsigned* st_ = (volatile LAS unsigned*)((LAS unsigned char*)lds_b_ + MISC_OFF) + 8; \
    unsigned* barw_ = (unsigned*)((unsigned char*)kargs()->ws + WS_CTL) + CW_BAR; \
    if (__builtin_amdgcn_readfirstlane(st_[3])) xcc_local_barrier(barw_, xb_xcc_id(), 32u); \
    else { XcdBarrier bar_; bar_.bar = barw_; bar_.x = xb_xcc_id(); bar_.st = st_; xcd_barrier(bar_); } } SKEW_DEP(); } while (0)

__global__ void __launch_bounds__(NWAVES * 64, 2) yoco_fwd(Args args_unused) {
#ifdef PROBE_SKEW
    int curL = 4;
#endif
    STAMP(100);
    {
        extern __shared__ __attribute__((aligned(16))) unsigned char lds_z_[]; LAS unsigned char* ldz = (LAS unsigned char*)lds_z_;
        for (int u = threadIdx.x; u < (LDS_BYTES - LDSCTL_OFF) / 4; u += NWAVES * 64) ((LAS unsigned*)(ldz + LDSCTL_OFF))[u] = 0u;
        __syncthreads();
        if (threadIdx.x == 0) {
            unsigned* barw = (unsigned*)((unsigned char*)kargs()->ws + WS_CTL) + CW_BAR; volatile LAS unsigned* st = (volatile LAS unsigned*)(ldz + MISC_OFF) + 8;
            st[4] = xb_add(&barw[XB_XCNT(xb_xcc_id())], 1u); st[2] = blockIdx.x;
        }
        __syncthreads();
    }
    {
        PHASE_IDS();
        Ins in;
#pragma unroll
        for (int i = 0; i < 18; ++i) in.p[i] = (const float*)ka->in[i];
        prologue_weights(in, ws, lds, gw, NGW, wave, lane);
        STAMP(102);
        norm_first(in.p[0], (bf16*)(ws + WS_XH), (float*)(ws + WS_RSTD), gw, NGW, lane);
        for (int i = gtid; i < (int)((4 * MiB) / 16); i += NT) ((GAS v4u*)(ws + WS_SUMS))[i] = (v4u){0u, 0u, 0u, 0u};
    }
    GRID_BAR();
    {
        extern __shared__ __attribute__((aligned(16))) unsigned char lds_m_[]; volatile LAS unsigned* st = (volatile LAS unsigned*)((LAS unsigned char*)lds_m_ + MISC_OFF) + 8;
        if (threadIdx.x == 0) {
            unsigned* barw = (unsigned*)((unsigned char*)kargs()->ws + WS_CTL) + CW_BAR; const unsigned x = xb_xcc_id();
            bool uni = (gridDim.x == 256u) && (x < 8u);
            for (unsigned j = 0; j < 8; ++j) uni = uni && (xb_ld(&barw[XB_XCNT(j)]) == 32u);
#if GROUP_LOCAL_SYNC
            if (uni) { st[2] = st[4] * 8u + x; st[3] = 1u; }
#else
            (void)uni;
#endif
        }
        __syncthreads();
    }
    STAMP(101);

#pragma unroll 1
    for (int L = 0; L < 4; ++L) {
        STAMP(L * 20 + 0);
#ifdef PROBE_SKEW
        curL = L;
#endif
        if (L < 2) {
            {
                PHASE_IDS();
                pg8::Gemm g{(const bf16*)(ws + WS_XH), (const bf16*)(ws + WS_WIN + L * SZ_WIN), M, MIN_NP, D}; pg8::StaticOrder S; S.init(M, MIN_NP, G, bx);
                pg8::EpiOut E{(bf16*)SLAB(SO_QKVO, SH_QKVO), MIN_LD, 0, 0, 1.f, MIN_LD / 256, (float*)(ws + WS_GATES), nullptr};
                pg8::gemm_phase<pg8::EpiOut, pg8::StaticOrder, true, true>(lds + RING_OFF, g, S, E);
            }
            GRID_BAR();
            STAMP(L * 20 + 1);
            {
                PHASE_IDS();
                mlstm_phase(lds, (const bf16*)SLAB(SO_QKVO, SH_QKVO), (const float*)(ws + WS_GATES), (const float*)ka->in[6] + L * 16, (const float*)ka->in[7] + L * D, (bf16*)SLAB(SO_HA, SH_ROW1K), vcu, G, tid, wave, lane);
            }
        } else {
            {
                PHASE_IDS();
                const int j = L - 2;
                pg8::Gemm g{(const bf16*)(ws + WS_XH), (const bf16*)(ws + WS_WQG + j * SZ_WQG), M, 2 * D, D}; pg8::StaticOrder S; S.init(M, 2 * D, G, bx);
                pg8::EpiOut E{(bf16*)SLAB(SO_FQ, SH_ROW1K), D, D, (size_t)(SO_FG - SO_FQ) / 2, attn_body::C2, -1, nullptr, nullptr, (int*)(ws + WS_T0), (const float*)(ws + WS_C2), (const float*)(ws + WS_KMAX), (LAS float*)(lds + XCH_OFF)};
                pg8::gemm_phase<pg8::EpiOut, pg8::StaticOrder, true, true>(lds + RING_OFF, g, S, E);
            }
            GRID_BAR_ALL();
            STAMP(L * 20 + 1);
            {
                PHASE_IDS();
                fox_phase(lds_raw, lds, (const bf16*)(ws + WS_S + SO_FQ), (const bf16*)(ws + WS_KB), (const bf16*)(ws + WS_VB), (const bf16*)(ws + WS_S + SO_FG), (bf16*)(ws + WS_S + SO_FQ), (const float*)(ws + WS_C2), (const int*)(ws + WS_T0), (gu32*)(ws + WS_CTL) + CW_QUEUE + 64 * (L - 2));
            }
        }
        if (L < 2) GRID_BAR(); else GRID_BAR_ALL();
        STAMP(L * 20 + 2);
        {
            PHASE_IDS();
            const bf16* Aout = (L < 2) ? (const bf16*)SLAB(SO_HA, SH_ROW1K) : (const bf16*)SLAB(SO_FQ, SH_ROW1K);
            const bf16* Wout = (L < 2) ? (const bf16*)(ws + WS_WMOUT + L * SZ_SQ) : (const bf16*)(ws + WS_WFOUT + (L - 2) * SZ_SQ);
            pg8::Gemm g{Aout, Wout, M, D, D}; pg8::StaticOrder S; S.init(M, D, G, bx);
            pg8::EpiNormRes E{(bf16*)(ws + WS_XH), (float*)(ws + WS_RSTD), (const float*)ka->in[2] + L * D, nullptr, false, (float*)(ws + WS_SUMS), (unsigned*)(ws + WS_CTL) + CW_NCNT, (unsigned*)(ws + WS_CTL) + CW_BAR + XB_TMO, 2 * L, lds + XCH_OFF};
            pg8::gemm_phase<pg8::EpiNormRes, pg8::StaticOrder, true, true>(lds + RING_OFF, g, S, E);
        }
        GRID_BAR();
        STAMP(L * 20 + 3);
        STAMP(L * 20 + 4);
        {
            PHASE_IDS();
            pg8::Gemm g{(const bf16*)(ws + WS_XH), (const bf16*)(ws + WS_WUP + L * SZ_WUP), M, DFF2, D}; pg8::StaticOrder S; S.init(M, DFF2, G, bx);
            pg8::EpiConv E{(bf16*)SLAB(SO_ACT, SH_ACT), (const float*)ka->in[15] + (size_t)L * 3 * DFF2, (const float*)ka->in[16] + (size_t)L * DFF2, (float*)SLAB(SO_HALO, SH_HALO), lds + XCH_OFF, DFF, (const float*)(ws + WS_RSTD)};
            pg8::gemm_phase<pg8::EpiConv, pg8::StaticOrder, true, true>(lds + RING_OFF, g, S, E);
        }
        GRID_BAR();
        STAMP(L * 20 + 5);
        {
            PHASE_IDS();
            ffn_fixup_phase((const float*)SLAB(SO_HALO, SH_HALO), (const float*)ka->in[15] + (size_t)L * 3 * DFF2, (const float*)ka->in[16] + (size_t)L * DFF2, (bf16*)SLAB(SO_ACT, SH_ACT), vcu, tid);
        }
        GRID_BAR();
        STAMP(L * 20 + 6);
        {
            PHASE_IDS();
            pg8::Gemm g{(const bf16*)SLAB(SO_ACT, SH_ACT), (const bf16*)(ws + WS_WDN + L * SZ_WDN), M, D, DFF}; pg8::StaticOrder S; S.init(M, D, G, bx);
            pg8::EpiNormRes E{(bf16*)(ws + WS_XH), (float*)(ws + WS_RSTD), (const float*)ka->in[4] + L * D, (float*)ka->out, L == 3, (float*)(ws + WS_SUMS), (unsigned*)(ws + WS_CTL) + CW_NCNT, (unsigned*)(ws + WS_CTL) + CW_BAR + XB_TMO, 2 * L + 1, lds + XCH_OFF};
            pg8::gemm_phase<pg8::EpiNormRes, pg8::StaticOrder, true, true>(lds + RING_OFF, g, S, E);
        }
        if (L < 3) GRID_BAR();
        STAMP(L * 20 + 10);
        STAMP(L * 20 + 11);
        if (L == 1) {
            PHASE_IDS();
            pg8::Gemm g{(const bf16*)(ws + WS_XH), (const bf16*)(ws + WS_WKV), M, KV_NP, D}; pg8::StaticOrder S; S.init(M, KV_NP, G, bx);
            pg8::EpiOut E{(bf16*)(ws + WS_KB), D, D, (size_t)(WS_VB - WS_KB) / 2, 1.f, 8, (float*)(ws + WS_GATES), nullptr};
            pg8::gemm_phase<pg8::EpiOut, pg8::StaticOrder, true, true>(lds + RING_OFF, g, S, E);
        }
        if (L == 1) {
            GRID_BAR();
            PHASE_IDS();
            fox_cscan_phase(lds, (const float*)(ws + WS_GATES), (const float*)ka->in[11], (float*)(ws + WS_C2), (const bf16*)(ws + WS_KB), (float*)(ws + WS_KMAX), vcu, G);
            GRID_BAR();
        }
        STAMP(L * 20 + 12);
    }
#ifdef PROBE_K
    if (blockIdx.x == 0 && threadIdx.x == 0) {
        const GAS unsigned long long* ts = (const GAS unsigned long long*)((unsigned char*)kargs()->ws + WS_STAMP);
        unsigned long long tot = 0;
        for (int L = 0; L < 6; ++L) if ((PROBE_LMASK >> L) & 1) {
            tot += __hip_atomic_load(ts + 20 * L + PROBE_S1, __ATOMIC_RELAXED, __HIP_MEMORY_SCOPE_AGENT) - __hip_atomic_load(ts + 20 * L + PROBE_S0, __ATOMIC_RELAXED, __HIP_MEMORY_SCOPE_AGENT);
#ifdef PROBE_T0
            tot += __hip_atomic_load(ts + 20 * L + PROBE_T1, __ATOMIC_RELAXED, __HIP_MEMORY_SCOPE_AGENT) - __hip_atomic_load(ts + 20 * L + PROBE_T0, __ATOMIC_RELAXED, __HIP_MEMORY_SCOPE_AGENT);
#endif
        }
        const unsigned long long t0 = __builtin_amdgcn_s_memrealtime();
        while (__builtin_amdgcn_s_memrealtime() - t0 < (unsigned long long)PROBE_K * tot) __builtin_amdgcn_s_sleep(16);
    }
#endif
#ifdef PROBE_END
    {
        extern __shared__ __attribute__((aligned(16))) unsigned char lds_e_[]; volatile LAS unsigned* st = (volatile LAS unsigned*)((LAS unsigned char*)lds_e_ + MISC_OFF) + 8;
        GAS unsigned long long* en = (GAS unsigned long long*)((unsigned char*)kargs()->ws + WS_STAMP + 4096);
        if (threadIdx.x == 0) __hip_atomic_store(en + st[2], (unsigned long long)__builtin_amdgcn_s_memrealtime(), __ATOMIC_RELAXED, __HIP_MEMORY_SCOPE_AGENT);
        GRID_BAR_ALL();
        if (blockIdx.x == 0 && threadIdx.x < 64) {
            unsigned long long gmx = 0, gmn = ~0ull;
            for (int x = 0; x < 8; ++x) {
                unsigned long long v = __hip_atomic_load(en + x + 8 * (threadIdx.x & 31), __ATOMIC_RELAXED, __HIP_MEMORY_SCOPE_AGENT);
                for (int o = 32; o; o >>= 1) { const unsigned long long a = __shfl_xor(v, o); v = a > v ? a : v; }
                gmx = v > gmx ? v : gmx; gmn = v < gmn ? v : gmn;
            }
            if (threadIdx.x == 0) { const unsigned long long t0 = __builtin_amdgcn_s_memrealtime(); while (__builtin_amdgcn_s_memrealtime() - t0 < (unsigned long long)PROBE_END * (gmx - gmn)) __builtin_amdgcn_s_sleep(16); }
        }
    }
#endif
#ifdef PROBE_MODE
    { extern __shared__ __attribute__((aligned(16))) unsigned char lds_p_[]; volatile LAS unsigned* st = (volatile LAS unsigned*)((LAS unsigned char*)lds_p_ + MISC_OFF) + 8;
      if (blockIdx.x == 0 && threadIdx.x == 0 && st[3]) { const unsigned long long t0 = __builtin_amdgcn_s_memrealtime(); while (__builtin_amdgcn_s_memrealtime() - t0 < 200000ull) __builtin_amdgcn_s_sleep(16); } }
#endif
#ifdef PROBE_SKEW
    GRID_BAR();
    if (blockIdx.x == 0 && threadIdx.x < 64) {
        const GAS unsigned long long* ar = (const GAS unsigned long long*)((unsigned char*)kargs()->ws + WS_STAMP + 4096);
        unsigned long long tot = 0;
#if PROBE_SMODE == 2
        unsigned long long gx[8] = {0, 0, 0, 0, 0, 0, 0, 0};
        for (int s = 0; s < 80; ++s) if ((PROBE_SMASK >> (s & 15)) & 1u) {
            unsigned long long mxx[8], mall = 0;
#pragma unroll
            for (int x = 0; x < 8; ++x) {
                unsigned long long v = __hip_atomic_load(ar + (size_t)s * 256 + x + 8 * (threadIdx.x & 31), __ATOMIC_RELAXED, __HIP_MEMORY_SCOPE_AGENT);
                for (int o = 32; o; o >>= 1) { const unsigned long long a = __shfl_xor(v, o); v = a > v ? a : v; }
                mxx[x] = v; mall = v > mall ? v : mall;
            }
            if (mxx[0] != 0) {
#pragma unroll
                for (int x = 0; x < 8; ++x) gx[x] += mall - mxx[x];
            }
        }
        tot = gx[0];
#pragma unroll
        for (int x = 1; x < 8; ++x) tot = gx[x] < tot ? gx[x] : tot;
#endif
#if PROBE_SMODE == 3
        for (int s = 0; s < 80; ++s) if ((PROBE_SMASK >> (s & 15)) & 1u) {
            unsigned long long mx = 0, mn = ~0ull;
            for (int j = 0; j < 4; ++j) { const unsigned long long v = __hip_atomic_load(ar + (size_t)s * 256 + threadIdx.x * 4 + j, __ATOMIC_RELAXED, __HIP_MEMORY_SCOPE_AGENT); mx = v > mx ? v : mx;
                const unsigned long long w = __hip_atomic_load(ar + (size_t)(80 + s) * 256 + threadIdx.x * 4 + j, __ATOMIC_RELAXED, __HIP_MEMORY_SCOPE_AGENT); mn = w < mn ? w : mn; }
            for (int o = 32; o; o >>= 1) { const unsigned long long a = __shfl_xor(mx, o), b = __shfl_xor(mn, o); mx = a > mx ? a : mx; mn = b < mn ? b : mn; }
            if (mx != 0 && mn > mx) tot += mn - mx;
        }
#endif
        for (int s = 0; s < 80 && PROBE_SMODE < 2; ++s) if ((PROBE_SMASK >> (s & 15)) & 1u) {
            unsigned long long mx = 0, mn = ~0ull, sm = 0;
            for (int j = 0; j < 4; ++j) { const unsigned long long v = __hip_atomic_load(ar + (size_t)s * 256 + threadIdx.x * 4 + j, __ATOMIC_RELAXED, __HIP_MEMORY_SCOPE_AGENT); mx = v > mx ? v : mx; mn = v < mn ? v : mn; sm += v; }
            for (int o = 32; o; o >>= 1) { const unsigned long long a = __shfl_xor(mx, o), b = __shfl_xor(mn, o), c = __shfl_xor(sm, o); mx = a > mx ? a : mx; mn = b < mn ? b : mn; sm += c; }
            if (mn != 0) tot += (PROBE_SMODE == 0) ? (mx - mn) : (mx - sm / 256);
        }
        if (threadIdx.x == 0) {
            const unsigned long long t0 = __builtin_amdgcn_s_memrealtime();
            while (__builtin_amdgcn_s_memrealtime() - t0 < (unsigned long long)PROBE_SKEW * tot) __builtin_amdgcn_s_sleep(16);
        }
    }
#endif
#ifdef PROBE_A0
    GRID_BAR();
    {
        PHASE_IDS();
        const GAS unsigned long long* ts = (const GAS unsigned long long*)(ws + WS_STAMP);
        const float c = (float)(__hip_atomic_load(ts + PROBE_A1, __ATOMIC_RELAXED, __HIP_MEMORY_SCOPE_AGENT) - __hip_atomic_load(ts + PROBE_A0, __ATOMIC_RELAXED, __HIP_MEMORY_SCOPE_AGENT)) * 0.001f;
        const float d = (float)(__hip_atomic_load(ts + PROBE_B1, __ATOMIC_RELAXED, __HIP_MEMORY_SCOPE_AGENT) - __hip_atomic_load(ts + PROBE_B0, __ATOMIC_RELAXED, __HIP_MEMORY_SCOPE_AGENT)) * 0.01f;
        GAS float* o = (GAS float*)ka->out;
        for (size_t i = gtid; i < (size_t)M * D; i += NT) o[i] = (i == 0) ? d : c;
    }
#endif
}

extern "C" void kernel_launch(void* const* d_in, const int* in_sizes, int n_in, void* d_out, int out_size, void* d_ws, size_t ws_size, hipStream_t stream) {
    static int grid = 0;
    if (grid == 0) {
        if (n_in != 18 || in_sizes[0] != M * D || out_size != M * D || ws_size < WS_END) { fprintf(stderr, "kernel_launch: unexpected shapes (n_in %d, in0 %d, out %d, ws %zu); nothing launched\n", n_in, n_in > 0 ? in_sizes[0] : -1, out_size, ws_size); grid = -1; return; }
        if (hipFuncSetAttribute((const void*)yoco_fwd, hipFuncAttributeMaxDynamicSharedMemorySize, LDS_BYTES) != hipSuccess) { fprintf(stderr, "kernel_launch: hipFuncSetAttribute failed\n"); grid = -1; return; }
        int dev = 0, cus = 0, per_cu = 0;
        (void)hipGetDevice(&dev); (void)hipDeviceGetAttribute(&cus, hipDeviceAttributeMultiprocessorCount, dev);
        (void)hipOccupancyMaxActiveBlocksPerMultiprocessor(&per_cu, (const void*)yoco_fwd, NWAVES * 64, LDS_BYTES);
        (void)hipGetLastError();
        grid = (cus >= 256 && per_cu >= 1) ? 256 : (cus > 0 ? cus : 256);
    }
    if (grid < 0) return;
    (void)hipMemsetAsync((char*)d_ws + WS_CTL, 0, CTL_ZERO_BYTES, stream);
    Args a{};
    for (int i = 0; i < 18; ++i) a.in.p[i] = (const float*)d_in[i];
    a.out = (float*)d_out; a.ws = (unsigned char*)d_ws;
    hipLaunchKernelGGL(yoco_fwd, dim3(grid), dim3(NWAVES * 64), LDS_BYTES, stream, a);
}
```
